# Optimizing an MI355X kernel written in HIP

```python
import math
import jax
import jax.numpy as jnp
from jax import lax
import numpy as np

D_MODEL = 4096
BATCH = 2
SEQ = 4096
DEPTH = 4

N_META = 16
GRID_W = 64
HEAD_DIM = 128
NA_WIDTH = D_MODEL // 2
NA_HEADS = NA_WIDTH // HEAD_DIM
NA_KH = 8
NA_KW = 16
HG_WIDTH = D_MODEL // 2
HG_HEADS = HG_WIDTH // HEAD_DIM
HG_CHUNK = 64
EVEN_MIX = NA_WIDTH + HG_WIDTH
EVEN_SPLITS = [NA_WIDTH, 2 * NA_WIDTH, 3 * NA_WIDTH, 3 * NA_WIDTH + HG_WIDTH, 3 * NA_WIDTH + 2 * HG_WIDTH, 3 * NA_WIDTH + 3 * HG_WIDTH, 3 * NA_WIDTH + 4 * HG_WIDTH]
EVEN_IN = 3 * NA_WIDTH + 4 * HG_WIDTH + EVEN_MIX
HY_WIDTH = D_MODEL
HY_ORDER = 2
HY_SHORT = 3
HY_EMB = 33
HY_BANDS = (HY_EMB - 1) // 2
HY_FFN = 64
HY_FAST_DECAY = 0.3
HY_SLOW_DECAY = 1.5
HY_TARGET = 1e-2
ODD_IN = (HY_ORDER + 1) * HY_WIDTH + HY_WIDTH
N_EVEN = (DEPTH + 1) // 2
N_ODD = DEPTH // 2
EPS = 1e-6

kernel_name = 'hybrid_natten_hgrn2_hyena_encoder'


def rms_norm(x, g):
    xf = x.astype(jnp.float32)
    xf = xf * lax.rsqrt(jnp.mean(xf * xf, axis=-1, keepdims=True) + EPS)
    return (xf * g.astype(jnp.float32)).astype(x.dtype)


def split_heads(a):
    b, l, w = a.shape
    return a.reshape(b, l, w // HEAD_DIM, HEAD_DIM).transpose(0, 2, 1, 3)


def merge_heads(a):
    b, h, l, d = a.shape
    return a.transpose(0, 2, 1, 3).reshape(b, l, h * d)


def neighbourhood_attention(q, k, v, rpb, meta_bias):
    b, h, l, dh = q.shape
    t = l - N_META
    rows = t // GRID_W
    kh = min(NA_KH, rows)
    scale = dh ** -0.5
    f32 = jnp.float32
    qm, km, vm = q[:, :, :N_META], k[:, :, :N_META], v[:, :, :N_META]
    qg = q[:, :, N_META:].reshape(b, h, rows, GRID_W, dh)
    kg = k[:, :, N_META:].reshape(b, h, rows, GRID_W, dh)
    vg = v[:, :, N_META:].reshape(b, h, rows, GRID_W, dh)
    mbias = meta_bias.astype(f32)[None, :, None, :]
    s_mm = jnp.einsum('bhqd,bhkd->bhqk', qm, km).astype(f32) * scale + mbias
    o_meta = jnp.einsum('bhqk,bhkd->bhqd', jax.nn.softmax(s_mm, axis=-1).astype(v.dtype), vm)
    cols = np.arange(GRID_W)
    c0 = np.clip(cols - NA_KW // 2, 0, GRID_W - NA_KW)
    col_ok = (cols[None, :] >= c0[:, None]) & (cols[None, :] < c0[:, None] + NA_KW)
    col_idx = np.clip(cols[None, :] - cols[:, None] + NA_KW - 1, 0, 2 * NA_KW - 2)
    rpb_cols = rpb.astype(f32)[:, :, col_idx]

    def row_block(r):
        r0 = jnp.clip(r - kh // 2, 0, rows - kh)
        kb = lax.dynamic_slice_in_dim(kg, r0, kh, axis=2)
        vb = lax.dynamic_slice_in_dim(vg, r0, kh, axis=2)
        qr = lax.dynamic_index_in_dim(qg, r, axis=2, keepdims=False)
        s_win = jnp.einsum('bhqd,bhikd->bhqik', qr, kb).astype(f32) * scale
        row_off = r0 + jnp.arange(kh) - r + NA_KH - 1
        bias = jnp.take(rpb_cols, row_off, axis=1).transpose(0, 2, 1, 3)
        s_win = jnp.where(col_ok[None, None, :, None, :], s_win + bias[None], -jnp.inf)
        s_meta = jnp.einsum('bhqd,bhmd->bhqm', qr, km).astype(f32) * scale + mbias
        s = jnp.concatenate([s_meta, s_win.reshape(b, h, GRID_W, kh * GRID_W)], axis=-1)
        p = jax.nn.softmax(s, axis=-1).astype(v.dtype)
        p_win = p[..., N_META:].reshape(b, h, GRID_W, kh, GRID_W)
        return (jnp.einsum('bhqm,bhmd->bhqd', p[..., :N_META], vm)
                + jnp.einsum('bhqik,bhikd->bhqd', p_win, vb))

    o_grid = lax.map(row_block, jnp.arange(rows))
    o_grid = o_grid.transpose(1, 2, 0, 3, 4).reshape(b, h, t, dh)
    return jnp.concatenate([o_meta, o_grid], axis=2)


def hgrn2_bidirectional(q, i, f_fwd, f_bwd, lb, norm_gain):
    out_dtype = q.dtype
    f32 = jnp.float32
    b, l, _ = q.shape
    pad = HG_CHUNK - N_META
    q = jax.nn.silu(q.astype(f32)) * HEAD_DIM ** -0.5
    v = i.astype(f32)

    def gates(f_raw, lb_d):
        f_raw = f_raw.astype(f32)
        log_f = jnp.logaddexp(jnp.log(lb_d), jnp.log1p(-lb_d) + jax.nn.log_sigmoid(f_raw))
        key = (1.0 - lb_d) * jax.nn.sigmoid(-f_raw)
        return log_f, key

    g_f, k_f = gates(f_fwd, lb[0])
    g_b, k_b = gates(f_bwd, lb[1])

    def both_dirs(a_fwd, a_bwd):
        pa = lambda a: jnp.pad(a, ((0, 0), (pad, 0), (0, 0)))
        s = jnp.stack([pa(a_fwd), jnp.flip(pa(a_bwd), axis=1)])
        n_chunks = s.shape[2] // HG_CHUNK
        s = s.reshape(2, b, n_chunks, HG_CHUNK, HG_HEADS, HEAD_DIM)
        return s.transpose(2, 0, 1, 4, 3, 5)

    qs, vs = both_dirs(q, q), both_dirs(v, v)
    ks, gs = both_dirs(k_f, k_b), both_dirs(g_f, g_b)
    mask = np.tril(np.ones((HG_CHUNK, HG_CHUNK), dtype=bool))

    def chunk_step(state, inp):
        qc, kc, vc, gc = inp
        gcum = jnp.cumsum(gc, axis=-2)
        diff = gcum[..., :, None, :] - gcum[..., None, :, :]
        decay = jnp.exp(jnp.where(mask[:, :, None], diff, -jnp.inf))
        attn = jnp.einsum('zbhtd,zbhsd,zbhtsd->zbhts', qc, kc, decay)
        o = (jnp.einsum('zbhts,zbhsv->zbhtv', attn, vc)
             + jnp.einsum('zbhtd,zbhdv->zbhtv', qc * jnp.exp(gcum), state))
        g_end = gcum[..., -1:, :]
        state = (jnp.exp(g_end)[..., 0, :, None] * state
                 + jnp.einsum('zbhsd,zbhsv->zbhdv', kc * jnp.exp(g_end - gcum), vc))
        return state, o

    s0 = jnp.zeros((2, b, HG_HEADS, HEAD_DIM, HEAD_DIM), f32)
    _, o = lax.scan(chunk_step, s0, (qs, ks, vs, gs))
    o = o.transpose(1, 2, 0, 4, 3, 5).reshape(2, b, -1, HG_HEADS, HEAD_DIM)
    o = (o[0] + jnp.flip(o[1], axis=1))[:, pad:]
    o = o * lax.rsqrt(jnp.mean(o * o, axis=-1, keepdims=True) + EPS)
    o = o * norm_gain.astype(f32).reshape(HG_HEADS, HEAD_DIM)
    return o.reshape(b, l, HG_WIDTH).astype(out_dtype)


def short_conv(u, w):
    up = jnp.pad(u, ((0, 0), (1, 1), (0, 0)))
    return up[:, :-2] * w[:, 0] + up[:, 1:-1] * w[:, 1] + up[:, 2:] * w[:, 2]


def hyena_filters(l, w1, b1, fr1, w2, b2, fr2, w3):
    f32 = jnp.float32
    t = jnp.linspace(0.0, 1.0, l, dtype=f32)[:, None]
    w = 2.0 * math.pi * jnp.arange(l, dtype=f32)[:, None] / l
    bands = jnp.linspace(1e-4, HY_BANDS - 1, HY_BANDS, dtype=f32)[None, :]
    z = jnp.concatenate([t, jnp.cos(bands * w), -jnp.sin(bands * w)], axis=-1)
    hid = jnp.sin(fr1.astype(f32) * (z @ w1.astype(f32) + b1.astype(f32)))
    hid = jnp.sin(fr2.astype(f32) * (hid @ w2.astype(f32) + b2.astype(f32)))
    filt = (hid @ w3.astype(f32)).reshape(l, 2, HY_ORDER, HY_WIDTH)
    min_decay = math.log(HY_TARGET) / HY_SLOW_DECAY
    max_decay = math.log(HY_TARGET) / HY_FAST_DECAY
    deltas = jnp.abs(jnp.linspace(min_decay, max_decay, HY_WIDTH, dtype=f32))
    window = jnp.exp(-t * deltas[None, :])
    return filt * window[:, None, None, :]


def long_conv(u, filt, bias):
    l = u.shape[1]
    hf, hb = filt[:, 0], filt[:, 1]
    kern = jnp.concatenate([hf[:1] + hb[:1], hf[1:], jnp.zeros_like(hf[:1]), hb[:0:-1]], axis=0)
    uf = jnp.fft.rfft(u.astype(jnp.float32), n=2 * l, axis=1)
    kf = jnp.fft.rfft(kern, n=2 * l, axis=0)
    y = jnp.fft.irfft(uf * kf[None], n=2 * l, axis=1)[:, :l]
    return (y + u.astype(jnp.float32) * bias.astype(jnp.float32)).astype(u.dtype)


def even_mixer(hn, w_in, w_out, rpb, meta_bias, lb, norm_gain):
    p = hn @ w_in
    qa, ka, va, qb, ib, f_fwd, f_bwd, gate = jnp.split(p, EVEN_SPLITS, axis=-1)
    oa = merge_heads(neighbourhood_attention(split_heads(qa), split_heads(ka), split_heads(va), rpb, meta_bias))
    ob = hgrn2_bidirectional(qb, ib, f_fwd, f_bwd, lb, norm_gain)
    y = jnp.concatenate([oa, ob], axis=-1) * jax.nn.silu(gate)
    return y @ w_out


def odd_mixer(hn, w_in, w_out, w_short, w1, b1, fr1, w2, b2, fr2, w3, bias):
    p = hn @ w_in
    u, gate = p[..., :3 * HY_WIDTH], p[..., 3 * HY_WIDTH:]
    u = short_conv(u, w_short)
    v, x1, x2 = jnp.split(u, 3, axis=-1)
    filt = hyena_filters(hn.shape[1], w1, b1, fr1, w2, b2, fr2, w3)
    z = v
    for n, x_n in enumerate((x1, x2)):
        z = x_n * long_conv(z, filt[:, :, n], bias[n])
    return (z * jax.nn.silu(gate)) @ w_out


def setup_inputs(seed: int = 0) -> dict:
    key = jax.random.key(seed)
    ks = jax.random.split(key, 21)
    f32 = jnp.float32

    def nrm(k, shape, std):
        return jax.random.normal(k, shape, f32) * std

    return {
        'x': nrm(ks[0], (BATCH, SEQ, D_MODEL), 1.0),
        'meta_tokens': nrm(ks[1], (N_META, D_MODEL), 1.0),
        'norm_pre': 1.0 + nrm(ks[2], (DEPTH, D_MODEL), 0.02),
        'norm_post': 1.0 + nrm(ks[3], (DEPTH, D_MODEL), 0.02),
        'ev_w_in': nrm(ks[4], (N_EVEN, D_MODEL, EVEN_IN), D_MODEL ** -0.5),
        'ev_w_out': nrm(ks[5], (N_EVEN, EVEN_MIX, D_MODEL), EVEN_MIX ** -0.5),
        'na_rpb': nrm(ks[6], (N_EVEN, NA_HEADS, 2 * NA_KH - 1, 2 * NA_KW - 1), 0.02),
        'na_meta_bias': nrm(ks[7], (N_EVEN, NA_HEADS, N_META), 0.02),
        'hg_lower': 1.0 + nrm(ks[8], (N_EVEN, 2, HG_WIDTH), 0.1),
        'hg_norm': 1.0 + nrm(ks[9], (N_EVEN, HG_WIDTH), 0.02),
        'od_w_in': nrm(ks[10], (N_ODD, D_MODEL, ODD_IN), D_MODEL ** -0.5),
        'od_w_out': nrm(ks[11], (N_ODD, HY_WIDTH, D_MODEL), HY_WIDTH ** -0.5),
        'hy_short': nrm(ks[12], (N_ODD, 3 * HY_WIDTH, HY_SHORT), HY_SHORT ** -0.5),
        'hy_ffn_w1': nrm(ks[13], (N_ODD, HY_EMB, HY_FFN), HY_EMB ** -0.5),
        'hy_ffn_b1': nrm(ks[14], (N_ODD, HY_FFN), 0.1),
        'hy_ffn_freq1': 1.0 + nrm(ks[15], (N_ODD, HY_FFN), 0.1),
        'hy_ffn_w2': nrm(ks[16], (N_ODD, HY_FFN, HY_FFN), HY_FFN ** -0.5),
        'hy_ffn_b2': nrm(ks[17], (N_ODD, HY_FFN), 0.1),
        'hy_ffn_freq2': 1.0 + nrm(ks[18], (N_ODD, HY_FFN), 0.1),
        'hy_ffn_w3': nrm(ks[19], (N_ODD, HY_FFN, 2 * HY_ORDER * HY_WIDTH), 0.02),
        'hy_bias': nrm(ks[20], (N_ODD, HY_ORDER, HY_WIDTH), 0.5),
    }


def reference(x, meta_tokens, norm_pre, norm_post, ev_w_in, ev_w_out, na_rpb, na_meta_bias, hg_lower, hg_norm,
              od_w_in, od_w_out, hy_short, hy_ffn_w1, hy_ffn_b1, hy_ffn_freq1, hy_ffn_w2, hy_ffn_b2, hy_ffn_freq2,
              hy_ffn_w3, hy_bias):
    b = x.shape[0]
    lb_all = jnp.cumsum(jax.nn.softmax(hg_lower.astype(jnp.float32), axis=0), axis=0)
    lb_all = lb_all - lb_all[:1]
    meta = jnp.broadcast_to(meta_tokens.astype(x.dtype)[None], (b, N_META, D_MODEL))
    h = jnp.concatenate([meta, x], axis=1)
    for layer in range(DEPTH):
        j = layer // 2
        hn = rms_norm(h, norm_pre[layer])
        if layer % 2 == 0:
            out = even_mixer(hn, ev_w_in[j], ev_w_out[j], na_rpb[j], na_meta_bias[j], lb_all[j], hg_norm[j])
        else:
            out = odd_mixer(hn, od_w_in[j], od_w_out[j], hy_short[j], hy_ffn_w1[j], hy_ffn_b1[j], hy_ffn_freq1[j],
                            hy_ffn_w2[j], hy_ffn_b2[j], hy_ffn_freq2[j], hy_ffn_w3[j], hy_bias[j])
        h = h + rms_norm(out, norm_post[layer])
    return h[:, N_META:]
```

```cpp
#include <hip/hip_runtime.h>
#include <cstdio>
#include <cstdint>
#ifndef MK_PER_PHASE
#define MK_PER_PHASE 1
#endif
#ifndef MK_NLAYERS
#define MK_NLAYERS 4
#endif
#ifndef MK_SANITIZE
#define MK_SANITIZE 0
#endif
#ifndef MK_DBG
#define MK_DBG 0
#endif
namespace pg8 {
#define PG8_LAS __attribute__((address_space(3)))
typedef unsigned short bf16_t;
typedef short bf16x8 __attribute__((ext_vector_type(8)));
typedef float f32x4 __attribute__((ext_vector_type(4)));
typedef unsigned u32x4 __attribute__((ext_vector_type(4)));
constexpr int BM = 256, BK = 64, HALF = 128, HTB = HALF * BK * 2  , STAGE_BYTES = 8 * HTB, NXCD = 8, WGM = 8;

__host__ __device__ __forceinline__ int lds_byte(int r, int c) { const int st = (r >> 4) * 2 + (c >> 5), rr = r & 15, cc = c & 31, ob = rr * 64 + cc * 2; return st * 1024 + (ob ^ (((ob >> 9) & 1) << 5)); }
__host__ __device__ __forceinline__ void stage_rc(int b, int& R, int& C) { const int st = b / 1024, sb = b % 1024, swz = sb ^ (((sb >> 9) & 1) << 5); R = (st >> 1) * 16 + swz / 64; C = (st & 1) * 32 + (swz % 64) / 2; }
__host__ __device__ __forceinline__ int perm32(int rho) { const int n = rho >> 4, i = rho & 15; return 8 * (i >> 2) + 4 * n + (i & 3); }

struct Unit { int pm, pn, kind; };

struct DualOrder {
    const char *A0, *B0, *A1, *B1; int nM0, nN0, n0, nM1, nN1, n1, G, c, skip_lo, skip_n; size_t tstep;
    __device__ void init(const void* a0, const void* b0, int M0, int N0, const void* a1, const void* b1, int M1, int N1, int K, int G_, int c_, int sl, int sn) {
        A0 = (const char*)a0; B0 = (const char*)b0; A1 = (const char*)a1; B1 = (const char*)b1; nM0 = M0 / BM; nN0 = N0 / BM; n0 = nM0 * nN0; nM1 = M1 / BM; nN1 = N1 / BM; n1 = nM1 * nN1;
        G = G_; c = c_; skip_lo = sl; skip_n = sn; tstep = (size_t)BM * K * 2; }
    __device__ bool next(int i, Unit& u) const {
        const long L = (long)i * G + c; const int nwg = n0 + n1; if (L >= nwg) return false;
        int wgid = (int)L; { const int q = nwg / NXCD, r = nwg % NXCD, xcd = wgid % NXCD, off = wgid / NXCD; wgid = (xcd < r ? xcd * (q + 1) : r * (q + 1) + (xcd - r) * q) + off; }
        int nM, nN, kind;
        if (wgid < n0) { nM = nM0; nN = nN0; kind = 0; } else { wgid -= n0; nM = nM1; nN = nN1; kind = 1; }
        const int nig = WGM * nN, gid = wgid / nig, fm = gid * WGM, gsz = (nM - fm) < WGM ? (nM - fm) : WGM;
        u.pm = fm + ((wgid % nig) % gsz); int pn = (wgid % nig) / gsz; if (kind == 0 && pn >= skip_lo) pn += skip_n; u.pn = pn; u.kind = kind; return true;
    }
    __device__ __forceinline__ const char* abase(const Unit& u) const { return (u.kind ? A1 : A0) + (size_t)u.pm * tstep; }
    __device__ __forceinline__ const char* bbase(const Unit& u) const { return (u.kind ? B1 : B0) + (size_t)u.pn * tstep; }
    __device__ __forceinline__ void a_ready(const Unit&) const {}
    __device__ __forceinline__ void done(const Unit&) const {}
};

typedef __bf16 bf16x2_t __attribute__((ext_vector_type(2)));
typedef float f32x2_t __attribute__((ext_vector_type(2)));
__device__ __forceinline__ unsigned cvt_pk_bf16(float lo, float hi) { const f32x2_t v = {lo, hi}; const bf16x2_t b = __builtin_convertvector(v, bf16x2_t); return __builtin_bit_cast(unsigned, b); }

struct EpiF32 {
    static constexpr bool PERM = false, AFTER_DRAIN = false;
    float* C; int ldc;
    __device__ __forceinline__ void operator()(const f32x4 (&acc)[2][2][4][2], const Unit& u, int wr, int wc, int fr, int fq) const {
        const int row0 = u.pm * BM + wr * 64 + fr, col0 = u.pn * BM + wc * 32 + 4 * fq;
#pragma unroll
        for (int ai = 0; ai < 2; ++ai)
#pragma unroll
            for (int m = 0; m < 4; ++m) { float* rowp = C + (size_t)(row0 + ai * HALF + m * 16) * ldc + col0;
#pragma unroll
                for (int bj = 0; bj < 2; ++bj)
#pragma unroll
                    for (int n = 0; n < 2; ++n) *(f32x4*)(rowp + bj * HALF + n * 16) = acc[ai][bj][m][n]; }
    }
};
__device__ __forceinline__ float silu_f(float x) { return x * __builtin_amdgcn_rcpf(1.0f + __expf(-x)); }
struct EpiEvenIn {
    static constexpr bool PERM = true, AFTER_DRAIN = false;
    bf16_t* P; int ldp; bf16_t* VT; int ldv; const float* lb;
    __device__ __forceinline__ void operator()(const f32x4 (&acc)[2][2][4][2], const Unit& u, int wr, int wc, int fr, int fq) const {
        const int row0 = u.pm * BM + wr * 64 + fr; const int col0 = u.pn * BM + wc * 32 + 8 * fq;
        bf16_t* base = u.kind ? VT : P; const int ldc = u.kind ? ldv : ldp;
        const int seg = u.kind ? 1 : (u.pn >> 3);
        const int mode = (seg == 0) ? 1 : (seg == 3) ? 2 : (seg == 5 || seg == 6) ? 3 : (seg >= 7) ? 4 : 0;
        f32x4 lbv[2][2];
#pragma unroll
        for (int bj = 0; bj < 2; ++bj)
#pragma unroll
            for (int n = 0; n < 2; ++n) lbv[bj][n] = (mode == 3) ? *(const f32x4*)(lb + (seg - 5) * 2048 + ((col0 + bj * HALF + 4 * n) & 2047)) : (f32x4){0.f, 0.f, 0.f, 0.f};
#pragma unroll
        for (int ai = 0; ai < 2; ++ai)
#pragma unroll
            for (int m = 0; m < 4; ++m) { bf16_t* rowp = base + (size_t)(row0 + ai * HALF + m * 16) * ldc + col0;
#pragma unroll
                for (int bj = 0; bj < 2; ++bj) { f32x4 v[2] = {acc[ai][bj][m][0], acc[ai][bj][m][1]};
                    if (mode == 1) { v[0] = v[0] * 0.08838834764831845f; v[1] = v[1] * 0.08838834764831845f; }
                    else if (mode == 2) {
#pragma unroll
                        for (int n = 0; n < 2; ++n)
#pragma unroll
                            for (int k = 0; k < 4; ++k) v[n][k] = silu_f(v[n][k]) * 0.08838834764831845f; }
                    else if (mode == 3) {
#pragma unroll
                        for (int n = 0; n < 2; ++n)
#pragma unroll
                            for (int k = 0; k < 4; ++k) { const float x = fminf(fmaxf(v[n][k], -80.f), 80.f); const float sg = __builtin_amdgcn_rcpf(1.0f + __expf(-x)); const float l0 = lbv[bj][n][k];
                                v[n][k] = __logf(l0 + (1.0f - l0) * sg); } }
                    else if (mode == 4) {
#pragma unroll
                        for (int n = 0; n < 2; ++n)
#pragma unroll
                            for (int k = 0; k < 4; ++k) v[n][k] = silu_f(v[n][k]); }
                    u32x4 w; w.x = cvt_pk_bf16(v[0][0], v[0][1]); w.y = cvt_pk_bf16(v[0][2], v[0][3]); w.z = cvt_pk_bf16(v[1][0], v[1][1]); w.w = cvt_pk_bf16(v[1][2], v[1][3]);
                    *(u32x4*)(rowp + bj * HALF) = w; } }
    }
};
struct EpiOddIn {
    static constexpr bool PERM = true, AFTER_DRAIN = false;
    bf16_t* O; int ldc; int gate_pm0;
    __device__ __forceinline__ void operator()(const f32x4 (&acc)[2][2][4][2], const Unit& u, int wr, int wc, int fr, int fq) const {
        const int row0 = u.pm * BM + wr * 64 + fr; const int col0 = u.pn * BM + wc * 32 + 8 * fq; const bool gate = u.pm >= gate_pm0;
#pragma unroll
        for (int ai = 0; ai < 2; ++ai)
#pragma unroll
            for (int m = 0; m < 4; ++m) { bf16_t* rowp = O + (size_t)(row0 + ai * HALF + m * 16) * ldc + col0;
#pragma unroll
                for (int bj = 0; bj < 2; ++bj) { f32x4 v[2] = {acc[ai][bj][m][0], acc[ai][bj][m][1]};
                    if (gate) {
#pragma unroll
                        for (int n = 0; n < 2; ++n)
#pragma unroll
                            for (int k = 0; k < 4; ++k) v[n][k] = silu_f(v[n][k]); }
                    u32x4 w; w.x = cvt_pk_bf16(v[0][0], v[0][1]); w.y = cvt_pk_bf16(v[0][2], v[0][3]); w.z = cvt_pk_bf16(v[1][0], v[1][1]); w.w = cvt_pk_bf16(v[1][2], v[1][3]);
                    *(u32x4*)(rowp + bj * HALF) = w; } }
    }
};
template <class Epi, class Sched, bool ALIGN_EPI = false, bool SP2 = false>
__device__ __forceinline__ void gemm_phase(PG8_LAS unsigned char* lds, const int K, const Sched& S, const Epi& E) {
    int tid = threadIdx.x; asm volatile("" : "+v"(tid));
    const int wid = __builtin_amdgcn_readfirstlane(tid >> 6), lane = tid & 63, wr = wid >> 2, wc = wid & 3, fr = lane & 15, fq = lane >> 4;
    const int nt = K / BK;
    unsigned voffA[2], voffB[2];
#pragma unroll
    for (int i = 0; i < 2; ++i) { int R, C; stage_rc(tid * 16 + i * 8192, R, C); const int Rb = Epi::PERM ? ((R & ~31) + perm32(R & 31)) : R;
        voffA[i] = (unsigned)(R * K + C) * 2u; voffB[i] = (unsigned)(Rb * K + C) * 2u; }
    const size_t kstep = (size_t)(BK * 2);
    const size_t hstep = (size_t)HALF * K * 2;
    const size_t tstep = 2 * hstep;
    const unsigned ldsw = (unsigned)wid * 1024u;
    const int aoff = lds_byte(wr * 64 + fr, fq * 8), boff = lds_byte(wc * 32 + fr, fq * 8);
#define PG8_SA(b, h) (((b) * 2 + (h)) * HTB)
#define PG8_SB(b, h) ((4 + (b) * 2 + (h)) * HTB)
#define PG8_STAGE(bufoff, gbase, voff) do { _Pragma("unroll") for (int _i = 0; _i < 2; ++_i) \
        __builtin_amdgcn_global_load_lds((const unsigned*)((const char*)(gbase) + (voff)[_i]), (PG8_LAS unsigned*)(lds + (bufoff) + ldsw + _i * 8192), 16, 0, 0); } while (0)
#define PG8_LDA(dst, b, h) do { _Pragma("unroll") for (int m = 0; m < 4; ++m) _Pragma("unroll") for (int k = 0; k < 2; ++k) dst[m][k] = *(const PG8_LAS bf16x8*)(lds + PG8_SA(b, h) + aoff + m * 2048 + k * 1024); } while (0)
#define PG8_LDB(dst, b, h) do { _Pragma("unroll") for (int n = 0; n < 2; ++n) _Pragma("unroll") for (int k = 0; k < 2; ++k) dst[n][k] = *(const PG8_LAS bf16x8*)(lds + PG8_SB(b, h) + boff + n * 2048 + k * 1024); } while (0)
#define PG8_MMA(ai, bj, At, Bt) do { __builtin_amdgcn_s_setprio(1); _Pragma("unroll") for (int m = 0; m < 4; ++m) _Pragma("unroll") for (int n = 0; n < 2; ++n) _Pragma("unroll") for (int k = 0; k < 2; ++k) \
        acc[ai][bj][m][n] = __builtin_amdgcn_mfma_f32_16x16x32_bf16(Bt[n][k], At[m][k], acc[ai][bj][m][n], 0, 0, 0); __builtin_amdgcn_s_setprio(0); } while (0)
#define PG8_WAIT_V(n) asm volatile("s_waitcnt vmcnt(" #n ")" ::: "memory")
#define PG8_WAIT_L(n) asm volatile("s_waitcnt lgkmcnt(" #n ")" ::: "memory")
#define PG8_BAR __builtin_amdgcn_s_barrier()
#define PG8_SCHED __builtin_amdgcn_sched_barrier(0)
    Unit cur, nxt; int ui = 0;
    if (!S.next(0, cur)) return;
    f32x4 acc[2][2][4][2];
#pragma unroll
    for (int a = 0; a < 2; ++a)
#pragma unroll
        for (int b = 0; b < 2; ++b)
#pragma unroll
            for (int m = 0; m < 4; ++m)
#pragma unroll
                for (int n = 0; n < 2; ++n) acc[a][b][m][n] = (f32x4){0.f, 0.f, 0.f, 0.f};
    bf16x8 At[4][2], B0[2][2], B1[2][2];
    const char* cA = S.abase(cur); const char* cB = S.bbase(cur);
    S.a_ready(cur);
    if constexpr (SP2) {
        PG8_STAGE(PG8_SB(0, 0), cB, voffB); PG8_STAGE(PG8_SB(0, 1), cB + hstep, voffB); PG8_STAGE(PG8_SA(0, 0), cA, voffA); PG8_STAGE(PG8_SA(0, 1), cA + hstep, voffA);
        if (wr == 1) PG8_BAR;
        PG8_WAIT_V(2); PG8_BAR;
        PG8_STAGE(PG8_SB(1, 0), cB + kstep, voffB); PG8_STAGE(PG8_SA(1, 0), cA + kstep, voffA); PG8_STAGE(PG8_SB(1, 1), cB + hstep + kstep, voffB);
        PG8_WAIT_V(6); PG8_BAR;
    } else {
        PG8_STAGE(PG8_SB(0, 0), cB, voffB); PG8_STAGE(PG8_SA(0, 0), cA, voffA); PG8_STAGE(PG8_SB(0, 1), cB + hstep, voffB); PG8_STAGE(PG8_SA(0, 1), cA + hstep, voffA);
        if (wr == 1) PG8_BAR;
        PG8_WAIT_V(4); PG8_BAR;
        PG8_STAGE(PG8_SB(1, 0), cB + kstep, voffB); PG8_STAGE(PG8_SA(1, 0), cA + kstep, voffA); PG8_STAGE(PG8_SB(1, 1), cB + hstep + kstep, voffB);
        PG8_WAIT_V(6); PG8_BAR;
    }
    for (;;) {
        const bool has_next = S.next(ui + 1, nxt);
        const char* nA = has_next ? S.abase(nxt) : cA; const char* nB = has_next ? S.bbase(nxt) : cB;
        for (int t = 0; t < nt; t += 2) {
            const bool last = (t == nt - 2);
            const char* a1 = cA + (size_t)(t + 1) * kstep;
            const char* a2 = last ? nA : cA + (size_t)(t + 2) * kstep; const char* b2 = last ? nB : cB + (size_t)(t + 2) * kstep;
            const char* a3 = a2 + kstep; const char* b3 = b2 + kstep;
            if (last && has_next) S.a_ready(nxt);
            if constexpr (SP2) {
            PG8_LDB(B0, 0, 0); PG8_LDB(B1, 0, 1); PG8_SCHED; PG8_LDA(At, 0, 0); PG8_STAGE(PG8_SA(1, 1), a1 + hstep, voffA);
            PG8_WAIT_V(8); PG8_WAIT_L(0); PG8_BAR; PG8_MMA(0, 0, At, B0); PG8_MMA(0, 1, At, B1); PG8_BAR; PG8_SCHED;
            PG8_LDA(At, 0, 1); PG8_STAGE(PG8_SB(0, 0), b2, voffB); PG8_STAGE(PG8_SB(0, 1), b2 + hstep, voffB); PG8_STAGE(PG8_SA(0, 0), a2, voffA);
            PG8_WAIT_V(8); PG8_WAIT_L(0); PG8_BAR; PG8_MMA(1, 0, At, B0); PG8_MMA(1, 1, At, B1); PG8_BAR; PG8_SCHED;
            PG8_LDB(B0, 1, 0); PG8_LDB(B1, 1, 1); PG8_SCHED; PG8_LDA(At, 1, 0); PG8_STAGE(PG8_SA(0, 1), a2 + hstep, voffA);
            PG8_WAIT_V(8); PG8_WAIT_L(0); PG8_BAR; PG8_MMA(0, 0, At, B0); PG8_MMA(0, 1, At, B1); PG8_BAR; PG8_SCHED;
            PG8_LDA(At, 1, 1); PG8_STAGE(PG8_SB(1, 0), b3, voffB); PG8_STAGE(PG8_SB(1, 1), b3 + hstep, voffB); PG8_STAGE(PG8_SA(1, 0), a3, voffA);
            PG8_WAIT_V(8); PG8_WAIT_L(0); PG8_BAR; PG8_MMA(1, 0, At, B0); PG8_MMA(1, 1, At, B1); PG8_BAR; PG8_SCHED;
            } else {
            PG8_LDB(B0, 0, 0); PG8_SCHED; PG8_LDA(At, 0, 0); PG8_STAGE(PG8_SA(1, 1), a1 + hstep, voffA);
            PG8_WAIT_L(8); PG8_BAR; PG8_WAIT_L(0); PG8_MMA(0, 0, At, B0); PG8_BAR; PG8_SCHED;
            PG8_LDB(B1, 0, 1); PG8_STAGE(PG8_SB(0, 0), b2, voffB);
            PG8_BAR; PG8_WAIT_L(0); PG8_MMA(0, 1, At, B1); PG8_BAR;
            PG8_LDA(At, 0, 1); PG8_STAGE(PG8_SA(0, 0), a2, voffA);
            PG8_BAR; PG8_WAIT_L(0); PG8_MMA(1, 0, At, B0); PG8_BAR; PG8_SCHED;
            PG8_STAGE(PG8_SB(0, 1), b2 + hstep, voffB);
            PG8_WAIT_V(6); PG8_BAR; PG8_MMA(1, 1, At, B1); PG8_BAR;
            PG8_LDB(B0, 1, 0); PG8_SCHED; PG8_LDA(At, 1, 0); PG8_STAGE(PG8_SA(0, 1), a2 + hstep, voffA);
            PG8_WAIT_L(8); PG8_BAR; PG8_WAIT_L(0); PG8_MMA(0, 0, At, B0); PG8_BAR; PG8_SCHED;
            PG8_LDB(B1, 1, 1); PG8_STAGE(PG8_SB(1, 0), b3, voffB);
            PG8_BAR; PG8_WAIT_L(0); PG8_MMA(0, 1, At, B1); PG8_BAR;
            PG8_LDA(At, 1, 1); PG8_STAGE(PG8_SA(1, 0), a3, voffA);
            PG8_BAR; PG8_WAIT_L(0); PG8_MMA(1, 0, At, B0); PG8_BAR; PG8_SCHED;
            PG8_STAGE(PG8_SB(1, 1), b3 + hstep, voffB);
            PG8_WAIT_V(6); PG8_BAR; PG8_MMA(1, 1, At, B1); PG8_BAR;
            }
        }
        if constexpr (ALIGN_EPI) { if (wr == 0) PG8_BAR; }
        if constexpr (!Epi::AFTER_DRAIN) { E(acc, cur, wr, wc, fr, fq); S.done(cur); }
        if (!has_next) break;
#pragma unroll
        for (int a = 0; a < 2; ++a)
#pragma unroll
            for (int b = 0; b < 2; ++b)
#pragma unroll
                for (int m = 0; m < 4; ++m)
#pragma unroll
                    for (int n = 0; n < 2; ++n) acc[a][b][m][n] = (f32x4){0.f, 0.f, 0.f, 0.f};
        cur = nxt; cA = nA; cB = nB; ++ui;
        if constexpr (ALIGN_EPI) { if (wr == 1) PG8_BAR; }
    }
    PG8_WAIT_V(0);
    if constexpr (!ALIGN_EPI) { if (wr == 0) PG8_BAR; }
    PG8_BAR;

#undef PG8_SA
#undef PG8_SB
#undef PG8_STAGE
#undef PG8_LDA
#undef PG8_LDB
#undef PG8_MMA
#undef PG8_WAIT_V
#undef PG8_WAIT_L
#undef PG8_BAR
#undef PG8_SCHED
}
}
constexpr int NB = 2, T = 4096, NMETA = 16, L = T + NMETA, D = 4096;
constexpr int MV = NB * L;
constexpr int MP = 8448;
constexpr int EIN = 18432, OIN = 16384, HD = 128;
constexpr int QA_OFF = 0, KA_OFF = 2048, QB_OFF = 6144, IB_OFF = 8192, FF_OFF = 10240, FB_OFF = 12288, GATE_OFF = 14336;
constexpr int KOFF = 4128, KLEN = 8256;
constexpr int LPAD = 4128;
constexpr float EPS = 1e-6f;
constexpr int NWAVES = 8, NTHR = 512;
constexpr int NPHASE = 22;

constexpr size_t MiB = 1u << 20;
constexpr size_t WS_CTL = 0, CTL_ZERO_BYTES = 1 * MiB;
constexpr size_t WS_WEIN = 1 * MiB;
constexpr size_t WS_WEOUT = WS_WEIN + 2 * (size_t)EIN * D * 2;
constexpr size_t WS_WOIN = WS_WEOUT + 2 * (size_t)D * D * 2;
constexpr size_t WS_WOOUT = WS_WOIN + 2 * (size_t)OIN * D * 2;
constexpr size_t WS_H = WS_WOOUT + 2 * (size_t)D * D * 2;
constexpr size_t WS_HN = WS_H + (size_t)MP * D * 4;
constexpr size_t WS_P = WS_HN + (size_t)MP * D * 2;
constexpr size_t WS_VT = WS_P + (size_t)MP * EIN * 2;
constexpr size_t WS_Y = WS_VT + (size_t)2048 * MP * 2;
constexpr size_t WS_YT = WS_Y + (size_t)MP * D * 2;
constexpr size_t WS_OBP = WS_YT + (size_t)MP * D * 2;
constexpr size_t WS_OUT = WS_OBP + (size_t)2 * MP * 2048 * 4;
constexpr size_t WS_KT = WS_OUT + (size_t)MP * D * 4;
constexpr size_t WS_HID2 = WS_KT + (size_t)2 * 2 * 4096 * KLEN * 2;
constexpr size_t WS_LB = WS_HID2 + (size_t)2 * LPAD * 64 * 2;
constexpr size_t WS_END = WS_LB + (size_t)2 * 2 * 2048 * 4;
static_assert(WS_WEIN % 256 == 0 && WS_H % 256 == 0 && WS_P % 256 == 0 && WS_KT % 256 == 0 && WS_HID2 % 256 == 0 && WS_LB % 256 == 0, "alignment");
constexpr int CW_BAR = 4096;

constexpr int LDS_BYTES = 147456;
constexpr int MISC_OFF = 146432;

#define LAS __attribute__((address_space(3)))
typedef unsigned short bf16_t;
typedef short bf16x8 __attribute__((ext_vector_type(8)));
typedef short bf16x4 __attribute__((ext_vector_type(4)));
typedef float f32x4 __attribute__((ext_vector_type(4)));
typedef float f32x16 __attribute__((ext_vector_type(16)));
typedef unsigned u32x4 __attribute__((ext_vector_type(4)));
typedef unsigned u32x2 __attribute__((ext_vector_type(2)));
#define LDS_WAIT() asm volatile("s_waitcnt lgkmcnt(0)" ::: "memory")
#define VM_WAIT() asm volatile("s_waitcnt vmcnt(0)" ::: "memory")
__device__ __forceinline__ unsigned f2bf(float f) { return pg8::cvt_pk_bf16(f, 0.f) & 0xffffu; }
__device__ __forceinline__ unsigned pk2(float lo, float hi) { return pg8::cvt_pk_bf16(lo, hi); }
__device__ __forceinline__ float bflo(unsigned w) { return __builtin_bit_cast(float, w << 16); }
__device__ __forceinline__ float bfhi(unsigned w) { return __builtin_bit_cast(float, w & 0xffff0000u); }
__device__ __forceinline__ float bf1(bf16_t w) { return __builtin_bit_cast(float, ((unsigned)w) << 16); }
__device__ __forceinline__ float wave_sum(float v) {
#pragma unroll
    for (int o = 1; o < 64; o <<= 1) v += __shfl_xor(v, o);
    return v;
}

#define XB_TMO      128
#define XB_XCNT(j)  (256  + 64 * (j))
#define XB_XSUB(j)  (1280 + 64 * (j))
#define XB_XGEN(j)  (2304 + 64 * (j))
#define XB_TOP      3328
#define XB_TOPGEN   3392
#define XCD_BAR_WORDS 3456
#define XB_SPIN_CAP (1u << 20)
__device__ __forceinline__ unsigned xb_ld(unsigned* p)              { return __hip_atomic_load(p, __ATOMIC_RELAXED, __HIP_MEMORY_SCOPE_AGENT); }
__device__ __forceinline__ unsigned xb_add(unsigned* p, unsigned v) { return __hip_atomic_fetch_add(p, v, __ATOMIC_RELAXED, __HIP_MEMORY_SCOPE_AGENT); }
__device__ __forceinline__ unsigned xb_xcc_id() { return (unsigned)__builtin_amdgcn_s_getreg((3 << 11) | 20) & 0xFu; }
#define XB_SPIN(cond, bar) do { unsigned _sp = 0; while (cond) { __builtin_amdgcn_s_sleep(1); \
    if ((++_sp & 255u) == 0u) { if (xb_ld(&(bar)[XB_TMO])) break; if (_sp > XB_SPIN_CAP) { atomicAdd(&(bar)[XB_TMO], 1u); break; } } } } while (0)
struct XcdBarrier { unsigned* bar; unsigned x; volatile LAS unsigned* st; };
__device__ __forceinline__ XcdBarrier xcd_barrier_post(unsigned* bar, volatile LAS unsigned* st) {
    XcdBarrier b; b.bar = bar; b.x = xb_xcc_id(); b.st = st;
    if (threadIdx.x == 0) (void)xb_add(&bar[XB_XCNT(b.x)], 1u);
    return b;
}
__device__ __forceinline__ void xcd_barrier_complete(unsigned* bar, unsigned x, unsigned& nloc, unsigned& nx) {
    const unsigned G = gridDim.x * gridDim.y * gridDim.z;
    unsigned sum, cnt, mine, sp = 0u;
    for (;;) {
        sum = 0u; cnt = 0u; mine = 0u;
#pragma unroll
        for (unsigned j = 0; j < 16; ++j) { const unsigned c = xb_ld(&bar[XB_XCNT(j)]); sum += c; cnt += (c > 0u) ? 1u : 0u; mine = (j == x) ? c : mine; }
        if (sum == G) break;
        __builtin_amdgcn_s_sleep(1);
        if ((++sp & 255u) == 0u) { if (xb_ld(&bar[XB_TMO])) break; if (sp > XB_SPIN_CAP) { atomicAdd(&bar[XB_TMO], 1u); break; } }
    }
    nloc = mine > 0u ? mine : 1u; nx = cnt > 0u ? cnt : 1u;
}
__device__ __forceinline__ void xcd_barrier(const XcdBarrier& b) {
    asm volatile("s_waitcnt vmcnt(0)" ::: "memory");
    __syncthreads();
    if (threadIdx.x == 0) {
        unsigned* bar = b.bar;
        __builtin_amdgcn_s_waitcnt(0);
        unsigned nloc = b.st[0], nx = b.st[1];
        if (nloc == 0u) { xcd_barrier_complete(bar, b.x, nloc, nx); b.st[0] = nloc; b.st[1] = nx; }
        const unsigned old = xb_add(&bar[XB_XSUB(b.x)], 1u);
        const unsigned gen = old / nloc;
        if (old + 1u == (gen + 1u) * nloc) {
            __builtin_amdgcn_fence(__ATOMIC_RELEASE, "agent");
            asm volatile("s_waitcnt vmcnt(0)" ::: "memory");
            const unsigned og = xb_add(&bar[XB_TOP], 1u);
            const unsigned tg = og / nx;
            if (og + 1u == (tg + 1u) * nx) xb_add(&bar[XB_TOPGEN], 1u);
            else XB_SPIN(xb_ld(&bar[XB_TOPGEN]) == tg, bar);
            __builtin_amdgcn_fence(__ATOMIC_ACQUIRE, "agent");
            xb_add(&bar[XB_XGEN(b.x)], 1u);
            asm volatile("s_waitcnt vmcnt(0)" ::: "memory");
        } else {
            XB_SPIN(xb_ld(&bar[XB_XGEN(b.x)]) == gen, bar);
            __builtin_amdgcn_fence(__ATOMIC_ACQUIRE, "agent");
            asm volatile("s_waitcnt vmcnt(0)" ::: "memory");
        }
    }
    __syncthreads();
}

struct Params { const float* in[21]; float* out; unsigned char* ws; int ph_lo, ph_hi; };
enum { I_X = 0, I_META, I_NPRE, I_NPOST, I_EWIN, I_EWOUT, I_RPB, I_MBIAS, I_HGLOW, I_HGNORM, I_OWIN, I_OWOUT, I_HYSHORT, I_W1, I_B1, I_FR1, I_W2, I_B2, I_FR2, I_W3, I_HYBIAS };
__device__ __forceinline__ void p0_transpose_item(const float* W, int K, int N, bf16_t* WT, LAS float* scr, int item, int lane) {
    const int nblk = N / 32, kb = item / nblk, nb = item % nblk, k0 = 64 * kb, n0 = 32 * nb;
#pragma unroll 8
    for (int i = 0; i < 32; ++i) { const int kk = 2 * i + (lane >> 5); scr[kk * 33 + (lane & 31)] = W[(size_t)(k0 + kk) * N + n0 + (lane & 31)]; }
    LDS_WAIT(); asm volatile("" ::: "memory");
    const int c = lane & 7;
#pragma unroll
    for (int j = 0; j < 4; ++j) { const int n = (lane >> 3) + 8 * j; const LAS float* s = scr + (8 * c) * 33 + n;
        u32x4 o; o.x = pk2(s[0 * 33], s[1 * 33]); o.y = pk2(s[2 * 33], s[3 * 33]); o.z = pk2(s[4 * 33], s[5 * 33]); o.w = pk2(s[6 * 33], s[7 * 33]);
        *(u32x4*)(WT + (size_t)(n0 + n) * K + k0 + 8 * c) = o; }
    LDS_WAIT(); asm volatile("" ::: "memory");
}
__device__ __forceinline__ void rms_row_to_bf16(const f32x4 (&v)[16], const float* g, bf16_t* orow, int lane) {
    float s = 0.f;
#pragma unroll
    for (int j = 0; j < 16; ++j) s += (v[j].x * v[j].x + v[j].y * v[j].y) + (v[j].z * v[j].z + v[j].w * v[j].w);
    const float rstd = 1.0f / sqrtf(wave_sum(s) * (1.0f / D) + EPS);
    const f32x4* g4 = (const f32x4*)g + lane; u32x2* o8 = (u32x2*)orow + lane;
#pragma unroll
    for (int j = 0; j < 16; ++j) { const f32x4 gg = g4[64 * j]; u32x2 w; w.x = pk2(v[j].x * rstd * gg.x, v[j].y * rstd * gg.y); w.y = pk2(v[j].z * rstd * gg.z, v[j].w * rstd * gg.w); o8[64 * j] = w; }
}
__device__ __forceinline__ void phase_prologue(const Params& p, LAS unsigned char* lds, int gw, int NGW, int wave, int lane) {
    unsigned char* ws = p.ws;
    LAS float* scr = (LAS float*)(lds + wave * 16384);
    constexpr int I_EIN = (D / 64) * (EIN / 32), I_SQ = (D / 64) * (D / 32), I_OIN = (D / 64) * (OIN / 32), I_LAYER = I_EIN + 2 * I_SQ + I_OIN;
    for (int it = gw; it < 2 * I_LAYER; it += NGW) {
        const int j = it / I_LAYER; int r = it % I_LAYER;
        if (r < I_EIN) { p0_transpose_item(p.in[I_EWIN] + (size_t)j * D * EIN, D, EIN, (bf16_t*)(ws + WS_WEIN) + (size_t)j * EIN * D, scr, r, lane); continue; } r -= I_EIN;
        if (r < I_SQ) { p0_transpose_item(p.in[I_EWOUT] + (size_t)j * D * D, D, D, (bf16_t*)(ws + WS_WEOUT) + (size_t)j * D * D, scr, r, lane); continue; } r -= I_SQ;
        if (r < I_OIN) { p0_transpose_item(p.in[I_OWIN] + (size_t)j * D * OIN, D, OIN, (bf16_t*)(ws + WS_WOIN) + (size_t)j * OIN * D, scr, r, lane); continue; } r -= I_OIN;
        p0_transpose_item(p.in[I_OWOUT] + (size_t)j * D * D, D, D, (bf16_t*)(ws + WS_WOOUT) + (size_t)j * D * D, scr, r, lane);
    }
    float* H = (float*)(ws + WS_H); bf16_t* HN = (bf16_t*)(ws + WS_HN);
    for (int m = gw; m < MP; m += NGW) {
        f32x4 v[16];
        if (m < MV) {
            const float* src = (m < NB * T) ? p.in[I_X] + (size_t)m * D : p.in[I_META] + (size_t)((m - NB * T) & 15) * D;
#pragma unroll
            for (int j = 0; j < 16; ++j) v[j] = ((const f32x4*)src)[lane + 64 * j];
#pragma unroll
            for (int j = 0; j < 16; ++j) ((f32x4*)(H + (size_t)m * D))[lane + 64 * j] = v[j];
            rms_row_to_bf16(v, p.in[I_NPRE], HN + (size_t)m * D, lane);
        } else {
#pragma unroll
            for (int j = 0; j < 16; ++j) ((u32x2*)(HN + (size_t)m * D))[lane + 64 * j] = (u32x2){0u, 0u};
        }
    }
    { float* LB = (float*)(ws + WS_LB); const float* hl = p.in[I_HGLOW];
      for (int i = gw * 64 + lane; i < 2 * 2048; i += NGW * 64) { LB[i] = 0.f; LB[4096 + i] = 1.0f / (1.0f + __expf(hl[i] - hl[4096 + i])); } }
    { bf16_t* HID2 = (bf16_t*)(ws + WS_HID2);
      for (int it = gw; it < 2 * LPAD; it += NGW) {
        const int jl = it / LPAD, l = it % LPAD; float h2 = 0.f;
        if (l < L) {
            float z = 0.f;
            if (lane == 0) z = (float)l * (1.0f / (float)(L - 1));
            else if (lane < 33) { const int k = (lane - 1) & 15; const float band = 1e-4f + (float)k * ((15.0f - 1e-4f) / 15.0f); float rev = band * ((float)l / (float)L); rev -= floorf(rev);
                z = (lane < 17) ? __builtin_amdgcn_cosf(rev) : -__builtin_amdgcn_sinf(rev); }
            const float* w1 = p.in[I_W1] + (size_t)jl * 33 * 64; const float* w2 = p.in[I_W2] + (size_t)jl * 64 * 64;
            float a = p.in[I_B1][jl * 64 + lane];
#pragma unroll
            for (int i = 0; i < 33; ++i) a += __shfl(z, i) * w1[i * 64 + lane];
            const float h1 = __sinf(p.in[I_FR1][jl * 64 + lane] * a);
            float a2 = p.in[I_B2][jl * 64 + lane];
#pragma unroll 16
            for (int i = 0; i < 64; ++i) a2 += __shfl(h1, i) * w2[i * 64 + lane];
            h2 = __sinf(p.in[I_FR2][jl * 64 + lane] * a2);
        }
        HID2[(size_t)it * 64 + lane] = (bf16_t)f2bf(h2);
      } }
}

__device__ __forceinline__ void phase_filtergen(const Params& p, int gw, int NGW, int lane) {
    unsigned char* ws = p.ws; const bf16_t* HID2 = (const bf16_t*)(ws + WS_HID2); bf16_t* KT = (bf16_t*)(ws + WS_KT);
    const int r32 = lane & 31, h = lane >> 5;
    for (int wi = gw; wi < 2048; wi += NGW) {
        const int lpart = wi & 3, cb = (wi >> 2) & 127, n = (wi >> 9) & 1, jl = wi >> 10; const int c0 = cb * 32;
        const float* w3 = p.in[I_W3] + (size_t)jl * 64 * 16384;
        bf16x8 A[2][4];
#pragma unroll
        for (int dir = 0; dir < 2; ++dir)
#pragma unroll
            for (int st = 0; st < 4; ++st) { const float* src = w3 + (size_t)(16 * st + 8 * h) * 16384 + (dir * 2 + n) * 4096 + c0 + r32;
                u32x4 w; w.x = pk2(src[0], src[16384]); w.y = pk2(src[2 * 16384], src[3 * 16384]); w.z = pk2(src[4 * 16384], src[5 * 16384]); w.w = pk2(src[6 * 16384], src[7 * 16384]);
                A[dir][st] = __builtin_bit_cast(bf16x8, w); }
        const int lb0 = lpart * 33, lb1 = (lb0 + 33 < 129) ? lb0 + 33 : 129;
        for (int lb = lb0; lb < lb1; ++lb) {
            const int l = lb * 32 + r32;
            f32x16 acc0, acc1;
#pragma unroll
            for (int i = 0; i < 16; ++i) { acc0[i] = 0.f; acc1[i] = 0.f; }
#pragma unroll
            for (int st = 0; st < 4; ++st) { const bf16x8 B = *(const bf16x8*)(HID2 + ((size_t)jl * LPAD + l) * 64 + 16 * st + 8 * h);
                acc0 = __builtin_amdgcn_mfma_f32_32x32x16_bf16(A[0][st], B, acc0, 0, 0, 0); acc1 = __builtin_amdgcn_mfma_f32_32x32x16_bf16(A[1][st], B, acc1, 0, 0, 0); }
            const float tl = (float)l * (1.0f / (float)(L - 1));
#pragma unroll
            for (int reg = 0; reg < 16; ++reg) { const int c = c0 + (reg & 3) + 8 * (reg >> 2) + 4 * h;
                const float delta = 3.0701134f + (15.350567f - 3.0701134f) * ((float)c * (1.0f / 4095.0f)); const float wdw = __expf(-tl * delta);
                bf16_t* R = KT + ((size_t)(jl * 2 + n) * 4096 + c) * KLEN; const float v0 = acc0[reg] * wdw, v1 = acc1[reg] * wdw;
                if (l == 0) R[KOFF] = (bf16_t)f2bf(v0 + v1); else { R[KOFF - l] = (bf16_t)f2bf(v0); R[KOFF + l] = (bf16_t)f2bf(v1); } }
        }
        if (lpart == 3 && lane < 32) KT[((size_t)(jl * 2 + n) * 4096 + c0 + lane) * KLEN] = 0;
    }
}
constexpr int HG_QM = 0, HG_KM = 17408, HG_QS = 34816, HG_KST = 52224, HG_VT = 70656, HG_STB = 75264, HG_TOT = 92672, HG_DEC = 100864, HG_END = 101376;
__device__ __forceinline__ int hg_row(int dir, int b, int ci, int tau) {
    if (dir == 0) { if (ci == 0) return tau < 16 ? 8192 + 16 * b + tau : -1; return b * 4096 + 64 * (ci - 1) + tau; }
    if (ci == 64) return tau < 16 ? 8192 + 16 * b + 15 - tau : -1;
    return b * 4096 + 4095 - (64 * ci + tau);
}
__device__ __forceinline__ void hgrn_item(const Params& p, LAS unsigned char* lds, int item, int tid, int wave, int lane) {
    const int dvs = item & 3, hd = (item >> 2) & 15, b = (item >> 6) & 1, dir = item >> 7, dv0 = dvs * 32;
    const bf16_t* P = (const bf16_t*)(p.ws + WS_P); float* OBP = (float*)(p.ws + WS_OBP) + (size_t)dir * MP * 2048;
    const int qcol = QB_OFF + hd * 128, vcol = IB_OFF + hd * 128 + dv0, fcol = (dir ? FB_OFF : FF_OFF) + hd * 128;
    const int dg = tid & 31, tg = tid >> 5;
    const int tv = tid >> 3, dvq = tid & 7;
    const int r32 = lane & 31, h = lane >> 5;
    LAS bf16_t* QM = (LAS bf16_t*)(lds + HG_QM); LAS bf16_t* KM = (LAS bf16_t*)(lds + HG_KM); LAS bf16_t* QS = (LAS bf16_t*)(lds + HG_QS);
    LAS bf16_t* KST = (LAS bf16_t*)(lds + HG_KST); LAS bf16_t* VTL = (LAS bf16_t*)(lds + HG_VT); LAS bf16_t* STB = (LAS bf16_t*)(lds + HG_STB);
    LAS float* TOT = (LAS float*)(lds + HG_TOT); LAS float* DEC = (LAS float*)(lds + HG_DEC);
    for (int i = tid; i < 2 * 32 * 136 / 2; i += NTHR) ((LAS unsigned*)STB)[i] = 0u;
    f32x16 st;
#pragma unroll
    for (int i = 0; i < 16; ++i) st[i] = 0.f;
    u32x2 qraw[4], lraw[4], vraw;
    auto load_chunk = [&](int ci) {
#pragma unroll
        for (int i = 0; i < 4; ++i) { const int row = hg_row(dir, b, ci, 4 * tg + i);
            if (row >= 0) { qraw[i] = *(const u32x2*)(P + (size_t)row * EIN + qcol + 4 * dg); lraw[i] = *(const u32x2*)(P + (size_t)row * EIN + fcol + 4 * dg); }
            else { qraw[i] = (u32x2){0u, 0u}; lraw[i] = (u32x2){0u, 0u}; } }
        { const int row = hg_row(dir, b, ci, tv); vraw = (row >= 0) ? *(const u32x2*)(P + (size_t)row * EIN + vcol + 4 * dvq) : (u32x2){0u, 0u}; }
    };
    load_chunk(0);
    int cur = 0;
    __syncthreads();
    for (int ci = 0; ci < 65; ++ci) {
        float qs[4][4], lg[4][4];
#pragma unroll
        for (int i = 0; i < 4; ++i) { qs[i][0] = bflo(qraw[i].x); qs[i][1] = bfhi(qraw[i].x); qs[i][2] = bflo(qraw[i].y); qs[i][3] = bfhi(qraw[i].y);
            lg[i][0] = bflo(lraw[i].x); lg[i][1] = bfhi(lraw[i].x); lg[i][2] = bflo(lraw[i].y); lg[i][3] = bfhi(lraw[i].y); }
        float kk[4][4];
#pragma unroll
        for (int i = 0; i < 4; ++i)
#pragma unroll
            for (int k = 0; k < 4; ++k) kk[i][k] = 1.0f - __expf(lg[i][k]);
        float cs[4][4];
#pragma unroll
        for (int k = 0; k < 4; ++k) { cs[0][k] = lg[0][k]; cs[1][k] = cs[0][k] + lg[1][k]; cs[2][k] = cs[1][k] + lg[2][k]; cs[3][k] = cs[2][k] + lg[3][k]; }
        *(LAS f32x4*)(TOT + tg * 128 + 4 * dg) = (f32x4){cs[3][0], cs[3][1], cs[3][2], cs[3][3]};
        { const float v0 = bflo(vraw.x), v1 = bfhi(vraw.x), v2 = bflo(vraw.y), v3 = bfhi(vraw.y);
          VTL[(4 * dvq + 0) * 72 + tv] = (bf16_t)f2bf(v0); VTL[(4 * dvq + 1) * 72 + tv] = (bf16_t)f2bf(v1); VTL[(4 * dvq + 2) * 72 + tv] = (bf16_t)f2bf(v2); VTL[(4 * dvq + 3) * 72 + tv] = (bf16_t)f2bf(v3); }
        __syncthreads();
        f32x4 pre = (f32x4){0.f, 0.f, 0.f, 0.f}, mid = pre, end = pre;
#pragma unroll
        for (int g = 0; g < 16; ++g) { const f32x4 t4 = *(const LAS f32x4*)(TOT + g * 128 + 4 * dg); if (g < tg) pre += t4; if (g < 8) mid += t4; end += t4; }
        if (ci + 1 < 65) load_chunk(ci + 1);
#pragma unroll
        for (int k = 0; k < 4; ++k) {
            const float emid = __expf(mid[k]), eem = __expf(end[k] - mid[k]);
            float ksv[4];
#pragma unroll
            for (int i = 0; i < 4; ++i) { const float G = pre[k] + cs[i][k]; const float e1 = __expf(G - mid[k]), e2 = __expf(mid[k] - G);
                const float qm = qs[i][k] * e1, km = kk[i][k] * e2; const int tau = 4 * tg + i, d = 4 * dg + k;
                QM[tau * 136 + d] = (bf16_t)f2bf(qm); KM[tau * 136 + d] = (bf16_t)f2bf(km); QS[tau * 136 + d] = (bf16_t)f2bf(qm * emid); ksv[i] = km * eem; }
            u32x2 w; w.x = pk2(ksv[0], ksv[1]); w.y = pk2(ksv[2], ksv[3]);
            *(LAS u32x2*)(KST + (4 * dg + k) * 72 + 4 * tg) = w;
            if (tg == 0) DEC[4 * dg + k] = emid * eem;
        }
        __syncthreads();
        if (wave < 2) {
            const int tb = wave;
            f32x16 accO;
#pragma unroll
            for (int i = 0; i < 16; ++i) accO[i] = 0.f;
            for (int sb = 0; sb <= tb; ++sb) {
                f32x16 s;
#pragma unroll
                for (int i = 0; i < 16; ++i) s[i] = 0.f;
#pragma unroll
                for (int stp = 0; stp < 8; ++stp) { const bf16x8 a = *(const LAS bf16x8*)(KM + (32 * sb + r32) * 136 + 16 * stp + 8 * h); const bf16x8 bq = *(const LAS bf16x8*)(QM + (32 * tb + r32) * 136 + 16 * stp + 8 * h);
                    s = __builtin_amdgcn_mfma_f32_32x32x16_bf16(a, bq, s, 0, 0, 0); }
                if (sb == tb) {
#pragma unroll
                    for (int reg = 0; reg < 16; ++reg) { const int sl = (reg & 3) + 8 * (reg >> 2) + 4 * h; if (sl > r32) s[reg] = 0.f; }
                }
#pragma unroll
                for (int st2 = 0; st2 < 2; ++st2) {
                    u32x4 pw; pw.x = pk2(s[8 * st2 + 0], s[8 * st2 + 1]); pw.y = pk2(s[8 * st2 + 2], s[8 * st2 + 3]); pw.z = pk2(s[8 * st2 + 4], s[8 * st2 + 5]); pw.w = pk2(s[8 * st2 + 6], s[8 * st2 + 7]);
                    const LAS bf16_t* vp = VTL + r32 * 72 + 32 * sb + 16 * st2 + 4 * h;
                    const u32x2 a0 = *(const LAS u32x2*)vp, a1 = *(const LAS u32x2*)(vp + 8);
                    const u32x4 aw = (u32x4){a0.x, a0.y, a1.x, a1.y};
                    accO = __builtin_amdgcn_mfma_f32_32x32x16_bf16(__builtin_bit_cast(bf16x8, aw), __builtin_bit_cast(bf16x8, pw), accO, 0, 0, 0);
                }
            }
            const LAS bf16_t* sbp = STB + cur * (32 * 136);
#pragma unroll
            for (int stp = 0; stp < 8; ++stp) { const bf16x8 a = *(const LAS bf16x8*)(sbp + r32 * 136 + 16 * stp + 8 * h); const bf16x8 bq = *(const LAS bf16x8*)(QS + (32 * tb + r32) * 136 + 16 * stp + 8 * h);
                accO = __builtin_amdgcn_mfma_f32_32x32x16_bf16(a, bq, accO, 0, 0, 0); }
            const int row = hg_row(dir, b, ci, 32 * tb + r32);
            if (row >= 0) { float* op = OBP + (size_t)row * 2048 + hd * 128 + dv0 + 4 * h;
#pragma unroll
                for (int g4 = 0; g4 < 4; ++g4) *(f32x4*)(op + 8 * g4) = (f32x4){accO[4 * g4], accO[4 * g4 + 1], accO[4 * g4 + 2], accO[4 * g4 + 3]}; }
        } else if (wave < 6) {
            const int db = wave - 2; const float dec = DEC[32 * db + r32];
#pragma unroll
            for (int i = 0; i < 16; ++i) st[i] *= dec;
#pragma unroll
            for (int stp = 0; stp < 4; ++stp) { const bf16x8 a = *(const LAS bf16x8*)(VTL + r32 * 72 + 16 * stp + 8 * h); const bf16x8 bk = *(const LAS bf16x8*)(KST + (32 * db + r32) * 72 + 16 * stp + 8 * h);
                st = __builtin_amdgcn_mfma_f32_32x32x16_bf16(a, bk, st, 0, 0, 0); }
            LAS bf16_t* sbn = STB + (cur ^ 1) * (32 * 136);
#pragma unroll
            for (int reg = 0; reg < 16; ++reg) { const int dvl = (reg & 3) + 8 * (reg >> 2) + 4 * h; sbn[dvl * 136 + 32 * db + r32] = (bf16_t)f2bf(st[reg]); }
        }
        cur ^= 1;
        __syncthreads();
    }
}

typedef float f32x4v __attribute__((ext_vector_type(4)));
__device__ __forceinline__ void natten_item(const Params& p, int item, int jl, int lane) {
    const bf16_t* P = (const bf16_t*)(p.ws + WS_P); const bf16_t* VT = (const bf16_t*)(p.ws + WS_VT); bf16_t* Y = (bf16_t*)(p.ws + WS_Y);
    const bool ismeta = item >= 8192;
    int b, hd, r, j;
    if (ismeta) { const int t = item - 8192; b = t >> 4; hd = t & 15; r = 0; j = 0; } else { j = item & 3; r = (item >> 2) & 63; hd = (item >> 8) & 15; b = item >> 12; }
    const int q16 = lane & 15, h4 = lane >> 4;
    const int qrow = ismeta ? 8192 + 16 * b + q16 : b * 4096 + 64 * r + 16 * j + q16;
    const int kw0 = (j == 0) ? 0 : (j == 1) ? 8 : (j == 2) ? 24 : 32;
    const int r0 = (r - 4 < 0) ? 0 : ((r - 4 > 56) ? 56 : r - 4);
    const float* rpb = p.in[I_RPB] + ((size_t)jl * 16 + hd) * 15 * 31; const float* mb = p.in[I_MBIAS] + ((size_t)jl * 16 + hd) * 16;
    bf16x8 QF[4];
#pragma unroll
    for (int stp = 0; stp < 4; ++stp) QF[stp] = *(const bf16x8*)(P + (size_t)qrow * EIN + QA_OFF + hd * 128 + 32 * stp + 8 * h4);
    f32x4 S[17];
    auto tokbase = [&](int kt) -> int { if (kt == 0) return 8192 + 16 * b; const int i = (kt - 1) >> 1, half = (kt - 1) & 1; return b * 4096 + 64 * (r0 + i) + kw0 + 16 * half; };
#pragma unroll
    for (int kt = 0; kt < 17; ++kt) {
        const int krow = tokbase(kt) + q16; f32x4 s = (f32x4){0.f, 0.f, 0.f, 0.f};
#pragma unroll
        for (int stp = 0; stp < 4; ++stp) { const bf16x8 a = *(const bf16x8*)(P + (size_t)krow * EIN + KA_OFF + hd * 128 + 32 * stp + 8 * h4);
            s = __builtin_amdgcn_mfma_f32_16x16x32_bf16(a, QF[stp], s, 0, 0, 0); }
        S[kt] = s;
    }
    const int qc = 16 * j + q16; const int c0 = (qc - 8 < 0) ? 0 : ((qc - 8 > 48) ? 48 : qc - 8);
    float mx = -3.0e38f;
#pragma unroll
    for (int reg = 0; reg < 4; ++reg) { S[0][reg] += mb[4 * h4 + reg]; mx = fmaxf(mx, S[0][reg]); }
#pragma unroll
    for (int kt = 1; kt < 17; ++kt) { const int i = (kt - 1) >> 1, half = (kt - 1) & 1;
#pragma unroll
        for (int reg = 0; reg < 4; ++reg) { const int kc = kw0 + 16 * half + 4 * h4 + reg; const bool ok = !ismeta && kc >= c0 && kc < c0 + 16;
            int ci = kc - qc + 15; ci = ci < 0 ? 0 : (ci > 30 ? 30 : ci);
            const float bias = rpb[((r0 + i) - r + 7) * 31 + ci];
            const float v = ok ? S[kt][reg] + bias : -3.0e38f; S[kt][reg] = v; mx = fmaxf(mx, v); } }
    mx = fmaxf(mx, __shfl_xor(mx, 16)); mx = fmaxf(mx, __shfl_xor(mx, 32));
    float sum = 0.f;
#pragma unroll
    for (int kt = 0; kt < 17; ++kt)
#pragma unroll
        for (int reg = 0; reg < 4; ++reg) { const float e = (S[kt][reg] > -1.0e38f) ? __expf(S[kt][reg] - mx) : 0.f; S[kt][reg] = e; sum += e; }
    sum += __shfl_xor(sum, 16); sum += __shfl_xor(sum, 32);
    const float inv = 1.0f / sum;
    f32x4 O[8];
#pragma unroll
    for (int dt = 0; dt < 8; ++dt) O[dt] = (f32x4){0.f, 0.f, 0.f, 0.f};
#pragma unroll
    for (int u = 0; u < 9; ++u) {
        const int k0t = 2 * u, k1t = 2 * u + 1;
        u32x4 pw; pw.x = pk2(S[k0t][0], S[k0t][1]); pw.y = pk2(S[k0t][2], S[k0t][3]);
        if (k1t < 17) { pw.z = pk2(S[k1t][0], S[k1t][1]); pw.w = pk2(S[k1t][2], S[k1t][3]); } else { pw.z = 0u; pw.w = 0u; }
        const int tb0 = tokbase(k0t) + 4 * h4, tb1 = (k1t < 17) ? tokbase(k1t) + 4 * h4 : tb0;
#pragma unroll
        for (int dt = 0; dt < 8; ++dt) { const bf16_t* vr = VT + (size_t)(hd * 128 + 16 * dt + q16) * MP;
            const u32x2 a0 = *(const u32x2*)(vr + tb0), a1 = *(const u32x2*)(vr + tb1);
            const u32x4 aw = (u32x4){a0.x, a0.y, a1.x, a1.y};
            O[dt] = __builtin_amdgcn_mfma_f32_16x16x32_bf16(__builtin_bit_cast(bf16x8, aw), __builtin_bit_cast(bf16x8, pw), O[dt], 0, 0, 0); }
    }
#pragma unroll
    for (int dt = 0; dt < 8; ++dt) { const int col = hd * 128 + 16 * dt + 4 * h4;
        const u32x2 g = *(const u32x2*)(P + (size_t)qrow * EIN + GATE_OFF + col);
        u32x2 w; w.x = pk2(O[dt][0] * inv * bflo(g.x), O[dt][1] * inv * bfhi(g.x)); w.y = pk2(O[dt][2] * inv * bflo(g.y), O[dt][3] * inv * bfhi(g.y));
        *(u32x2*)(Y + (size_t)qrow * D + col) = w; }
}
__device__ __forceinline__ void phase_combine(const Params& p, int jl, int gw, int NGW, int lane) {
    const float* OB0 = (const float*)(p.ws + WS_OBP); const float* OB1 = OB0 + (size_t)MP * 2048; const bf16_t* P = (const bf16_t*)(p.ws + WS_P); bf16_t* Y = (bf16_t*)(p.ws + WS_Y);
    const float* gain = p.in[I_HGNORM] + (size_t)jl * 2048;
    for (int m = gw; m < MV; m += NGW) {
        f32x4 o[8]; float ss = 0.f;
#pragma unroll
        for (int k = 0; k < 8; ++k) { o[k] = *(const f32x4*)(OB0 + (size_t)m * 2048 + 32 * lane + 4 * k) + *(const f32x4*)(OB1 + (size_t)m * 2048 + 32 * lane + 4 * k);
            ss += (o[k].x * o[k].x + o[k].y * o[k].y) + (o[k].z * o[k].z + o[k].w * o[k].w); }
        ss += __shfl_xor(ss, 1); ss += __shfl_xor(ss, 2);
        const float rstd = 1.0f / sqrtf(ss * (1.0f / 128.0f) + EPS);
#pragma unroll
        for (int k2 = 0; k2 < 4; ++k2) { const u32x4 g = *(const u32x4*)(P + (size_t)m * EIN + GATE_OFF + 2048 + 32 * lane + 8 * k2);
            const f32x4 ga = *(const f32x4*)(gain + 32 * lane + 8 * k2), gb = *(const f32x4*)(gain + 32 * lane + 8 * k2 + 4); const f32x4 a = o[2 * k2], bq = o[2 * k2 + 1];
            u32x4 w; w.x = pk2(a.x * rstd * ga.x * bflo(g.x), a.y * rstd * ga.y * bfhi(g.x)); w.y = pk2(a.z * rstd * ga.z * bflo(g.y), a.w * rstd * ga.w * bfhi(g.y));
            w.z = pk2(bq.x * rstd * gb.x * bflo(g.z), bq.y * rstd * gb.y * bfhi(g.z)); w.w = pk2(bq.z * rstd * gb.z * bflo(g.w), bq.w * rstd * gb.w * bfhi(g.w));
            *(u32x4*)(Y + (size_t)m * D + 2048 + 32 * lane + 8 * k2) = w; }
    }
}
__device__ __forceinline__ void phase_postnorm(const Params& p, int layer, int gw, int NGW, int lane) {
    const float* OUT = (const float*)(p.ws + WS_OUT); float* H = (float*)(p.ws + WS_H); bf16_t* HN = (bf16_t*)(p.ws + WS_HN);
    const float* gpost = p.in[I_NPOST] + (size_t)layer * D; const bool last = (layer == MK_NLAYERS - 1); const float* gpre = p.in[I_NPRE] + (size_t)(last ? 0 : layer + 1) * D;
    for (int m = gw; m < MV; m += NGW) {
        if (last && m >= NB * T) continue;
        f32x4 o[16]; float ss = 0.f;
#pragma unroll
        for (int j = 0; j < 16; ++j) { o[j] = ((const f32x4*)(OUT + (size_t)m * D))[lane + 64 * j]; ss += (o[j].x * o[j].x + o[j].y * o[j].y) + (o[j].z * o[j].z + o[j].w * o[j].w); }
        const float rstd = 1.0f / sqrtf(wave_sum(ss) * (1.0f / D) + EPS);
        f32x4 hv[16];
#pragma unroll
        for (int j = 0; j < 16; ++j) { const f32x4 g = ((const f32x4*)gpost)[lane + 64 * j]; hv[j] = ((const f32x4*)(H + (size_t)m * D))[lane + 64 * j] + o[j] * rstd * g; }
        if (last) {
#pragma unroll
            for (int j = 0; j < 16; ++j) {
#if MK_SANITIZE
                for (int k = 0; k < 4; ++k) if (!(fabsf(hv[j][k]) < 1e30f)) hv[j][k] = 0.f;
#endif
                ((f32x4*)(p.out + (size_t)m * D))[lane + 64 * j] = hv[j]; }
        } else {
#pragma unroll
            for (int j = 0; j < 16; ++j) ((f32x4*)(H + (size_t)m * D))[lane + 64 * j] = hv[j];
            rms_row_to_bf16(hv, gpre, HN + (size_t)m * D, lane);
        }
    }
}
constexpr int LC_KCS = 16704;
constexpr int LC_KC = 0, LC_U1 = 4 * LC_KCS  , LC_US = 20480, LC_U2 = LC_U1 + LC_US, LC_X1 = LC_U2 + LC_US  , LC_XS = 16512, LC_X2 = LC_X1 + LC_XS, LC_TAIL = LC_X2 + LC_XS  , LC_END = LC_TAIL + 256;
static_assert(LC_END <= MISC_OFF, "long-conv LDS map");
__device__ __forceinline__ int lc_ugran(int b, int G) { return b * 10240 + (G & 3) * 2560 + (G >> 2) * 16; }
__device__ __forceinline__ int lc_tokrow(int b, int l) { return l < 16 ? 8192 + 16 * b + l : b * 4096 + l - 16; }
__device__ __forceinline__ void lc_shortconv(const bf16_t* urow, int b, int gl, float w0, float w1, float w2, float (&o)[8]) {
    const int l0 = 8 * gl; const int r0 = lc_tokrow(b, l0);
    const u32x4 raw = *(const u32x4*)(urow + r0);
    float x[10];
    x[1] = bflo(raw.x); x[2] = bfhi(raw.x); x[3] = bflo(raw.y); x[4] = bfhi(raw.y); x[5] = bflo(raw.z); x[6] = bfhi(raw.z); x[7] = bflo(raw.w); x[8] = bfhi(raw.w);
    x[0] = (l0 > 0) ? bf1(urow[lc_tokrow(b, l0 - 1)]) : 0.f;
    x[9] = (l0 + 8 < L) ? bf1(urow[lc_tokrow(b, l0 + 8)]) : 0.f;
#pragma unroll
    for (int k = 0; k < 8; ++k) o[k] = w0 * x[k] + w1 * x[k + 1] + w2 * x[k + 2];
}
__device__ __forceinline__ void lc_stage_filter(const bf16_t* krow, LAS unsigned char* lds, int tid) {
    for (int m = tid; m < KLEN / 8; m += NTHR) {
        const u32x4 a = *(const u32x4*)(krow + 8 * m); const u32x4 bq = (m + 1 < KLEN / 8) ? *(const u32x4*)(krow + 8 * m + 8) : (u32x4){0u, 0u, 0u, 0u};
        const unsigned w[6] = {a.x, a.y, a.z, a.w, bq.x, bq.y};
        *(LAS u32x4*)(lds + LC_KC + 0 * LC_KCS + 16 * m) = a;
        *(LAS u32x4*)(lds + LC_KC + 1 * LC_KCS + 16 * m) = (u32x4){__builtin_amdgcn_alignbit(w[1], w[0], 16), __builtin_amdgcn_alignbit(w[2], w[1], 16), __builtin_amdgcn_alignbit(w[3], w[2], 16), __builtin_amdgcn_alignbit(w[4], w[3], 16)};
        *(LAS u32x4*)(lds + LC_KC + 2 * LC_KCS + 16 * m) = (u32x4){w[1], w[2], w[3], w[4]};
        *(LAS u32x4*)(lds + LC_KC + 3 * LC_KCS + 16 * m) = (u32x4){__builtin_amdgcn_alignbit(w[2], w[1], 16), __builtin_amdgcn_alignbit(w[3], w[2], 16), __builtin_amdgcn_alignbit(w[4], w[3], 16), __builtin_amdgcn_alignbit(w[5], w[4], 16)};
    }
}
__device__ __forceinline__ void lc_conv(LAS unsigned char* lds, int uin_off, int wave, int lane, f32x16& accm) {
    const int g = wave; const int i32 = lane & 31, h = lane >> 5, n16 = lane & 15, b = (lane >> 4) & 1;
    const int e0 = 32 * g - 257;
    const int p0 = KOFF - 16 * e0 - i32 + 8 * h; const int cc = p0 & 3; const int q0 = p0 - cc;
    const LAS unsigned char* kp = lds + LC_KC + cc * LC_KCS + 2 * q0;
    const int I = 16 * g + n16;
    const int G0 = 4 * I - 2 * e0 + h + 60, G1 = G0 - 2;
    const LAS unsigned char* up0 = lds + uin_off + lc_ugran(b, G0); const LAS unsigned char* up1 = lds + uin_off + lc_ugran(b, G1);
    f32x16 acc0, acc1;
#pragma unroll
    for (int r = 0; r < 16; ++r) { acc0[r] = 0.f; acc1[r] = 0.f; }
#pragma unroll 4
    for (int k = 0; k < 144; ++k) {
        const u32x2 a00 = *(const LAS u32x2*)(kp - 64 * k), a01 = *(const LAS u32x2*)(kp - 64 * k + 8);
        const u32x2 a10 = *(const LAS u32x2*)(kp - 64 * k - 32), a11 = *(const LAS u32x2*)(kp - 64 * k - 32 + 8);
        const bf16x8 b0 = *(const LAS bf16x8*)(up0 - 16 * k), b1 = *(const LAS bf16x8*)(up1 - 16 * k);
        acc0 = __builtin_amdgcn_mfma_f32_32x32x16_bf16(__builtin_bit_cast(bf16x8, (u32x4){a00.x, a00.y, a01.x, a01.y}), b0, acc0, 0, 0, 0);
        acc1 = __builtin_amdgcn_mfma_f32_32x32x16_bf16(__builtin_bit_cast(bf16x8, (u32x4){a10.x, a10.y, a11.x, a11.y}), b1, acc1, 0, 0, 0);
    }
    accm = acc0 + acc1;
    {
        const int h4 = lane >> 4; f32x4 t = (f32x4){0.f, 0.f, 0.f, 0.f};
        const int s_lo = 17 * wave, s_hi = (s_lo + 17 < 129) ? s_lo + 17 : 129;
        const int pt = 32 - n16 + 8 * h4; const int ct = pt & 3; const LAS unsigned char* kt = lds + LC_KC + ct * LC_KCS + 2 * (pt - ct);
        const LAS unsigned char* ut = lds + uin_off + (n16 & 1) * 10240 + h4 * 2560 + 16 * 15;
        for (int s = s_lo; s < s_hi; ++s) {
            const u32x2 a0 = *(const LAS u32x2*)(kt + 64 * s), a1 = *(const LAS u32x2*)(kt + 64 * s + 8);
            u32x4 bw = *(const LAS u32x4*)(ut + 16 * s); if (n16 >= 2) bw = (u32x4){0u, 0u, 0u, 0u};
            t = __builtin_amdgcn_mfma_f32_16x16x32_bf16(__builtin_bit_cast(bf16x8, (u32x4){a0.x, a0.y, a1.x, a1.y}), __builtin_bit_cast(bf16x8, bw), t, 0, 0, 0);
        }
        if (n16 < 2) { LAS float* tl = (LAS float*)(lds + LC_TAIL) + n16 * 16 + 4 * h4;
#pragma unroll
            for (int r = 0; r < 4; ++r) (void)__hip_atomic_fetch_add(tl + r, t[r], __ATOMIC_RELAXED, __HIP_MEMORY_SCOPE_WORKGROUP); }
    }
}
__device__ __forceinline__ void phase_longconv(const Params& p, LAS unsigned char* lds, int jl, int vcu, int G, int tid, int wave, int lane) {
    const bf16_t* UT = (const bf16_t*)(p.ws + WS_P); bf16_t* YT = (bf16_t*)(p.ws + WS_YT); const bf16_t* KT = (const bf16_t*)(p.ws + WS_KT);
    const float* wsh = p.in[I_HYSHORT] + (size_t)jl * 3 * 4096 * 3; const float* hb = p.in[I_HYBIAS] + (size_t)jl * 2 * 4096;
    for (int i = tid; i < 2 * LC_US / 16; i += NTHR) *(LAS u32x4*)(lds + LC_U1 + 16 * i) = (u32x4){0u, 0u, 0u, 0u};
    __syncthreads();
    const int i32 = lane & 31, h = lane >> 5, n16 = lane & 15, bl = (lane >> 4) & 1;
    for (int c = vcu; c < 4096; c += G) {
        const bf16_t* vrow = UT + (size_t)c * MP; const bf16_t* x1row = UT + (size_t)(4096 + c) * MP; const bf16_t* x2row = UT + (size_t)(8192 + c) * MP; const bf16_t* grow = UT + (size_t)(12288 + c) * MP;
        const float bias0 = hb[c], bias1 = hb[4096 + c];
        for (int it = tid; it < 2 * 514; it += NTHR) {
            const int b = it / 514, gl = it % 514; float o[8];
            lc_shortconv(vrow, b, gl, wsh[c * 3 + 0], wsh[c * 3 + 1], wsh[c * 3 + 2], o);
            *(LAS u32x4*)(lds + LC_U1 + lc_ugran(b, gl + 60)) = (u32x4){pk2(o[0], o[1]), pk2(o[2], o[3]), pk2(o[4], o[5]), pk2(o[6], o[7])};
            lc_shortconv(x1row, b, gl, wsh[(4096 + c) * 3 + 0], wsh[(4096 + c) * 3 + 1], wsh[(4096 + c) * 3 + 2], o);
            *(LAS u32x4*)(lds + LC_X1 + b * 8224 + 16 * gl) = (u32x4){pk2(o[0], o[1]), pk2(o[2], o[3]), pk2(o[4], o[5]), pk2(o[6], o[7])};
            lc_shortconv(x2row, b, gl, wsh[(8192 + c) * 3 + 0], wsh[(8192 + c) * 3 + 1], wsh[(8192 + c) * 3 + 2], o);
            *(LAS u32x4*)(lds + LC_X2 + b * 8224 + 16 * gl) = (u32x4){pk2(o[0], o[1]), pk2(o[2], o[3]), pk2(o[4], o[5]), pk2(o[6], o[7])};
        }
        lc_stage_filter(KT + ((size_t)(jl * 2 + 0) * 4096 + c) * KLEN, lds, tid);
        if (tid < 32) ((LAS float*)(lds + LC_TAIL))[tid] = 0.f;
        __syncthreads();
        f32x16 acc;
        lc_conv(lds, LC_U1, wave, lane, acc);
        __syncthreads();
        {
            const int I = 16 * wave + n16;
#pragma unroll
            for (int rg = 0; rg < 4; ++rg) { const int t = 32 * I + 8 * rg + 4 * h; const int G8 = (t + 480) >> 3; const int uoff = lc_ugran(bl, G8) + 2 * (t & 7);
                const u32x2 uu = *(const LAS u32x2*)(lds + LC_U1 + uoff); const u32x2 xx = *(const LAS u32x2*)(lds + LC_X1 + bl * 8224 + 2 * t);
                const float z0 = bflo(xx.x) * (acc[4 * rg + 0] + bias0 * bflo(uu.x)), z1 = bfhi(xx.x) * (acc[4 * rg + 1] + bias0 * bfhi(uu.x));
                const float z2 = bflo(xx.y) * (acc[4 * rg + 2] + bias0 * bflo(uu.y)), z3 = bfhi(xx.y) * (acc[4 * rg + 3] + bias0 * bfhi(uu.y));
                *(LAS u32x2*)(lds + LC_U2 + uoff) = (u32x2){pk2(z0, z1), pk2(z2, z3)}; }
            if (tid < 32) { const int b = tid >> 4, i = tid & 15, t = 4096 + i; const int uoff = lc_ugran(b, (t + 480) >> 3) + 2 * (t & 7);
                const float u = bf1(*(const LAS bf16_t*)(lds + LC_U1 + uoff)), x = bf1(*(const LAS bf16_t*)(lds + LC_X1 + b * 8224 + 2 * t));
                const float y = ((LAS float*)(lds + LC_TAIL))[b * 16 + i];
                *(LAS bf16_t*)(lds + LC_U2 + uoff) = (bf16_t)f2bf(x * (y + bias0 * u)); }
        }
        __syncthreads();
        lc_stage_filter(KT + ((size_t)(jl * 2 + 1) * 4096 + c) * KLEN, lds, tid);
        if (tid < 32) ((LAS float*)(lds + LC_TAIL))[tid] = 0.f;
        __syncthreads();
        lc_conv(lds, LC_U2, wave, lane, acc);
        __syncthreads();
        {
            const int I = 16 * wave + n16;
#pragma unroll
            for (int rg = 0; rg < 4; ++rg) { const int t = 32 * I + 8 * rg + 4 * h; const int G8 = (t + 480) >> 3; const int uoff = lc_ugran(bl, G8) + 2 * (t & 7);
                const u32x2 zz = *(const LAS u32x2*)(lds + LC_U2 + uoff); const u32x2 xx = *(const LAS u32x2*)(lds + LC_X2 + bl * 8224 + 2 * t);
                const int row = lc_tokrow(bl, t); const u32x2 gg = *(const u32x2*)(grow + row);
                const float o0 = bflo(xx.x) * (acc[4 * rg + 0] + bias1 * bflo(zz.x)) * bflo(gg.x), o1 = bfhi(xx.x) * (acc[4 * rg + 1] + bias1 * bfhi(zz.x)) * bfhi(gg.x);
                const float o2 = bflo(xx.y) * (acc[4 * rg + 2] + bias1 * bflo(zz.y)) * bflo(gg.y), o3 = bfhi(xx.y) * (acc[4 * rg + 3] + bias1 * bfhi(zz.y)) * bfhi(gg.y);
                *(u32x2*)(YT + (size_t)c * MP + row) = (u32x2){pk2(o0, o1), pk2(o2, o3)}; }
            if (tid < 32) { const int b = tid >> 4, i = tid & 15, t = 4096 + i; const int uoff = lc_ugran(b, (t + 480) >> 3) + 2 * (t & 7);
                const float z = bf1(*(const LAS bf16_t*)(lds + LC_U2 + uoff)), x = bf1(*(const LAS bf16_t*)(lds + LC_X2 + b * 8224 + 2 * t));
                const float y = ((LAS float*)(lds + LC_TAIL))[b * 16 + i]; const int row = lc_tokrow(b, t);
                YT[(size_t)c * MP + row] = (bf16_t)f2bf(x * (y + bias1 * z) * bf1(grow[row])); }
        }
        __syncthreads();
    }
}
__device__ __forceinline__ void phase_transpose(const Params& p, LAS unsigned char* lds, int gw, int NGW, int wave, int lane) {
    const bf16_t* YT = (const bf16_t*)(p.ws + WS_YT); bf16_t* Y = (bf16_t*)(p.ws + WS_Y);
    LAS bf16_t* tile = (LAS bf16_t*)(lds + wave * 8704);
    constexpr int NTT = MP / 64;
    for (int it = gw; it < (D / 64) * NTT; it += NGW) {
        const int ct = it / NTT, tt = it % NTT; const int c0 = 64 * ct, t0 = 64 * tt;
#pragma unroll
        for (int k = 0; k < 8; ++k) { const int cl = 8 * k + (lane >> 3), ch = lane & 7; const u32x4 v = *(const u32x4*)(YT + (size_t)(c0 + cl) * MP + t0 + 8 * ch);
            LAS unsigned* d = (LAS unsigned*)(tile + cl * 68 + 8 * ch); d[0] = v.x; d[1] = v.y; d[2] = v.z; d[3] = v.w; }
        LDS_WAIT(); asm volatile("" ::: "memory");
#pragma unroll
        for (int k = 0; k < 8; ++k) { const int tl = 8 * k + (lane >> 3), ch = lane & 7; const LAS bf16_t* s = tile + (8 * ch) * 68 + tl;
            u32x4 o; o.x = (unsigned)s[0] | ((unsigned)s[68] << 16); o.y = (unsigned)s[2 * 68] | ((unsigned)s[3 * 68] << 16); o.z = (unsigned)s[4 * 68] | ((unsigned)s[5 * 68] << 16); o.w = (unsigned)s[6 * 68] | ((unsigned)s[7 * 68] << 16);
            *(u32x4*)(Y + (size_t)(t0 + tl) * D + c0 + 8 * ch) = o; }
        LDS_WAIT(); asm volatile("" ::: "memory");
    }
}
#define GEMM_ALIGN true
#define GEMM_SP2 true
__global__ void __launch_bounds__(NTHR, 2) mk_fwd(Params p) {
    extern __shared__ __attribute__((aligned(16))) unsigned char lds_raw[];
    LAS unsigned char* lds = (LAS unsigned char*)lds_raw;
    volatile LAS unsigned* MISC = (volatile LAS unsigned*)(lds + MISC_OFF);
    const int tid = threadIdx.x, lane = tid & 63, wave = __builtin_amdgcn_readfirstlane(tid >> 6);
    const int G = gridDim.x; const int bx = blockIdx.x; const int vcu = (G % 8 == 0) ? (bx % 8) * (G / 8) + bx / 8 : bx;
    const int gw = vcu * NWAVES + wave, NGW = G * NWAVES;
    unsigned char* ws = p.ws;
    for (int u = tid; u < (LDS_BYTES - MISC_OFF) / 4; u += NTHR) MISC[u] = 0u;
    __syncthreads();
    XcdBarrier bar; bar.bar = (unsigned*)(ws + WS_CTL) + CW_BAR; bar.x = 0; bar.st = nullptr;
#if !MK_PER_PHASE
    bar = xcd_barrier_post((unsigned*)(ws + WS_CTL) + CW_BAR, MISC);
#endif
    const int lo = p.ph_lo, hi = p.ph_hi;
#define FRESH() int tid_ = threadIdx.x; asm volatile("" : "+v"(tid_)); const int lane_ = tid_ & 63, wave_ = __builtin_amdgcn_readfirstlane(tid_ >> 6); \
    int vcu_ = vcu; asm volatile("" : "+s"(vcu_)); const int gw_ = vcu_ * NWAVES + wave_; Params q = p; { unsigned char* w_ = q.ws; asm volatile("" : "+s"(w_)); q.ws = w_; } unsigned char* ws_ = q.ws; (void)lane_; (void)gw_; (void)ws_;
#define IN(k) (lo <= (k) && (k) < hi)
#if MK_PER_PHASE
#define SEAM(k) do { } while (0)
#else
#define SEAM(k) do { if (IN(k) && IN((k) + 1)) xcd_barrier(bar); } while (0)
#endif
    if (IN(0)) { FRESH() phase_prologue(q, lds, gw_, NGW, wave_, lane_); } SEAM(0);
    if (IN(1)) { FRESH() phase_filtergen(q, gw_, NGW, lane_); } SEAM(1);
    for (int jp = 0; jp < 2; ++jp) {
        const int pb = 2 + 10 * jp;
        if (IN(pb + 0)) { FRESH() const bf16_t* HN = (const bf16_t*)(ws_ + WS_HN);
            const bf16_t* W = (const bf16_t*)(ws_ + WS_WEIN) + (size_t)jp * EIN * D;
            pg8::DualOrder S; S.init(HN, W, MP, EIN - 2048, W + (size_t)4096 * D, HN, 2048, MP, D, G, bx, 16, 8);
            pg8::EpiEvenIn E{(bf16_t*)(ws_ + WS_P), EIN, (bf16_t*)(ws_ + WS_VT), MP, (const float*)(ws_ + WS_LB) + (size_t)jp * 4096};
            pg8::gemm_phase<pg8::EpiEvenIn, pg8::DualOrder, GEMM_ALIGN, GEMM_SP2>(lds, D, S, E);
        } SEAM(pb + 0);
        if (IN(pb + 1)) { FRESH()
#if MK_DBG == 1
            { const u32x4* s = (const u32x4*)(ws_ + WS_HN); u32x4* d = (u32x4*)(ws_ + WS_Y); for (size_t i = (size_t)bx * NTHR + tid_; i < (size_t)MP * D / 8; i += (size_t)G * NTHR) d[i] = s[i]; }
#else
#if MK_DBG == 4
            { const bf16_t* Pd = (const bf16_t*)(ws_ + WS_P); float* O0 = (float*)(ws_ + WS_OBP); float* O1 = O0 + (size_t)MP * 2048;
              for (size_t i = (size_t)bx * NTHR + tid_; i < (size_t)MV * 2048; i += (size_t)G * NTHR) { const size_t r = i / 2048, c = i % 2048;
                O0[r * 2048 + c] = bf1(Pd[r * EIN + QB_OFF + c]) + bf1(Pd[r * EIN + IB_OFF + c]); O1[r * 2048 + c] = bf1(Pd[r * EIN + FF_OFF + c]) + bf1(Pd[r * EIN + FB_OFF + c]); } }
#elif MK_DBG != 2
            for (int item = bx; item < 256; item += G) hgrn_item(q, lds, item, tid_, wave_, lane_);
#endif
#if MK_DBG != 3 && MK_DBG != 4
            for (int it = gw_; it < 8192 + 32; it += NGW) natten_item(q, it, jp, lane_);
#endif
#endif
        } SEAM(pb + 1);
        if (IN(pb + 2)) { FRESH()
#if MK_DBG == 0
            phase_combine(q, jp, gw_, NGW, lane_);
#elif MK_DBG == 2
            { bf16_t* Yd = (bf16_t*)(ws_ + WS_Y); for (size_t i = (size_t)bx * NTHR + tid_; i < (size_t)MP * 256; i += (size_t)G * NTHR) { const size_t r = i / 256, c8 = i % 256; *(u32x4*)(Yd + r * D + 2048 + 8 * c8) = (u32x4){0u, 0u, 0u, 0u}; } }
#elif MK_DBG == 3 || MK_DBG == 4
            phase_combine(q, jp, gw_, NGW, lane_);
            { bf16_t* Yd = (bf16_t*)(ws_ + WS_Y); for (size_t i = (size_t)bx * NTHR + tid_; i < (size_t)MP * 256; i += (size_t)G * NTHR) { const size_t r = i / 256, c8 = i % 256; *(u32x4*)(Yd + r * D + 8 * c8) = (u32x4){0u, 0u, 0u, 0u}; } }
#endif
        } SEAM(pb + 2);
        if (IN(pb + 3)) { FRESH()
            pg8::DualOrder S; S.init(ws_ + WS_Y, (const bf16_t*)(ws_ + WS_WEOUT) + (size_t)jp * D * D, MP, D, nullptr, nullptr, 0, 0, D, G, bx, 1 << 30, 0);
            pg8::EpiF32 E{(float*)(ws_ + WS_OUT), D};
            pg8::gemm_phase<pg8::EpiF32, pg8::DualOrder, GEMM_ALIGN, GEMM_SP2>(lds, D, S, E);
        } SEAM(pb + 3);
        if (IN(pb + 4)) { FRESH() phase_postnorm(q, 2 * jp, gw_, NGW, lane_); } SEAM(pb + 4);
        if (IN(pb + 5)) { FRESH() const bf16_t* HN = (const bf16_t*)(ws_ + WS_HN);
            pg8::DualOrder S; S.init((const bf16_t*)(ws_ + WS_WOIN) + (size_t)jp * OIN * D, HN, OIN, MP, nullptr, nullptr, 0, 0, D, G, bx, 1 << 30, 0);
            pg8::EpiOddIn E{(bf16_t*)(ws_ + WS_P), MP, 48};
            pg8::gemm_phase<pg8::EpiOddIn, pg8::DualOrder, GEMM_ALIGN, GEMM_SP2>(lds, D, S, E);
        } SEAM(pb + 5);
        if (IN(pb + 6)) { FRESH() phase_longconv(q, lds, jp, vcu_, G, tid_, wave_, lane_); } SEAM(pb + 6);
        if (IN(pb + 7)) { FRESH() phase_transpose(q, lds, gw_, NGW, wave_, lane_); } SEAM(pb + 7);
        if (IN(pb + 8)) { FRESH()
            pg8::DualOrder S; S.init(ws_ + WS_Y, (const bf16_t*)(ws_ + WS_WOOUT) + (size_t)jp * D * D, MP, D, nullptr, nullptr, 0, 0, D, G, bx, 1 << 30, 0);
            pg8::EpiF32 E{(float*)(ws_ + WS_OUT), D};
            pg8::gemm_phase<pg8::EpiF32, pg8::DualOrder, GEMM_ALIGN, GEMM_SP2>(lds, D, S, E);
        } SEAM(pb + 8);
        if (IN(pb + 9)) { FRESH() phase_postnorm(q, 2 * jp + 1, gw_, NGW, lane_); } SEAM(pb + 9);
    }
#undef IN
#undef SEAM
}

extern "C" void kernel_launch(void* const* d_in, const int* in_sizes, int n_in, void* d_out, int out_size, void* d_ws, size_t ws_size, hipStream_t stream) {
    static int grid = 0;
    if (grid == 0) {
        if (n_in != 21 || ws_size < WS_END) { fprintf(stderr, "kernel_launch: expected 21 inputs and >= %zu bytes of workspace; got %d, %zu\n", (size_t)WS_END, n_in, ws_size); grid = -1; return; }
        int dev = 0, cus = 0, per_cu = 0;
        if (hipGetDevice(&dev) != hipSuccess || hipDeviceGetAttribute(&cus, hipDeviceAttributeMultiprocessorCount, dev) != hipSuccess) { grid = -1; return; }
        if (hipFuncSetAttribute((const void*)mk_fwd, hipFuncAttributeMaxDynamicSharedMemorySize, LDS_BYTES) != hipSuccess) { fprintf(stderr, "kernel_launch: hipFuncSetAttribute failed\n"); grid = -1; return; }
        if (hipOccupancyMaxActiveBlocksPerMultiprocessor(&per_cu, (const void*)mk_fwd, NTHR, LDS_BYTES) != hipSuccess || per_cu < 1)
            fprintf(stderr, "kernel_launch: note: occupancy query reports %d workgroups per CU\n", per_cu);
        (void)hipGetLastError();
        grid = cus;
    }
    if (grid < 0) return;
    if (hipMemsetAsync((char*)d_ws + WS_CTL, 0, CTL_ZERO_BYTES, stream) != hipSuccess) return;
    Params a{};
    for (int i = 0; i < 21; ++i) a.in[i] = (const float*)d_in[i];
    a.out = (float*)d_out; a.ws = (unsigned char*)d_ws;
#if MK_PER_PHASE
    for (int ph = 0; ph < 2 + 5 * MK_NLAYERS; ++ph) { a.ph_lo = ph; a.ph_hi = ph + 1; hipLaunchKernelGGL(mk_fwd, dim3(grid), dim3(NTHR), LDS_BYTES, stream, a); }
#else
    a.ph_lo = 0; a.ph_hi = 2 + 5 * MK_NLAYERS; hipLaunchKernelGGL(mk_fwd, dim3(grid), dim3(NTHR), LDS_BYTES, stream, a);
#endif
    const hipError_t le = hipPeekAtLastError();
    if (le != hipSuccess) fprintf(stderr, "kernel_launch: launch failed: %s\n", hipGetErrorName(le));
}
```

```cpp
#include <hip/hip_runtime.h>
#include <cstdio>
#include <cstdint>
#ifndef MK_PER_PHASE
#define MK_PER_PHASE 0
#endif
#ifndef MK_NLAYERS
#define MK_NLAYERS 4
#endif
#ifndef MK_SANITIZE
#define MK_SANITIZE 0
#endif
#ifndef MK_DBG
#define MK_DBG 0
#endif
namespace pg8 {
#define PG8_LAS __attribute__((address_space(3)))
typedef unsigned short bf16_t;
typedef short bf16x8 __attribute__((ext_vector_type(8)));
typedef float f32x4 __attribute__((ext_vector_type(4)));
typedef unsigned u32x4 __attribute__((ext_vector_type(4)));
constexpr int BM = 256, BK = 64, HALF = 128, HTB = HALF * BK * 2  , STAGE_BYTES = 8 * HTB, NXCD = 8, WGM = 8;

__host__ __device__ __forceinline__ int lds_byte(int r, int c) { const int st = (r >> 4) * 2 + (c >> 5), rr = r & 15, cc = c & 31, ob = rr * 64 + cc * 2; return st * 1024 + (ob ^ (((ob >> 9) & 1) << 5)); }
__host__ __device__ __forceinline__ void stage_rc(int b, int& R, int& C) { const int st = b / 1024, sb = b % 1024, swz = sb ^ (((sb >> 9) & 1) << 5); R = (st >> 1) * 16 + swz / 64; C = (st & 1) * 32 + (swz % 64) / 2; }
__host__ __device__ __forceinline__ int perm32(int rho) { const int n = rho >> 4, i = rho & 15; return 8 * (i >> 2) + 4 * n + (i & 3); }

struct Unit { int pm, pn, kind; };

struct DualOrder {
    const char *A0, *B0, *A1, *B1; int nM0, nN0, n0, nM1, nN1, n1, G, c, skip_lo, skip_n; size_t tstep;
    __device__ void init(const void* a0, const void* b0, int M0, int N0, const void* a1, const void* b1, int M1, int N1, int K, int G_, int c_, int sl, int sn) {
        A0 = (const char*)a0; B0 = (const char*)b0; A1 = (const char*)a1; B1 = (const char*)b1; nM0 = M0 / BM; nN0 = N0 / BM; n0 = nM0 * nN0; nM1 = M1 / BM; nN1 = N1 / BM; n1 = nM1 * nN1;
        G = G_; c = c_; skip_lo = sl; skip_n = sn; tstep = (size_t)BM * K * 2; }
    __device__ bool next(int i, Unit& u) const {
        const long L = (long)i * G + c; const int nwg = n0 + n1; if (L >= nwg) return false;
        int wgid = (int)L; { const int q = nwg / NXCD, r = nwg % NXCD, xcd = wgid % NXCD, off = wgid / NXCD; wgid = (xcd < r ? xcd * (q + 1) : r * (q + 1) + (xcd - r) * q) + off; }
        int nM, nN, kind;
        if (wgid < n0) { nM = nM0; nN = nN0; kind = 0; } else { wgid -= n0; nM = nM1; nN = nN1; kind = 1; }
        const int nig = WGM * nN, gid = wgid / nig, fm = gid * WGM, gsz = (nM - fm) < WGM ? (nM - fm) : WGM;
        u.pm = fm + ((wgid % nig) % gsz); int pn = (wgid % nig) / gsz; if (kind == 0 && pn >= skip_lo) pn += skip_n; u.pn = pn; u.kind = kind; return true;
    }
    __device__ __forceinline__ const char* abase(const Unit& u) const { return (u.kind ? A1 : A0) + (size_t)u.pm * tstep; }
    __device__ __forceinline__ const char* bbase(const Unit& u) const { return (u.kind ? B1 : B0) + (size_t)u.pn * tstep; }
    __device__ __forceinline__ void a_ready(const Unit&) const {}
    __device__ __forceinline__ void done(const Unit&) const {}
};

typedef __bf16 bf16x2_t __attribute__((ext_vector_type(2)));
typedef float f32x2_t __attribute__((ext_vector_type(2)));
__device__ __forceinline__ unsigned cvt_pk_bf16(float lo, float hi) { const f32x2_t v = {lo, hi}; const bf16x2_t b = __builtin_convertvector(v, bf16x2_t); return __builtin_bit_cast(unsigned, b); }

struct EpiF32 {
    static constexpr bool PERM = false, AFTER_DRAIN = false;
    float* C; int ldc;
    __device__ __forceinline__ void operator()(const f32x4 (&acc)[2][2][4][2], const Unit& u, int wr, int wc, int fr, int fq) const {
        const int row0 = u.pm * BM + wr * 64 + fr, col0 = u.pn * BM + wc * 32 + 4 * fq;
#pragma unroll
        for (int ai = 0; ai < 2; ++ai)
#pragma unroll
            for (int m = 0; m < 4; ++m) { float* rowp = C + (size_t)(row0 + ai * HALF + m * 16) * ldc + col0;
#pragma unroll
                for (int bj = 0; bj < 2; ++bj)
#pragma unroll
                    for (int n = 0; n < 2; ++n) *(f32x4*)(rowp + bj * HALF + n * 16) = acc[ai][bj][m][n]; }
    }
};
__device__ __forceinline__ float silu_f(float x) { return x * __builtin_amdgcn_rcpf(1.0f + __expf(-x)); }
struct EpiEvenIn {
    static constexpr bool PERM = true, AFTER_DRAIN = false;
    bf16_t* P; int ldp; bf16_t* VT; int ldv; const float* lb;
    __device__ __forceinline__ void operator()(const f32x4 (&acc)[2][2][4][2], const Unit& u, int wr, int wc, int fr, int fq) const {
        const int row0 = u.pm * BM + wr * 64 + fr; const int col0 = u.pn * BM + wc * 32 + 8 * fq;
        bf16_t* base = u.kind ? VT : P; const int ldc = u.kind ? ldv : ldp;
        const int seg = u.kind ? 1 : (u.pn >> 3);
        const int mode = (seg == 0) ? 1 : (seg == 3) ? 2 : (seg == 5 || seg == 6) ? 3 : (seg >= 7) ? 4 : 0;
        f32x4 lbv[2][2];
#pragma unroll
        for (int bj = 0; bj < 2; ++bj)
#pragma unroll
            for (int n = 0; n < 2; ++n) lbv[bj][n] = (mode == 3) ? *(const f32x4*)(lb + (seg - 5) * 2048 + ((col0 + bj * HALF + 4 * n) & 2047)) : (f32x4){0.f, 0.f, 0.f, 0.f};
#pragma unroll
        for (int ai = 0; ai < 2; ++ai)
#pragma unroll
            for (int m = 0; m < 4; ++m) { bf16_t* rowp = base + (size_t)(row0 + ai * HALF + m * 16) * ldc + col0;
#pragma unroll
                for (int bj = 0; bj < 2; ++bj) { f32x4 v[2] = {acc[ai][bj][m][0], acc[ai][bj][m][1]};
                    if (mode == 1) { v[0] = v[0] * 0.08838834764831845f; v[1] = v[1] * 0.08838834764831845f; }
                    else if (mode == 2) {
#pragma unroll
                        for (int n = 0; n < 2; ++n)
#pragma unroll
                            for (int k = 0; k < 4; ++k) v[n][k] = silu_f(v[n][k]) * 0.08838834764831845f; }
                    else if (mode == 3) {
#pragma unroll
                        for (int n = 0; n < 2; ++n)
#pragma unroll
                            for (int k = 0; k < 4; ++k) { const float x = fminf(fmaxf(v[n][k], -80.f), 80.f); const float sg = __builtin_amdgcn_rcpf(1.0f + __expf(-x)); const float l0 = lbv[bj][n][k];
                                v[n][k] = __logf(l0 + (1.0f - l0) * sg); } }
                    else if (mode == 4) {
#pragma unroll
                        for (int n = 0; n < 2; ++n)
#pragma unroll
                            for (int k = 0; k < 4; ++k) v[n][k] = silu_f(v[n][k]); }
                    u32x4 w; w.x = cvt_pk_bf16(v[0][0], v[0][1]); w.y = cvt_pk_bf16(v[0][2], v[0][3]); w.z = cvt_pk_bf16(v[1][0], v[1][1]); w.w = cvt_pk_bf16(v[1][2], v[1][3]);
                    *(u32x4*)(rowp + bj * HALF) = w; } }
    }
};
struct EpiOddIn {
    static constexpr bool PERM = true, AFTER_DRAIN = false;
    bf16_t* O; int ldc; int gate_pm0;
    __device__ __forceinline__ void operator()(const f32x4 (&acc)[2][2][4][2], const Unit& u, int wr, int wc, int fr, int fq) const {
        const int row0 = u.pm * BM + wr * 64 + fr; const int col0 = u.pn * BM + wc * 32 + 8 * fq; const bool gate = u.pm >= gate_pm0;
#pragma unroll
        for (int ai = 0; ai < 2; ++ai)
#pragma unroll
            for (int m = 0; m < 4; ++m) { bf16_t* rowp = O + (size_t)(row0 + ai * HALF + m * 16) * ldc + col0;
#pragma unroll
                for (int bj = 0; bj < 2; ++bj) { f32x4 v[2] = {acc[ai][bj][m][0], acc[ai][bj][m][1]};
                    if (gate) {
#pragma unroll
                        for (int n = 0; n < 2; ++n)
#pragma unroll
                            for (int k = 0; k < 4; ++k) v[n][k] = silu_f(v[n][k]); }
                    u32x4 w; w.x = cvt_pk_bf16(v[0][0], v[0][1]); w.y = cvt_pk_bf16(v[0][2], v[0][3]); w.z = cvt_pk_bf16(v[1][0], v[1][1]); w.w = cvt_pk_bf16(v[1][2], v[1][3]);
                    *(u32x4*)(rowp + bj * HALF) = w; } }
    }
};
template <class Epi, class Sched, bool ALIGN_EPI = false, bool SP2 = false>
__device__ __forceinline__ void gemm_phase(PG8_LAS unsigned char* lds, const int K, const Sched& S, const Epi& E) {
    int tid = threadIdx.x; asm volatile("" : "+v"(tid));
    const int wid = __builtin_amdgcn_readfirstlane(tid >> 6), lane = tid & 63, wr = wid >> 2, wc = wid & 3, fr = lane & 15, fq = lane >> 4;
    const int nt = K / BK;
    unsigned voffA[2], voffB[2];
#pragma unroll
    for (int i = 0; i < 2; ++i) { int R, C; stage_rc(tid * 16 + i * 8192, R, C); const int Rb = Epi::PERM ? ((R & ~31) + perm32(R & 31)) : R;
        voffA[i] = (unsigned)(R * K + C) * 2u; voffB[i] = (unsigned)(Rb * K + C) * 2u; }
    const size_t kstep = (size_t)(BK * 2);
    const size_t hstep = (size_t)HALF * K * 2;
    const size_t tstep = 2 * hstep;
    const unsigned ldsw = (unsigned)wid * 1024u;
    const int aoff = lds_byte(wr * 64 + fr, fq * 8), boff = lds_byte(wc * 32 + fr, fq * 8);
#define PG8_SA(b, h) (((b) * 2 + (h)) * HTB)
#define PG8_SB(b, h) ((4 + (b) * 2 + (h)) * HTB)
#define PG8_STAGE(bufoff, gbase, voff) do { _Pragma("unroll") for (int _i = 0; _i < 2; ++_i) \
        __builtin_amdgcn_global_load_lds((const unsigned*)((const char*)(gbase) + (voff)[_i]), (PG8_LAS unsigned*)(lds + (bufoff) + ldsw + _i * 8192), 16, 0, 0); } while (0)
#define PG8_LDA(dst, b, h) do { _Pragma("unroll") for (int m = 0; m < 4; ++m) _Pragma("unroll") for (int k = 0; k < 2; ++k) dst[m][k] = *(const PG8_LAS bf16x8*)(lds + PG8_SA(b, h) + aoff + m * 2048 + k * 1024); } while (0)
#define PG8_LDB(dst, b, h) do { _Pragma("unroll") for (int n = 0; n < 2; ++n) _Pragma("unroll") for (int k = 0; k < 2; ++k) dst[n][k] = *(const PG8_LAS bf16x8*)(lds + PG8_SB(b, h) + boff + n * 2048 + k * 1024); } while (0)
#define PG8_MMA(ai, bj, At, Bt) do { __builtin_amdgcn_s_setprio(1); _Pragma("unroll") for (int m = 0; m < 4; ++m) _Pragma("unroll") for (int n = 0; n < 2; ++n) _Pragma("unroll") for (int k = 0; k < 2; ++k) \
        acc[ai][bj][m][n] = __builtin_amdgcn_mfma_f32_16x16x32_bf16(Bt[n][k], At[m][k], acc[ai][bj][m][n], 0, 0, 0); __builtin_amdgcn_s_setprio(0); } while (0)
#define PG8_WAIT_V(n) asm volatile("s_waitcnt vmcnt(" #n ")" ::: "memory")
#define PG8_WAIT_L(n) asm volatile("s_waitcnt lgkmcnt(" #n ")" ::: "memory")
#define PG8_BAR __builtin_amdgcn_s_barrier()
#define PG8_SCHED __builtin_amdgcn_sched_barrier(0)
    Unit cur, nxt; int ui = 0;
    if (!S.next(0, cur)) return;
    f32x4 acc[2][2][4][2];
#pragma unroll
    for (int a = 0; a < 2; ++a)
#pragma unroll
        for (int b = 0; b < 2; ++b)
#pragma unroll
            for (int m = 0; m < 4; ++m)
#pragma unroll
                for (int n = 0; n < 2; ++n) acc[a][b][m][n] = (f32x4){0.f, 0.f, 0.f, 0.f};
    bf16x8 At[4][2], B0[2][2], B1[2][2];
    const char* cA = S.abase(cur); const char* cB = S.bbase(cur);
    S.a_ready(cur);
    if constexpr (SP2) {
        PG8_STAGE(PG8_SB(0, 0), cB, voffB); PG8_STAGE(PG8_SB(0, 1), cB + hstep, voffB); PG8_STAGE(PG8_SA(0, 0), cA, voffA); PG8_STAGE(PG8_SA(0, 1), cA + hstep, voffA);
        if (wr == 1) PG8_BAR;
        PG8_WAIT_V(2); PG8_BAR;
        PG8_STAGE(PG8_SB(1, 0), cB + kstep, voffB); PG8_STAGE(PG8_SA(1, 0), cA + kstep, voffA); PG8_STAGE(PG8_SB(1, 1), cB + hstep + kstep, voffB);
        PG8_WAIT_V(6); PG8_BAR;
    } else {
        PG8_STAGE(PG8_SB(0, 0), cB, voffB); PG8_STAGE(PG8_SA(0, 0), cA, voffA); PG8_STAGE(PG8_SB(0, 1), cB + hstep, voffB); PG8_STAGE(PG8_SA(0, 1), cA + hstep, voffA);
        if (wr == 1) PG8_BAR;
        PG8_WAIT_V(4); PG8_BAR;
        PG8_STAGE(PG8_SB(1, 0), cB + kstep, voffB); PG8_STAGE(PG8_SA(1, 0), cA + kstep, voffA); PG8_STAGE(PG8_SB(1, 1), cB + hstep + kstep, voffB);
        PG8_WAIT_V(6); PG8_BAR;
    }
    for (;;) {
        const bool has_next = S.next(ui + 1, nxt);
        const char* nA = has_next ? S.abase(nxt) : cA; const char* nB = has_next ? S.bbase(nxt) : cB;
        for (int t = 0; t < nt; t += 2) {
            const bool last = (t == nt - 2);
            const char* a1 = cA + (size_t)(t + 1) * kstep;
            const char* a2 = last ? nA : cA + (size_t)(t + 2) * kstep; const char* b2 = last ? nB : cB + (size_t)(t + 2) * kstep;
            const char* a3 = a2 + kstep; const char* b3 = b2 + kstep;
            if (last && has_next) S.a_ready(nxt);
            if constexpr (SP2) {
            PG8_LDB(B0, 0, 0); PG8_LDB(B1, 0, 1); PG8_SCHED; PG8_LDA(At, 0, 0); PG8_STAGE(PG8_SA(1, 1), a1 + hstep, voffA);
            PG8_WAIT_V(8); PG8_WAIT_L(0); PG8_BAR; PG8_MMA(0, 0, At, B0); PG8_MMA(0, 1, At, B1); PG8_BAR; PG8_SCHED;
            PG8_LDA(At, 0, 1); PG8_STAGE(PG8_SB(0, 0), b2, voffB); PG8_STAGE(PG8_SB(0, 1), b2 + hstep, voffB); PG8_STAGE(PG8_SA(0, 0), a2, voffA);
            PG8_WAIT_V(8); PG8_WAIT_L(0); PG8_BAR; PG8_MMA(1, 0, At, B0); PG8_MMA(1, 1, At, B1); PG8_BAR; PG8_SCHED;
            PG8_LDB(B0, 1, 0); PG8_LDB(B1, 1, 1); PG8_SCHED; PG8_LDA(At, 1, 0); PG8_STAGE(PG8_SA(0, 1), a2 + hstep, voffA);
            PG8_WAIT_V(8); PG8_WAIT_L(0); PG8_BAR; PG8_MMA(0, 0, At, B0); PG8_MMA(0, 1, At, B1); PG8_BAR; PG8_SCHED;
            PG8_LDA(At, 1, 1); PG8_STAGE(PG8_SB(1, 0), b3, voffB); PG8_STAGE(PG8_SB(1, 1), b3 + hstep, voffB); PG8_STAGE(PG8_SA(1, 0), a3, voffA);
            PG8_WAIT_V(8); PG8_WAIT_L(0); PG8_BAR; PG8_MMA(1, 0, At, B0); PG8_MMA(1, 1, At, B1); PG8_BAR; PG8_SCHED;
            } else {
            PG8_LDB(B0, 0, 0); PG8_SCHED; PG8_LDA(At, 0, 0); PG8_STAGE(PG8_SA(1, 1), a1 + hstep, voffA);
            PG8_WAIT_L(8); PG8_BAR; PG8_WAIT_L(0); PG8_MMA(0, 0, At, B0); PG8_BAR; PG8_SCHED;
            PG8_LDB(B1, 0, 1); PG8_STAGE(PG8_SB(0, 0), b2, voffB);
            PG8_BAR; PG8_WAIT_L(0); PG8_MMA(0, 1, At, B1); PG8_BAR;
            PG8_LDA(At, 0, 1); PG8_STAGE(PG8_SA(0, 0), a2, voffA);
            PG8_BAR; PG8_WAIT_L(0); PG8_MMA(1, 0, At, B0); PG8_BAR; PG8_SCHED;
            PG8_STAGE(PG8_SB(0, 1), b2 + hstep, voffB);
            PG8_WAIT_V(6); PG8_BAR; PG8_MMA(1, 1, At, B1); PG8_BAR;
            PG8_LDB(B0, 1, 0); PG8_SCHED; PG8_LDA(At, 1, 0); PG8_STAGE(PG8_SA(0, 1), a2 + hstep, voffA);
            PG8_WAIT_L(8); PG8_BAR; PG8_WAIT_L(0); PG8_MMA(0, 0, At, B0); PG8_BAR; PG8_SCHED;
            PG8_LDB(B1, 1, 1); PG8_STAGE(PG8_SB(1, 0), b3, voffB);
            PG8_BAR; PG8_WAIT_L(0); PG8_MMA(0, 1, At, B1); PG8_BAR;
            PG8_LDA(At, 1, 1); PG8_STAGE(PG8_SA(1, 0), a3, voffA);
            PG8_BAR; PG8_WAIT_L(0); PG8_MMA(1, 0, At, B0); PG8_BAR; PG8_SCHED;
            PG8_STAGE(PG8_SB(1, 1), b3 + hstep, voffB);
            PG8_WAIT_V(6); PG8_BAR; PG8_MMA(1, 1, At, B1); PG8_BAR;
            }
        }
        if constexpr (ALIGN_EPI) { if (wr == 0) PG8_BAR; }
        if constexpr (!Epi::AFTER_DRAIN) { E(acc, cur, wr, wc, fr, fq); S.done(cur); }
        if (!has_next) break;
#pragma unroll
        for (int a = 0; a < 2; ++a)
#pragma unroll
            for (int b = 0; b < 2; ++b)
#pragma unroll
                for (int m = 0; m < 4; ++m)
#pragma unroll
                    for (int n = 0; n < 2; ++n) acc[a][b][m][n] = (f32x4){0.f, 0.f, 0.f, 0.f};
        cur = nxt; cA = nA; cB = nB; ++ui;
        if constexpr (ALIGN_EPI) { if (wr == 1) PG8_BAR; }
    }
    PG8_WAIT_V(0);
    if constexpr (!ALIGN_EPI) { if (wr == 0) PG8_BAR; }
    PG8_BAR;

#undef PG8_SA
#undef PG8_SB
#undef PG8_STAGE
#undef PG8_LDA
#undef PG8_LDB
#undef PG8_MMA
#undef PG8_WAIT_V
#undef PG8_WAIT_L
#undef PG8_BAR
#undef PG8_SCHED
}
}
constexpr int NB = 2, T = 4096, NMETA = 16, L = T + NMETA, D = 4096;
constexpr int MV = NB * L;
constexpr int MP = 8448;
constexpr int EIN = 18432, OIN = 16384, HD = 128;
constexpr int QA_OFF = 0, KA_OFF = 2048, QB_OFF = 6144, IB_OFF = 8192, FF_OFF = 10240, FB_OFF = 12288, GATE_OFF = 14336;
constexpr int KOFF = 4128, KLEN = 8256;
constexpr int LPAD = 4128;
constexpr float EPS = 1e-6f;
constexpr int NWAVES = 8, NTHR = 512;
constexpr int NPHASE = 22;

constexpr size_t MiB = 1u << 20;
constexpr size_t WS_CTL = 0, CTL_ZERO_BYTES = 1 * MiB;
constexpr size_t WS_WEIN = 1 * MiB;
constexpr size_t WS_WEOUT = WS_WEIN + 2 * (size_t)EIN * D * 2;
constexpr size_t WS_WOIN = WS_WEOUT + 2 * (size_t)D * D * 2;
constexpr size_t WS_WOOUT = WS_WOIN + 2 * (size_t)OIN * D * 2;
constexpr size_t WS_H = WS_WOOUT + 2 * (size_t)D * D * 2;
constexpr size_t WS_HN = WS_H + (size_t)MP * D * 4;
constexpr size_t WS_P = WS_HN + (size_t)MP * D * 2;
constexpr size_t WS_VT = WS_P + (size_t)MP * EIN * 2;
constexpr size_t WS_Y = WS_VT + (size_t)2048 * MP * 2;
constexpr size_t WS_YT = WS_Y + (size_t)MP * D * 2;
constexpr size_t WS_OBP = WS_YT + (size_t)MP * D * 2;
constexpr size_t WS_OUT = WS_OBP + (size_t)2 * MP * 2048 * 4;
constexpr size_t WS_KT = WS_OUT + (size_t)MP * D * 4;
constexpr size_t WS_HID2 = WS_KT + (size_t)2 * 2 * 4096 * KLEN * 2;
constexpr size_t WS_LB = WS_HID2 + (size_t)2 * LPAD * 64 * 2;
constexpr size_t WS_END = WS_LB + (size_t)2 * 2 * 2048 * 4;
static_assert(WS_WEIN % 256 == 0 && WS_H % 256 == 0 && WS_P % 256 == 0 && WS_KT % 256 == 0 && WS_HID2 % 256 == 0 && WS_LB % 256 == 0, "alignment");
constexpr int CW_BAR = 4096;

constexpr int LDS_BYTES = 147456;
constexpr int MISC_OFF = 146432;

#define LAS __attribute__((address_space(3)))
typedef unsigned short bf16_t;
typedef short bf16x8 __attribute__((ext_vector_type(8)));
typedef short bf16x4 __attribute__((ext_vector_type(4)));
typedef float f32x4 __attribute__((ext_vector_type(4)));
typedef float f32x16 __attribute__((ext_vector_type(16)));
typedef unsigned u32x4 __attribute__((ext_vector_type(4)));
typedef unsigned u32x2 __attribute__((ext_vector_type(2)));
#define LDS_WAIT() asm volatile("s_waitcnt lgkmcnt(0)" ::: "memory")
#define VM_WAIT() asm volatile("s_waitcnt vmcnt(0)" ::: "memory")
__device__ __forceinline__ unsigned f2bf(float f) { return pg8::cvt_pk_bf16(f, 0.f) & 0xffffu; }
__device__ __forceinline__ unsigned pk2(float lo, float hi) { return pg8::cvt_pk_bf16(lo, hi); }
__device__ __forceinline__ float bflo(unsigned w) { return __builtin_bit_cast(float, w << 16); }
__device__ __forceinline__ float bfhi(unsigned w) { return __builtin_bit_cast(float, w & 0xffff0000u); }
__device__ __forceinline__ float bf1(bf16_t w) { return __builtin_bit_cast(float, ((unsigned)w) << 16); }
__device__ __forceinline__ float wave_sum(float v) {
#pragma unroll
    for (int o = 1; o < 64; o <<= 1) v += __shfl_xor(v, o);
    return v;
}

#define XB_TMO      128
#define XB_XCNT(j)  (256  + 64 * (j))
#define XB_XSUB(j)  (1280 + 64 * (j))
#define XB_XGEN(j)  (2304 + 64 * (j))
#define XB_TOP      3328
#define XB_TOPGEN   3392
#define XCD_BAR_WORDS 3456
#define XB_SPIN_CAP (1u << 20)
__device__ __forceinline__ unsigned xb_ld(unsigned* p)              { return __hip_atomic_load(p, __ATOMIC_RELAXED, __HIP_MEMORY_SCOPE_AGENT); }
__device__ __forceinline__ unsigned xb_add(unsigned* p, unsigned v) { return __hip_atomic_fetch_add(p, v, __ATOMIC_RELAXED, __HIP_MEMORY_SCOPE_AGENT); }
__device__ __forceinline__ unsigned xb_xcc_id() { return (unsigned)__builtin_amdgcn_s_getreg((3 << 11) | 20) & 0xFu; }
#define XB_SPIN(cond, bar) do { unsigned _sp = 0; while (cond) { __builtin_amdgcn_s_sleep(1); \
    if ((++_sp & 255u) == 0u) { if (xb_ld(&(bar)[XB_TMO])) break; if (_sp > XB_SPIN_CAP) { atomicAdd(&(bar)[XB_TMO], 1u); break; } } } } while (0)
struct XcdBarrier { unsigned* bar; unsigned x; volatile LAS unsigned* st; };
__device__ __forceinline__ XcdBarrier xcd_barrier_post(unsigned* bar, volatile LAS unsigned* st) {
    XcdBarrier b; b.bar = bar; b.x = xb_xcc_id(); b.st = st;
    if (threadIdx.x == 0) (void)xb_add(&bar[XB_XCNT(b.x)], 1u);
    return b;
}
__device__ __forceinline__ void xcd_barrier_complete(unsigned* bar, unsigned x, unsigned& nloc, unsigned& nx) {
    const unsigned G = gridDim.x * gridDim.y * gridDim.z;
    unsigned sum, cnt, mine, sp = 0u;
    for (;;) {
        sum = 0u; cnt = 0u; mine = 0u;
#pragma unroll
        for (unsigned j = 0; j < 16; ++j) { const unsigned c = xb_ld(&bar[XB_XCNT(j)]); sum += c; cnt += (c > 0u) ? 1u : 0u; mine = (j == x) ? c : mine; }
        if (sum == G) break;
        __builtin_amdgcn_s_sleep(1);
        if ((++sp & 255u) == 0u) { if (xb_ld(&bar[XB_TMO])) break; if (sp > XB_SPIN_CAP) { atomicAdd(&bar[XB_TMO], 1u); break; } }
    }
    nloc = mine > 0u ? mine : 1u; nx = cnt > 0u ? cnt : 1u;
}
__device__ __forceinline__ void xcd_barrier(const XcdBarrier& b) {
    asm volatile("s_waitcnt vmcnt(0)" ::: "memory");
    __syncthreads();
    if (threadIdx.x == 0) {
        unsigned* bar = b.bar;
        __builtin_amdgcn_s_waitcnt(0);
        unsigned nloc = b.st[0], nx = b.st[1];
        if (nloc == 0u) { xcd_barrier_complete(bar, b.x, nloc, nx); b.st[0] = nloc; b.st[1] = nx; }
        const unsigned old = xb_add(&bar[XB_XSUB(b.x)], 1u);
        const unsigned gen = old / nloc;
        if (old + 1u == (gen + 1u) * nloc) {
            __builtin_amdgcn_fence(__ATOMIC_RELEASE, "agent");
            asm volatile("s_waitcnt vmcnt(0)" ::: "memory");
            const unsigned og = xb_add(&bar[XB_TOP], 1u);
            const unsigned tg = og / nx;
            if (og + 1u == (tg + 1u) * nx) xb_add(&bar[XB_TOPGEN], 1u);
            else XB_SPIN(xb_ld(&bar[XB_TOPGEN]) == tg, bar);
            __builtin_amdgcn_fence(__ATOMIC_ACQUIRE, "agent");
            xb_add(&bar[XB_XGEN(b.x)], 1u);
            asm volatile("s_waitcnt vmcnt(0)" ::: "memory");
        } else {
            XB_SPIN(xb_ld(&bar[XB_XGEN(b.x)]) == gen, bar);
            __builtin_amdgcn_fence(__ATOMIC_ACQUIRE, "agent");
            asm volatile("s_waitcnt vmcnt(0)" ::: "memory");
        }
    }
    __syncthreads();
}

struct Params { const float* in[21]; float* out; unsigned char* ws; int ph_lo, ph_hi; };
enum { I_X = 0, I_META, I_NPRE, I_NPOST, I_EWIN, I_EWOUT, I_RPB, I_MBIAS, I_HGLOW, I_HGNORM, I_OWIN, I_OWOUT, I_HYSHORT, I_W1, I_B1, I_FR1, I_W2, I_B2, I_FR2, I_W3, I_HYBIAS };
__device__ __forceinline__ void p0_transpose_item(const float* W, int K, int N, bf16_t* WT, LAS float* scr, int item, int lane) {
    const int nblk = N / 32, kb = item / nblk, nb = item % nblk, k0 = 64 * kb, n0 = 32 * nb;
#pragma unroll 8
    for (int i = 0; i < 32; ++i) { const int kk = 2 * i + (lane >> 5); scr[kk * 33 + (lane & 31)] = W[(size_t)(k0 + kk) * N + n0 + (lane & 31)]; }
    LDS_WAIT(); asm volatile("" ::: "memory");
    const int c = lane & 7;
#pragma unroll
    for (int j = 0; j < 4; ++j) { const int n = (lane >> 3) + 8 * j; const LAS float* s = scr + (8 * c) * 33 + n;
        u32x4 o; o.x = pk2(s[0 * 33], s[1 * 33]); o.y = pk2(s[2 * 33], s[3 * 33]); o.z = pk2(s[4 * 33], s[5 * 33]); o.w = pk2(s[6 * 33], s[7 * 33]);
        *(u32x4*)(WT + (size_t)(n0 + n) * K + k0 + 8 * c) = o; }
    LDS_WAIT(); asm volatile("" ::: "memory");
}
__device__ __forceinline__ void rms_row_to_bf16(const f32x4 (&v)[16], const float* g, bf16_t* orow, int lane) {
    float s = 0.f;
#pragma unroll
    for (int j = 0; j < 16; ++j) s += (v[j].x * v[j].x + v[j].y * v[j].y) + (v[j].z * v[j].z + v[j].w * v[j].w);
    const float rstd = 1.0f / sqrtf(wave_sum(s) * (1.0f / D) + EPS);
    const f32x4* g4 = (const f32x4*)g + lane; u32x2* o8 = (u32x2*)orow + lane;
#pragma unroll
    for (int j = 0; j < 16; ++j) { const f32x4 gg = g4[64 * j]; u32x2 w; w.x = pk2(v[j].x * rstd * gg.x, v[j].y * rstd * gg.y); w.y = pk2(v[j].z * rstd * gg.z, v[j].w * rstd * gg.w); o8[64 * j] = w; }
}
__device__ __forceinline__ void phase_prologue(const Params& p, LAS unsigned char* lds, int gw, int NGW, int wave, int lane) {
    unsigned char* ws = p.ws;
    LAS float* scr = (LAS float*)(lds + wave * 16384);
    constexpr int I_EIN = (D / 64) * (EIN / 32), I_SQ = (D / 64) * (D / 32), I_OIN = (D / 64) * (OIN / 32), I_LAYER = I_EIN + 2 * I_SQ + I_OIN;
    for (int it = gw; it < 2 * I_LAYER; it += NGW) {
        const int j = it / I_LAYER; int r = it % I_LAYER;
        if (r < I_EIN) { p0_transpose_item(p.in[I_EWIN] + (size_t)j * D * EIN, D, EIN, (bf16_t*)(ws + WS_WEIN) + (size_t)j * EIN * D, scr, r, lane); continue; } r -= I_EIN;
        if (r < I_SQ) { p0_transpose_item(p.in[I_EWOUT] + (size_t)j * D * D, D, D, (bf16_t*)(ws + WS_WEOUT) + (size_t)j * D * D, scr, r, lane); continue; } r -= I_SQ;
        if (r < I_OIN) { p0_transpose_item(p.in[I_OWIN] + (size_t)j * D * OIN, D, OIN, (bf16_t*)(ws + WS_WOIN) + (size_t)j * OIN * D, scr, r, lane); continue; } r -= I_OIN;
        p0_transpose_item(p.in[I_OWOUT] + (size_t)j * D * D, D, D, (bf16_t*)(ws + WS_WOOUT) + (size_t)j * D * D, scr, r, lane);
    }
    float* H = (float*)(ws + WS_H); bf16_t* HN = (bf16_t*)(ws + WS_HN);
    for (int m = gw; m < MP; m += NGW) {
        f32x4 v[16];
        if (m < MV) {
            const float* src = (m < NB * T) ? p.in[I_X] + (size_t)m * D : p.in[I_META] + (size_t)((m - NB * T) & 15) * D;
#pragma unroll
            for (int j = 0; j < 16; ++j) v[j] = ((const f32x4*)src)[lane + 64 * j];
#pragma unroll
            for (int j = 0; j < 16; ++j) ((f32x4*)(H + (size_t)m * D))[lane + 64 * j] = v[j];
            rms_row_to_bf16(v, p.in[I_NPRE], HN + (size_t)m * D, lane);
        } else {
#pragma unroll
            for (int j = 0; j < 16; ++j) ((u32x2*)(HN + (size_t)m * D))[lane + 64 * j] = (u32x2){0u, 0u};
        }
    }
    { float* LB = (float*)(ws + WS_LB); const float* hl = p.in[I_HGLOW];
      for (int i = gw * 64 + lane; i < 2 * 2048; i += NGW * 64) { LB[i] = 0.f; LB[4096 + i] = 1.0f / (1.0f + __expf(hl[i] - hl[4096 + i])); } }
    { bf16_t* HID2 = (bf16_t*)(ws + WS_HID2);
      for (int it = gw; it < 2 * LPAD; it += NGW) {
        const int jl = it / LPAD, l = it % LPAD; float h2 = 0.f;
        if (l < L) {
            float z = 0.f;
            if (lane == 0) z = (float)l * (1.0f / (float)(L - 1));
            else if (lane < 33) { const int k = (lane - 1) & 15; const float band = 1e-4f + (float)k * ((15.0f - 1e-4f) / 15.0f); float rev = band * ((float)l / (float)L); rev -= floorf(rev);
                z = (lane < 17) ? __builtin_amdgcn_cosf(rev) : -__builtin_amdgcn_sinf(rev); }
            const float* w1 = p.in[I_W1] + (size_t)jl * 33 * 64; const float* w2 = p.in[I_W2] + (size_t)jl * 64 * 64;
            float a = p.in[I_B1][jl * 64 + lane];
#pragma unroll
            for (int i = 0; i < 33; ++i) a += __shfl(z, i) * w1[i * 64 + lane];
            const float h1 = __sinf(p.in[I_FR1][jl * 64 + lane] * a);
            float a2 = p.in[I_B2][jl * 64 + lane];
#pragma unroll 16
            for (int i = 0; i < 64; ++i) a2 += __shfl(h1, i) * w2[i * 64 + lane];
            h2 = __sinf(p.in[I_FR2][jl * 64 + lane] * a2);
        }
        HID2[(size_t)it * 64 + lane] = (bf16_t)f2bf(h2);
      } }
}

__device__ __forceinline__ void phase_filtergen(const Params& p, int gw, int NGW, int lane) {
    unsigned char* ws = p.ws; const bf16_t* HID2 = (const bf16_t*)(ws + WS_HID2); bf16_t* KT = (bf16_t*)(ws + WS_KT);
    const int r32 = lane & 31, h = lane >> 5;
    for (int wi = gw; wi < 2048; wi += NGW) {
        const int lpart = wi & 3, cb = (wi >> 2) & 127, n = (wi >> 9) & 1, jl = wi >> 10; const int c0 = cb * 32;
        const float* w3 = p.in[I_W3] + (size_t)jl * 64 * 16384;
        bf16x8 A[2][4];
#pragma unroll
        for (int dir = 0; dir < 2; ++dir)
#pragma unroll
            for (int st = 0; st < 4; ++st) { const float* src = w3 + (size_t)(16 * st + 8 * h) * 16384 + (dir * 2 + n) * 4096 + c0 + r32;
                u32x4 w; w.x = pk2(src[0], src[16384]); w.y = pk2(src[2 * 16384], src[3 * 16384]); w.z = pk2(src[4 * 16384], src[5 * 16384]); w.w = pk2(src[6 * 16384], src[7 * 16384]);
                A[dir][st] = __builtin_bit_cast(bf16x8, w); }
        const int lb0 = lpart * 33, lb1 = (lb0 + 33 < 129) ? lb0 + 33 : 129;
        for (int lb = lb0; lb < lb1; ++lb) {
            const int l = lb * 32 + r32;
            f32x16 acc0, acc1;
#pragma unroll
            for (int i = 0; i < 16; ++i) { acc0[i] = 0.f; acc1[i] = 0.f; }
#pragma unroll
            for (int st = 0; st < 4; ++st) { const bf16x8 B = *(const bf16x8*)(HID2 + ((size_t)jl * LPAD + l) * 64 + 16 * st + 8 * h);
                acc0 = __builtin_amdgcn_mfma_f32_32x32x16_bf16(A[0][st], B, acc0, 0, 0, 0); acc1 = __builtin_amdgcn_mfma_f32_32x32x16_bf16(A[1][st], B, acc1, 0, 0, 0); }
            const float tl = (float)l * (1.0f / (float)(L - 1));
#pragma unroll
            for (int reg = 0; reg < 16; ++reg) { const int c = c0 + (reg & 3) + 8 * (reg >> 2) + 4 * h;
                const float delta = 3.0701134f + (15.350567f - 3.0701134f) * ((float)c * (1.0f / 4095.0f)); const float wdw = __expf(-tl * delta);
                bf16_t* R = KT + ((size_t)(jl * 2 + n) * 4096 + c) * KLEN; const float v0 = acc0[reg] * wdw, v1 = acc1[reg] * wdw;
                if (l == 0) R[KOFF] = (bf16_t)f2bf(v0 + v1); else { R[KOFF - l] = (bf16_t)f2bf(v0); R[KOFF + l] = (bf16_t)f2bf(v1); } }
        }
        if (lpart == 3 && lane < 32) KT[((size_t)(jl * 2 + n) * 4096 + c0 + lane) * KLEN] = 0;
    }
}
constexpr int HG_QM = 0, HG_KM = 17408, HG_QS = 34816, HG_KST = 52224, HG_VT = 70656, HG_STB = 75264, HG_TOT = 92672, HG_DEC = 100864, HG_END = 101376;
__device__ __forceinline__ int hg_row(int dir, int b, int ci, int tau) {
    if (dir == 0) { if (ci == 0) return tau < 16 ? 8192 + 16 * b + tau : -1; return b * 4096 + 64 * (ci - 1) + tau; }
    if (ci == 64) return tau < 16 ? 8192 + 16 * b + 15 - tau : -1;
    return b * 4096 + 4095 - (64 * ci + tau);
}
__device__ __forceinline__ void hgrn_item(const Params& p, LAS unsigned char* lds, int item, int tid, int wave, int lane) {
    const int dvs = item & 3, hd = (item >> 2) & 15, b = (item >> 6) & 1, dir = item >> 7, dv0 = dvs * 32;
    const bf16_t* P = (const bf16_t*)(p.ws + WS_P); float* OBP = (float*)(p.ws + WS_OBP) + (size_t)dir * MP * 2048;
    const int qcol = QB_OFF + hd * 128, vcol = IB_OFF + hd * 128 + dv0, fcol = (dir ? FB_OFF : FF_OFF) + hd * 128;
    const int dg = tid & 31, tg = tid >> 5;
    const int tv = tid >> 3, dvq = tid & 7;
    const int r32 = lane & 31, h = lane >> 5;
    LAS bf16_t* QM = (LAS bf16_t*)(lds + HG_QM); LAS bf16_t* KM = (LAS bf16_t*)(lds + HG_KM); LAS bf16_t* QS = (LAS bf16_t*)(lds + HG_QS);
    LAS bf16_t* KST = (LAS bf16_t*)(lds + HG_KST); LAS bf16_t* VTL = (LAS bf16_t*)(lds + HG_VT); LAS bf16_t* STB = (LAS bf16_t*)(lds + HG_STB);
    LAS float* TOT = (LAS float*)(lds + HG_TOT); LAS float* DEC = (LAS float*)(lds + HG_DEC);
    for (int i = tid; i < 2 * 32 * 136 / 2; i += NTHR) ((LAS unsigned*)STB)[i] = 0u;
    f32x16 st;
#pragma unroll
    for (int i = 0; i < 16; ++i) st[i] = 0.f;
    u32x2 qraw[4], lraw[4], vraw;
    auto load_chunk = [&](int ci) {
#pragma unroll
        for (int i = 0; i < 4; ++i) { const int row = hg_row(dir, b, ci, 4 * tg + i);
            if (row >= 0) { qraw[i] = *(const u32x2*)(P + (size_t)row * EIN + qcol + 4 * dg); lraw[i] = *(const u32x2*)(P + (size_t)row * EIN + fcol + 4 * dg); }
            else { qraw[i] = (u32x2){0u, 0u}; lraw[i] = (u32x2){0u, 0u}; } }
        { const int row = hg_row(dir, b, ci, tv); vraw = (row >= 0) ? *(const u32x2*)(P + (size_t)row * EIN + vcol + 4 * dvq) : (u32x2){0u, 0u}; }
    };
    load_chunk(0);
    int cur = 0;
    __syncthreads();
    for (int ci = 0; ci < 65; ++ci) {
        float qs[4][4], lg[4][4];
#pragma unroll
        for (int i = 0; i < 4; ++i) { qs[i][0] = bflo(qraw[i].x); qs[i][1] = bfhi(qraw[i].x); qs[i][2] = bflo(qraw[i].y); qs[i][3] = bfhi(qraw[i].y);
            lg[i][0] = bflo(lraw[i].x); lg[i][1] = bfhi(lraw[i].x); lg[i][2] = bflo(lraw[i].y); lg[i][3] = bfhi(lraw[i].y); }
        float kk[4][4];
#pragma unroll
        for (int i = 0; i < 4; ++i)
#pragma unroll
            for (int k = 0; k < 4; ++k) kk[i][k] = 1.0f - __expf(lg[i][k]);
        float cs[4][4];
#pragma unroll
        for (int k = 0; k < 4; ++k) { cs[0][k] = lg[0][k]; cs[1][k] = cs[0][k] + lg[1][k]; cs[2][k] = cs[1][k] + lg[2][k]; cs[3][k] = cs[2][k] + lg[3][k]; }
        *(LAS f32x4*)(TOT + tg * 128 + 4 * dg) = (f32x4){cs[3][0], cs[3][1], cs[3][2], cs[3][3]};
        { const float v0 = bflo(vraw.x), v1 = bfhi(vraw.x), v2 = bflo(vraw.y), v3 = bfhi(vraw.y);
          VTL[(4 * dvq + 0) * 72 + tv] = (bf16_t)f2bf(v0); VTL[(4 * dvq + 1) * 72 + tv] = (bf16_t)f2bf(v1); VTL[(4 * dvq + 2) * 72 + tv] = (bf16_t)f2bf(v2); VTL[(4 * dvq + 3) * 72 + tv] = (bf16_t)f2bf(v3); }
        __syncthreads();
        f32x4 pre = (f32x4){0.f, 0.f, 0.f, 0.f}, mid = pre, end = pre;
#pragma unroll
        for (int g = 0; g < 16; ++g) { const f32x4 t4 = *(const LAS f32x4*)(TOT + g * 128 + 4 * dg); if (g < tg) pre += t4; if (g < 8) mid += t4; end += t4; }
        if (ci + 1 < 65) load_chunk(ci + 1);
#pragma unroll
        for (int k = 0; k < 4; ++k) {
            const float emid = __expf(mid[k]), eem = __expf(end[k] - mid[k]);
            float ksv[4];
#pragma unroll
            for (int i = 0; i < 4; ++i) { const float G = pre[k] + cs[i][k]; const float e1 = __expf(G - mid[k]), e2 = __expf(mid[k] - G);
                const float qm = qs[i][k] * e1, km = kk[i][k] * e2; const int tau = 4 * tg + i, d = 4 * dg + k;
                QM[tau * 136 + d] = (bf16_t)f2bf(qm); KM[tau * 136 + d] = (bf16_t)f2bf(km); QS[tau * 136 + d] = (bf16_t)f2bf(qm * emid); ksv[i] = km * eem; }
            u32x2 w; w.x = pk2(ksv[0], ksv[1]); w.y = pk2(ksv[2], ksv[3]);
            *(LAS u32x2*)(KST + (4 * dg + k) * 72 + 4 * tg) = w;
            if (tg == 0) DEC[4 * dg + k] = emid * eem;
        }
        __syncthreads();
        if (wave < 2) {
            const int tb = wave;
            f32x16 accO;
#pragma unroll
            for (int i = 0; i < 16; ++i) accO[i] = 0.f;
            for (int sb = 0; sb <= tb; ++sb) {
                f32x16 s;
#pragma unroll
                for (int i = 0; i < 16; ++i) s[i] = 0.f;
#pragma unroll
                for (int stp = 0; stp < 8; ++stp) { const bf16x8 a = *(const LAS bf16x8*)(KM + (32 * sb + r32) * 136 + 16 * stp + 8 * h); const bf16x8 bq = *(const LAS bf16x8*)(QM + (32 * tb + r32) * 136 + 16 * stp + 8 * h);
                    s = __builtin_amdgcn_mfma_f32_32x32x16_bf16(a, bq, s, 0, 0, 0); }
                if (sb == tb) {
#pragma unroll
                    for (int reg = 0; reg < 16; ++reg) { const int sl = (reg & 3) + 8 * (reg >> 2) + 4 * h; if (sl > r32) s[reg] = 0.f; }
                }
#pragma unroll
                for (int st2 = 0; st2 < 2; ++st2) {
                    u32x4 pw; pw.x = pk2(s[8 * st2 + 0], s[8 * st2 + 1]); pw.y = pk2(s[8 * st2 + 2], s[8 * st2 + 3]); pw.z = pk2(s[8 * st2 + 4], s[8 * st2 + 5]); pw.w = pk2(s[8 * st2 + 6], s[8 * st2 + 7]);
                    const LAS bf16_t* vp = VTL + r32 * 72 + 32 * sb + 16 * st2 + 4 * h;
                    const u32x2 a0 = *(const LAS u32x2*)vp, a1 = *(const LAS u32x2*)(vp + 8);
                    const u32x4 aw = (u32x4){a0.x, a0.y, a1.x, a1.y};
                    accO = __builtin_amdgcn_mfma_f32_32x32x16_bf16(__builtin_bit_cast(bf16x8, aw), __builtin_bit_cast(bf16x8, pw), accO, 0, 0, 0);
                }
            }
            const LAS bf16_t* sbp = STB + cur * (32 * 136);
#pragma unroll
            for (int stp = 0; stp < 8; ++stp) { const bf16x8 a = *(const LAS bf16x8*)(sbp + r32 * 136 + 16 * stp + 8 * h); const bf16x8 bq = *(const LAS bf16x8*)(QS + (32 * tb + r32) * 136 + 16 * stp + 8 * h);
                accO = __builtin_amdgcn_mfma_f32_32x32x16_bf16(a, bq, accO, 0, 0, 0); }
            const int row = hg_row(dir, b, ci, 32 * tb + r32);
            if (row >= 0) { float* op = OBP + (size_t)row * 2048 + hd * 128 + dv0 + 4 * h;
#pragma unroll
                for (int g4 = 0; g4 < 4; ++g4) *(f32x4*)(op + 8 * g4) = (f32x4){accO[4 * g4], accO[4 * g4 + 1], accO[4 * g4 + 2], accO[4 * g4 + 3]}; }
        } else if (wave < 6) {
            const int db = wave - 2; const float dec = DEC[32 * db + r32];
#pragma unroll
            for (int i = 0; i < 16; ++i) st[i] *= dec;
#pragma unroll
            for (int stp = 0; stp < 4; ++stp) { const bf16x8 a = *(const LAS bf16x8*)(VTL + r32 * 72 + 16 * stp + 8 * h); const bf16x8 bk = *(const LAS bf16x8*)(KST + (32 * db + r32) * 72 + 16 * stp + 8 * h);
                st = __builtin_amdgcn_mfma_f32_32x32x16_bf16(a, bk, st, 0, 0, 0); }
            LAS bf16_t* sbn = STB + (cur ^ 1) * (32 * 136);
#pragma unroll
            for (int reg = 0; reg < 16; ++reg) { const int dvl = (reg & 3) + 8 * (reg >> 2) + 4 * h; sbn[dvl * 136 + 32 * db + r32] = (bf16_t)f2bf(st[reg]); }
        }
        cur ^= 1;
        __syncthreads();
    }
}

typedef float f32x4v __attribute__((ext_vector_type(4)));
__device__ __forceinline__ void natten_item(const Params& p, int item, int jl, int lane) {
    const bf16_t* P = (const bf16_t*)(p.ws + WS_P); const bf16_t* VT = (const bf16_t*)(p.ws + WS_VT); bf16_t* Y = (bf16_t*)(p.ws + WS_Y);
    const bool ismeta = item >= 8192;
    int b, hd, r, j;
    if (ismeta) { const int t = item - 8192; b = t >> 4; hd = t & 15; r = 0; j = 0; } else { j = item & 3; r = (item >> 2) & 63; hd = (item >> 8) & 15; b = item >> 12; }
    const int q16 = lane & 15, h4 = lane >> 4;
    const int qrow = ismeta ? 8192 + 16 * b + q16 : b * 4096 + 64 * r + 16 * j + q16;
    const int kw0 = (j == 0) ? 0 : (j == 1) ? 8 : (j == 2) ? 24 : 32;
    const int r0 = (r - 4 < 0) ? 0 : ((r - 4 > 56) ? 56 : r - 4);
    const float* rpb = p.in[I_RPB] + ((size_t)jl * 16 + hd) * 15 * 31; const float* mb = p.in[I_MBIAS] + ((size_t)jl * 16 + hd) * 16;
    bf16x8 QF[4];
#pragma unroll
    for (int stp = 0; stp < 4; ++stp) QF[stp] = *(const bf16x8*)(P + (size_t)qrow * EIN + QA_OFF + hd * 128 + 32 * stp + 8 * h4);
    f32x4 S[17];
    auto tokbase = [&](int kt) -> int { if (kt == 0) return 8192 + 16 * b; const int i = (kt - 1) >> 1, half = (kt - 1) & 1; return b * 4096 + 64 * (r0 + i) + kw0 + 16 * half; };
#pragma unroll
    for (int kt = 0; kt < 17; ++kt) {
        const int krow = tokbase(kt) + q16; f32x4 s = (f32x4){0.f, 0.f, 0.f, 0.f};
#pragma unroll
        for (int stp = 0; stp < 4; ++stp) { const bf16x8 a = *(const bf16x8*)(P + (size_t)krow * EIN + KA_OFF + hd * 128 + 32 * stp + 8 * h4);
            s = __builtin_amdgcn_mfma_f32_16x16x32_bf16(a, QF[stp], s, 0, 0, 0); }
        S[kt] = s;
    }
    const int qc = 16 * j + q16; const int c0 = (qc - 8 < 0) ? 0 : ((qc - 8 > 48) ? 48 : qc - 8);
    float mx = -3.0e38f;
#pragma unroll
    for (int reg = 0; reg < 4; ++reg) { S[0][reg] += mb[4 * h4 + reg]; mx = fmaxf(mx, S[0][reg]); }
#pragma unroll
    for (int kt = 1; kt < 17; ++kt) { const int i = (kt - 1) >> 1, half = (kt - 1) & 1;
#pragma unroll
        for (int reg = 0; reg < 4; ++reg) { const int kc = kw0 + 16 * half + 4 * h4 + reg; const bool ok = !ismeta && kc >= c0 && kc < c0 + 16;
            int ci = kc - qc + 15; ci = ci < 0 ? 0 : (ci > 30 ? 30 : ci);
            const float bias = rpb[((r0 + i) - r + 7) * 31 + ci];
            const float v = ok ? S[kt][reg] + bias : -3.0e38f; S[kt][reg] = v; mx = fmaxf(mx, v); } }
    mx = fmaxf(mx, __shfl_xor(mx, 16)); mx = fmaxf(mx, __shfl_xor(mx, 32));
    float sum = 0.f;
#pragma unroll
    for (int kt = 0; kt < 17; ++kt)
#pragma unroll
        for (int reg = 0; reg < 4; ++reg) { const float e = (S[kt][reg] > -1.0e38f) ? __expf(S[kt][reg] - mx) : 0.f; S[kt][reg] = e; sum += e; }
    sum += __shfl_xor(sum, 16); sum += __shfl_xor(sum, 32);
    const float inv = 1.0f / sum;
    f32x4 O[8];
#pragma unroll
    for (int dt = 0; dt < 8; ++dt) O[dt] = (f32x4){0.f, 0.f, 0.f, 0.f};
#pragma unroll
    for (int u = 0; u < 9; ++u) {
        const int k0t = 2 * u, k1t = 2 * u + 1;
        u32x4 pw; pw.x = pk2(S[k0t][0], S[k0t][1]); pw.y = pk2(S[k0t][2], S[k0t][3]);
        if (k1t < 17) { pw.z = pk2(S[k1t][0], S[k1t][1]); pw.w = pk2(S[k1t][2], S[k1t][3]); } else { pw.z = 0u; pw.w = 0u; }
        const int tb0 = tokbase(k0t) + 4 * h4, tb1 = (k1t < 17) ? tokbase(k1t) + 4 * h4 : tb0;
#pragma unroll
        for (int dt = 0; dt < 8; ++dt) { const bf16_t* vr = VT + (size_t)(hd * 128 + 16 * dt + q16) * MP;
            const u32x2 a0 = *(const u32x2*)(vr + tb0), a1 = *(const u32x2*)(vr + tb1);
            const u32x4 aw = (u32x4){a0.x, a0.y, a1.x, a1.y};
            O[dt] = __builtin_amdgcn_mfma_f32_16x16x32_bf16(__builtin_bit_cast(bf16x8, aw), __builtin_bit_cast(bf16x8, pw), O[dt], 0, 0, 0); }
    }
#pragma unroll
    for (int dt = 0; dt < 8; ++dt) { const int col = hd * 128 + 16 * dt + 4 * h4;
        const u32x2 g = *(const u32x2*)(P + (size_t)qrow * EIN + GATE_OFF + col);
        u32x2 w; w.x = pk2(O[dt][0] * inv * bflo(g.x), O[dt][1] * inv * bfhi(g.x)); w.y = pk2(O[dt][2] * inv * bflo(g.y), O[dt][3] * inv * bfhi(g.y));
        *(u32x2*)(Y + (size_t)qrow * D + col) = w; }
}
__device__ __forceinline__ void phase_combine(const Params& p, int jl, int gw, int NGW, int lane) {
    const float* OB0 = (const float*)(p.ws + WS_OBP); const float* OB1 = OB0 + (size_t)MP * 2048; const bf16_t* P = (const bf16_t*)(p.ws + WS_P); bf16_t* Y = (bf16_t*)(p.ws + WS_Y);
    const float* gain = p.in[I_HGNORM] + (size_t)jl * 2048;
    for (int m = gw; m < MV; m += NGW) {
        f32x4 o[8]; float ss = 0.f;
#pragma unroll
        for (int k = 0; k < 8; ++k) { o[k] = *(const f32x4*)(OB0 + (size_t)m * 2048 + 32 * lane + 4 * k) + *(const f32x4*)(OB1 + (size_t)m * 2048 + 32 * lane + 4 * k);
            ss += (o[k].x * o[k].x + o[k].y * o[k].y) + (o[k].z * o[k].z + o[k].w * o[k].w); }
        ss += __shfl_xor(ss, 1); ss += __shfl_xor(ss, 2);
        const float rstd = 1.0f / sqrtf(ss * (1.0f / 128.0f) + EPS);
#pragma unroll
        for (int k2 = 0; k2 < 4; ++k2) { const u32x4 g = *(const u32x4*)(P + (size_t)m * EIN + GATE_OFF + 2048 + 32 * lane + 8 * k2);
            const f32x4 ga = *(const f32x4*)(gain + 32 * lane + 8 * k2), gb = *(const f32x4*)(gain + 32 * lane + 8 * k2 + 4); const f32x4 a = o[2 * k2], bq = o[2 * k2 + 1];
            u32x4 w; w.x = pk2(a.x * rstd * ga.x * bflo(g.x), a.y * rstd * ga.y * bfhi(g.x)); w.y = pk2(a.z * rstd * ga.z * bflo(g.y), a.w * rstd * ga.w * bfhi(g.y));
            w.z = pk2(bq.x * rstd * gb.x * bflo(g.z), bq.y * rstd * gb.y * bfhi(g.z)); w.w = pk2(bq.z * rstd * gb.z * bflo(g.w), bq.w * rstd * gb.w * bfhi(g.w));
            *(u32x4*)(Y + (size_t)m * D + 2048 + 32 * lane + 8 * k2) = w; }
    }
}
__device__ __forceinline__ void phase_postnorm(const Params& p, int layer, int gw, int NGW, int lane) {
    const float* OUT = (const float*)(p.ws + WS_OUT); float* H = (float*)(p.ws + WS_H); bf16_t* HN = (bf16_t*)(p.ws + WS_HN);
    const float* gpost = p.in[I_NPOST] + (size_t)layer * D; const bool last = (layer == MK_NLAYERS - 1); const float* gpre = p.in[I_NPRE] + (size_t)(last ? 0 : layer + 1) * D;
    for (int m = gw; m < MV; m += NGW) {
        if (last && m >= NB * T) continue;
        f32x4 o[16]; float ss = 0.f;
#pragma unroll
        for (int j = 0; j < 16; ++j) { o[j] = ((const f32x4*)(OUT + (size_t)m * D))[lane + 64 * j]; ss += (o[j].x * o[j].x + o[j].y * o[j].y) + (o[j].z * o[j].z + o[j].w * o[j].w); }
        const float rstd = 1.0f / sqrtf(wave_sum(ss) * (1.0f / D) + EPS);
        f32x4 hv[16];
#pragma unroll
        for (int j = 0; j < 16; ++j) { const f32x4 g = ((const f32x4*)gpost)[lane + 64 * j]; hv[j] = ((const f32x4*)(H + (size_t)m * D))[lane + 64 * j] + o[j] * rstd * g; }
        if (last) {
#pragma unroll
            for (int j = 0; j < 16; ++j) {
#if MK_SANITIZE
                for (int k = 0; k < 4; ++k) if (!(fabsf(hv[j][k]) < 1e30f)) hv[j][k] = 0.f;
#endif
                ((f32x4*)(p.out + (size_t)m * D))[lane + 64 * j] = hv[j]; }
        } else {
#pragma unroll
            for (int j = 0; j < 16; ++j) ((f32x4*)(H + (size_t)m * D))[lane + 64 * j] = hv[j];
            rms_row_to_bf16(hv, gpre, HN + (size_t)m * D, lane);
        }
    }
}
constexpr int LC_KCS = 16704;
constexpr int LC_KC = 0, LC_U1 = 4 * LC_KCS  , LC_US = 20480, LC_U2 = LC_U1 + LC_US, LC_X1 = LC_U2 + LC_US  , LC_XS = 16512, LC_X2 = LC_X1 + LC_XS, LC_TAIL = LC_X2 + LC_XS  , LC_END = LC_TAIL + 256;
static_assert(LC_END <= MISC_OFF, "long-conv LDS map");
__device__ __forceinline__ int lc_ugran(int b, int G) { return b * 10240 + (G & 3) * 2560 + (G >> 2) * 16; }
__device__ __forceinline__ int lc_tokrow(int b, int l) { return l < 16 ? 8192 + 16 * b + l : b * 4096 + l - 16; }
__device__ __forceinline__ void lc_shortconv(const bf16_t* urow, int b, int gl, float w0, float w1, float w2, float (&o)[8]) {
    const int l0 = 8 * gl; const int r0 = lc_tokrow(b, l0);
    const u32x4 raw = *(const u32x4*)(urow + r0);
    float x[10];
    x[1] = bflo(raw.x); x[2] = bfhi(raw.x); x[3] = bflo(raw.y); x[4] = bfhi(raw.y); x[5] = bflo(raw.z); x[6] = bfhi(raw.z); x[7] = bflo(raw.w); x[8] = bfhi(raw.w);
    x[0] = (l0 > 0) ? bf1(urow[lc_tokrow(b, l0 - 1)]) : 0.f;
    x[9] = (l0 + 8 < L) ? bf1(urow[lc_tokrow(b, l0 + 8)]) : 0.f;
#pragma unroll
    for (int k = 0; k < 8; ++k) o[k] = w0 * x[k] + w1 * x[k + 1] + w2 * x[k + 2];
}
__device__ __forceinline__ void lc_stage_filter(const bf16_t* krow, LAS unsigned char* lds, int tid) {
    for (int m = tid; m < KLEN / 8; m += NTHR) {
        const u32x4 a = *(const u32x4*)(krow + 8 * m); const u32x4 bq = (m + 1 < KLEN / 8) ? *(const u32x4*)(krow + 8 * m + 8) : (u32x4){0u, 0u, 0u, 0u};
        const unsigned w[6] = {a.x, a.y, a.z, a.w, bq.x, bq.y};
        *(LAS u32x4*)(lds + LC_KC + 0 * LC_KCS + 16 * m) = a;
        *(LAS u32x4*)(lds + LC_KC + 1 * LC_KCS + 16 * m) = (u32x4){__builtin_amdgcn_alignbit(w[1], w[0], 16), __builtin_amdgcn_alignbit(w[2], w[1], 16), __builtin_amdgcn_alignbit(w[3], w[2], 16), __builtin_amdgcn_alignbit(w[4], w[3], 16)};
        *(LAS u32x4*)(lds + LC_KC + 2 * LC_KCS + 16 * m) = (u32x4){w[1], w[2], w[3], w[4]};
        *(LAS u32x4*)(lds + LC_KC + 3 * LC_KCS + 16 * m) = (u32x4){__builtin_amdgcn_alignbit(w[2], w[1], 16), __builtin_amdgcn_alignbit(w[3], w[2], 16), __builtin_amdgcn_alignbit(w[4], w[3], 16), __builtin_amdgcn_alignbit(w[5], w[4], 16)};
    }
}
__device__ __forceinline__ void lc_conv(LAS unsigned char* lds, int uin_off, int wave, int lane, f32x16& accm) {
    const int g = wave; const int i32 = lane & 31, h = lane >> 5, n16 = lane & 15, b = (lane >> 4) & 1;
    const int e0 = 32 * g - 257;
    const int p0 = KOFF - 16 * e0 - i32 + 8 * h; const int cc = p0 & 3; const int q0 = p0 - cc;
    const LAS unsigned char* kp = lds + LC_KC + cc * LC_KCS + 2 * q0;
    const int I = 16 * g + n16;
    const int G0 = 4 * I - 2 * e0 + h + 60, G1 = G0 - 2;
    const LAS unsigned char* up0 = lds + uin_off + lc_ugran(b, G0); const LAS unsigned char* up1 = lds + uin_off + lc_ugran(b, G1);
    f32x16 acc0, acc1;
#pragma unroll
    for (int r = 0; r < 16; ++r) { acc0[r] = 0.f; acc1[r] = 0.f; }
#pragma unroll 4
    for (int k = 0; k < 144; ++k) {
        const u32x2 a00 = *(const LAS u32x2*)(kp - 64 * k), a01 = *(const LAS u32x2*)(kp - 64 * k + 8);
        const u32x2 a10 = *(const LAS u32x2*)(kp - 64 * k - 32), a11 = *(const LAS u32x2*)(kp - 64 * k - 32 + 8);
        const bf16x8 b0 = *(const LAS bf16x8*)(up0 - 16 * k), b1 = *(const LAS bf16x8*)(up1 - 16 * k);
        acc0 = __builtin_amdgcn_mfma_f32_32x32x16_bf16(__builtin_bit_cast(bf16x8, (u32x4){a00.x, a00.y, a01.x, a01.y}), b0, acc0, 0, 0, 0);
        acc1 = __builtin_amdgcn_mfma_f32_32x32x16_bf16(__builtin_bit_cast(bf16x8, (u32x4){a10.x, a10.y, a11.x, a11.y}), b1, acc1, 0, 0, 0);
    }
    accm = acc0 + acc1;
    {
        const int h4 = lane >> 4; f32x4 t = (f32x4){0.f, 0.f, 0.f, 0.f};
        const int s_lo = 17 * wave, s_hi = (s_lo + 17 < 129) ? s_lo + 17 : 129;
        const int pt = 32 - n16 + 8 * h4; const int ct = pt & 3; const LAS unsigned char* kt = lds + LC_KC + ct * LC_KCS + 2 * (pt - ct);
        const LAS unsigned char* ut = lds + uin_off + (n16 & 1) * 10240 + h4 * 2560 + 16 * 15;
        for (int s = s_lo; s < s_hi; ++s) {
            const u32x2 a0 = *(const LAS u32x2*)(kt + 64 * s), a1 = *(const LAS u32x2*)(kt + 64 * s + 8);
            u32x4 bw = *(const LAS u32x4*)(ut + 16 * s); if (n16 >= 2) bw = (u32x4){0u, 0u, 0u, 0u};
            t = __builtin_amdgcn_mfma_f32_16x16x32_bf16(__builtin_bit_cast(bf16x8, (u32x4){a0.x, a0.y, a1.x, a1.y}), __builtin_bit_cast(bf16x8, bw), t, 0, 0, 0);
        }
        if (n16 < 2) { LAS float* tl = (LAS float*)(lds + LC_TAIL) + n16 * 16 + 4 * h4;
#pragma unroll
            for (int r = 0; r < 4; ++r) (void)__hip_atomic_fetch_add(tl + r, t[r], __ATOMIC_RELAXED, __HIP_MEMORY_SCOPE_WORKGROUP); }
    }
}
__device__ __forceinline__ void phase_longconv(const Params& p, LAS unsigned char* lds, int jl, int vcu, int G, int tid, int wave, int lane) {
    const bf16_t* UT = (const bf16_t*)(p.ws + WS_P); bf16_t* YT = (bf16_t*)(p.ws + WS_YT); const bf16_t* KT = (const bf16_t*)(p.ws + WS_KT);
    const float* wsh = p.in[I_HYSHORT] + (size_t)jl * 3 * 4096 * 3; const float* hb = p.in[I_HYBIAS] + (size_t)jl * 2 * 4096;
    for (int i = tid; i < 2 * LC_US / 16; i += NTHR) *(LAS u32x4*)(lds + LC_U1 + 16 * i) = (u32x4){0u, 0u, 0u, 0u};
    __syncthreads();
    const int i32 = lane & 31, h = lane >> 5, n16 = lane & 15, bl = (lane >> 4) & 1;
    for (int c = vcu; c < 4096; c += G) {
        const bf16_t* vrow = UT + (size_t)c * MP; const bf16_t* x1row = UT + (size_t)(4096 + c) * MP; const bf16_t* x2row = UT + (size_t)(8192 + c) * MP; const bf16_t* grow = UT + (size_t)(12288 + c) * MP;
        const float bias0 = hb[c], bias1 = hb[4096 + c];
        for (int it = tid; it < 2 * 514; it += NTHR) {
            const int b = it / 514, gl = it % 514; float o[8];
            lc_shortconv(vrow, b, gl, wsh[c * 3 + 0], wsh[c * 3 + 1], wsh[c * 3 + 2], o);
            *(LAS u32x4*)(lds + LC_U1 + lc_ugran(b, gl + 60)) = (u32x4){pk2(o[0], o[1]), pk2(o[2], o[3]), pk2(o[4], o[5]), pk2(o[6], o[7])};
            lc_shortconv(x1row, b, gl, wsh[(4096 + c) * 3 + 0], wsh[(4096 + c) * 3 + 1], wsh[(4096 + c) * 3 + 2], o);
            *(LAS u32x4*)(lds + LC_X1 + b * 8224 + 16 * gl) = (u32x4){pk2(o[0], o[1]), pk2(o[2], o[3]), pk2(o[4], o[5]), pk2(o[6], o[7])};
            lc_shortconv(x2row, b, gl, wsh[(8192 + c) * 3 + 0], wsh[(8192 + c) * 3 + 1], wsh[(8192 + c) * 3 + 2], o);
            *(LAS u32x4*)(lds + LC_X2 + b * 8224 + 16 * gl) = (u32x4){pk2(o[0], o[1]), pk2(o[2], o[3]), pk2(o[4], o[5]), pk2(o[6], o[7])};
        }
        lc_stage_filter(KT + ((size_t)(jl * 2 + 0) * 4096 + c) * KLEN, lds, tid);
        if (tid < 32) ((LAS float*)(lds + LC_TAIL))[tid] = 0.f;
        __syncthreads();
        f32x16 acc;
        lc_conv(lds, LC_U1, wave, lane, acc);
        __syncthreads();
        {
            const int I = 16 * wave + n16;
#pragma unroll
            for (int rg = 0; rg < 4; ++rg) { const int t = 32 * I + 8 * rg + 4 * h; const int G8 = (t + 480) >> 3; const int uoff = lc_ugran(bl, G8) + 2 * (t & 7);
                const u32x2 uu = *(const LAS u32x2*)(lds + LC_U1 + uoff); const u32x2 xx = *(const LAS u32x2*)(lds + LC_X1 + bl * 8224 + 2 * t);
                const float z0 = bflo(xx.x) * (acc[4 * rg + 0] + bias0 * bflo(uu.x)), z1 = bfhi(xx.x) * (acc[4 * rg + 1] + bias0 * bfhi(uu.x));
                const float z2 = bflo(xx.y) * (acc[4 * rg + 2] + bias0 * bflo(uu.y)), z3 = bfhi(xx.y) * (acc[4 * rg + 3] + bias0 * bfhi(uu.y));
                *(LAS u32x2*)(lds + LC_U2 + uoff) = (u32x2){pk2(z0, z1), pk2(z2, z3)}; }
            if (tid < 32) { const int b = tid >> 4, i = tid & 15, t = 4096 + i; const int uoff = lc_ugran(b, (t + 480) >> 3) + 2 * (t & 7);
                const float u = bf1(*(const LAS bf16_t*)(lds + LC_U1 + uoff)), x = bf1(*(const LAS bf16_t*)(lds + LC_X1 + b * 8224 + 2 * t));
                const float y = ((LAS float*)(lds + LC_TAIL))[b * 16 + i];
                *(LAS bf16_t*)(lds + LC_U2 + uoff) = (bf16_t)f2bf(x * (y + bias0 * u)); }
        }
        __syncthreads();
        lc_stage_filter(KT + ((size_t)(jl * 2 + 1) * 4096 + c) * KLEN, lds, tid);
        if (tid < 32) ((LAS float*)(lds + LC_TAIL))[tid] = 0.f;
        __syncthreads();
        lc_conv(lds, LC_U2, wave, lane, acc);
        __syncthreads();
        {
            const int I = 16 * wave + n16;
#pragma unroll
            for (int rg = 0; rg < 4; ++rg) { const int t = 32 * I + 8 * rg + 4 * h; const int G8 = (t + 480) >> 3; const int uoff = lc_ugran(bl, G8) + 2 * (t & 7);
                const u32x2 zz = *(const LAS u32x2*)(lds + LC_U2 + uoff); const u32x2 xx = *(const LAS u32x2*)(lds + LC_X2 + bl * 8224 + 2 * t);
                const int row = lc_tokrow(bl, t); const u32x2 gg = *(const u32x2*)(grow + row);
                const float o0 = bflo(xx.x) * (acc[4 * rg + 0] + bias1 * bflo(zz.x)) * bflo(gg.x), o1 = bfhi(xx.x) * (acc[4 * rg + 1] + bias1 * bfhi(zz.x)) * bfhi(gg.x);
                const float o2 = bflo(xx.y) * (acc[4 * rg + 2] + bias1 * bflo(zz.y)) * bflo(gg.y), o3 = bfhi(xx.y) * (acc[4 * rg + 3] + bias1 * bfhi(zz.y)) * bfhi(gg.y);
                *(u32x2*)(YT + (size_t)c * MP + row) = (u32x2){pk2(o0, o1), pk2(o2, o3)}; }
            if (tid < 32) { const int b = tid >> 4, i = tid & 15, t = 4096 + i; const int uoff = lc_ugran(b, (t + 480) >> 3) + 2 * (t & 7);
                const float z = bf1(*(const LAS bf16_t*)(lds + LC_U2 + uoff)), x = bf1(*(const LAS bf16_t*)(lds + LC_X2 + b * 8224 + 2 * t));
                const float y = ((LAS float*)(lds + LC_TAIL))[b * 16 + i]; const int row = lc_tokrow(b, t);
                YT[(size_t)c * MP + row] = (bf16_t)f2bf(x * (y + bias1 * z) * bf1(grow[row])); }
        }
        __syncthreads();
    }
}
__device__ __forceinline__ void phase_transpose(const Params& p, LAS unsigned char* lds, int gw, int NGW, int wave, int lane) {
    const bf16_t* YT = (const bf16_t*)(p.ws + WS_YT); bf16_t* Y = (bf16_t*)(p.ws + WS_Y);
    LAS bf16_t* tile = (LAS bf16_t*)(lds + wave * 8704);
    constexpr int NTT = MP / 64;
    for (int it = gw; it < (D / 64) * NTT; it += NGW) {
        const int ct = it / NTT, tt = it % NTT; const int c0 = 64 * ct, t0 = 64 * tt;
#pragma unroll
        for (int k = 0; k < 8; ++k) { const int cl = 8 * k + (lane >> 3), ch = lane & 7; const u32x4 v = *(const u32x4*)(YT + (size_t)(c0 + cl) * MP + t0 + 8 * ch);
            LAS unsigned* d = (LAS unsigned*)(tile + cl * 68 + 8 * ch); d[0] = v.x; d[1] = v.y; d[2] = v.z; d[3] = v.w; }
        LDS_WAIT(); asm volatile("" ::: "memory");
#pragma unroll
        for (int k = 0; k < 8; ++k) { const int tl = 8 * k + (lane >> 3), ch = lane & 7; const LAS bf16_t* s = tile + (8 * ch) * 68 + tl;
            u32x4 o; o.x = (unsigned)s[0] | ((unsigned)s[68] << 16); o.y = (unsigned)s[2 * 68] | ((unsigned)s[3 * 68] << 16); o.z = (unsigned)s[4 * 68] | ((unsigned)s[5 * 68] << 16); o.w = (unsigned)s[6 * 68] | ((unsigned)s[7 * 68] << 16);
            *(u32x4*)(Y + (size_t)(t0 + tl) * D + c0 + 8 * ch) = o; }
        LDS_WAIT(); asm volatile("" ::: "memory");
    }
}
#define GEMM_ALIGN true
#define GEMM_SP2 true
__global__ void __launch_bounds__(NTHR, 2) mk_fwd(Params p) {
    extern __shared__ __attribute__((aligned(16))) unsigned char lds_raw[];
    LAS unsigned char* lds = (LAS unsigned char*)lds_raw;
    volatile LAS unsigned* MISC = (volatile LAS unsigned*)(lds + MISC_OFF);
    const int tid = threadIdx.x, lane = tid & 63, wave = __builtin_amdgcn_readfirstlane(tid >> 6);
    const int G = gridDim.x; const int bx = blockIdx.x; const int vcu = (G % 8 == 0) ? (bx % 8) * (G / 8) + bx / 8 : bx;
    const int gw = vcu * NWAVES + wave, NGW = G * NWAVES;
    unsigned char* ws = p.ws;
    for (int u = tid; u < (LDS_BYTES - MISC_OFF) / 4; u += NTHR) MISC[u] = 0u;
    __syncthreads();
    XcdBarrier bar; bar.bar = (unsigned*)(ws + WS_CTL) + CW_BAR; bar.x = 0; bar.st = nullptr;
#if !MK_PER_PHASE
    bar = xcd_barrier_post((unsigned*)(ws + WS_CTL) + CW_BAR, MISC);
#endif
    const int lo = p.ph_lo, hi = p.ph_hi;
#define FRESH() int tid_ = threadIdx.x; asm volatile("" : "+v"(tid_)); const int lane_ = tid_ & 63, wave_ = __builtin_amdgcn_readfirstlane(tid_ >> 6); \
    int vcu_ = vcu; asm volatile("" : "+s"(vcu_)); const int gw_ = vcu_ * NWAVES + wave_; Params q = p; { unsigned char* w_ = q.ws; asm volatile("" : "+s"(w_)); q.ws = w_; } unsigned char* ws_ = q.ws; (void)lane_; (void)gw_; (void)ws_;
#define IN(k) (lo <= (k) && (k) < hi)
#if MK_PER_PHASE
#define SEAM(k) do { } while (0)
#else
#define SEAM(k) do { if (IN(k) && IN((k) + 1)) xcd_barrier(bar); } while (0)
#endif
    if (IN(0)) { FRESH() phase_prologue(q, lds, gw_, NGW, wave_, lane_); } SEAM(0);
    if (IN(1)) { FRESH() phase_filtergen(q, gw_, NGW, lane_); } SEAM(1);
    for (int jp = 0; jp < 2; ++jp) {
        const int pb = 2 + 10 * jp;
        if (IN(pb + 0)) { FRESH() const bf16_t* HN = (const bf16_t*)(ws_ + WS_HN);
            const bf16_t* W = (const bf16_t*)(ws_ + WS_WEIN) + (size_t)jp * EIN * D;
            pg8::DualOrder S; S.init(HN, W, MP, EIN - 2048, W + (size_t)4096 * D, HN, 2048, MP, D, G, bx, 16, 8);
            pg8::EpiEvenIn E{(bf16_t*)(ws_ + WS_P), EIN, (bf16_t*)(ws_ + WS_VT), MP, (const float*)(ws_ + WS_LB) + (size_t)jp * 4096};
            pg8::gemm_phase<pg8::EpiEvenIn, pg8::DualOrder, GEMM_ALIGN, GEMM_SP2>(lds, D, S, E);
        } SEAM(pb + 0);
        if (IN(pb + 1)) { FRESH()
#if MK_DBG == 1
            { const u32x4* s = (const u32x4*)(ws_ + WS_HN); u32x4* d = (u32x4*)(ws_ + WS_Y); for (size_t i = (size_t)bx * NTHR + tid_; i < (size_t)MP * D / 8; i += (size_t)G * NTHR) d[i] = s[i]; }
#else
#if MK_DBG == 4
            { const bf16_t* Pd = (const bf16_t*)(ws_ + WS_P); float* O0 = (float*)(ws_ + WS_OBP); float* O1 = O0 + (size_t)MP * 2048;
              for (size_t i = (size_t)bx * NTHR + tid_; i < (size_t)MV * 2048; i += (size_t)G * NTHR) { const size_t r = i / 2048, c = i % 2048;
                O0[r * 2048 + c] = bf1(Pd[r * EIN + QB_OFF + c]) + bf1(Pd[r * EIN + IB_OFF + c]); O1[r * 2048 + c] = bf1(Pd[r * EIN + FF_OFF + c]) + bf1(Pd[r * EIN + FB_OFF + c]); } }
#elif MK_DBG != 2
            for (int item = bx; item < 256; item += G) hgrn_item(q, lds, item, tid_, wave_, lane_);
#endif
#if MK_DBG != 3 && MK_DBG != 4
            for (int it = gw_; it < 8192 + 32; it += NGW) natten_item(q, it, jp, lane_);
#endif
#endif
        } SEAM(pb + 1);
        if (IN(pb + 2)) { FRESH()
#if MK_DBG == 0
            phase_combine(q, jp, gw_, NGW, lane_);
#elif MK_DBG == 2
            { bf16_t* Yd = (bf16_t*)(ws_ + WS_Y); for (size_t i = (size_t)bx * NTHR + tid_; i < (size_t)MP * 256; i += (size_t)G * NTHR) { const size_t r = i / 256, c8 = i % 256; *(u32x4*)(Yd + r * D + 2048 + 8 * c8) = (u32x4){0u, 0u, 0u, 0u}; } }
#elif MK_DBG == 3 || MK_DBG == 4
            phase_combine(q, jp, gw_, NGW, lane_);
            { bf16_t* Yd = (bf16_t*)(ws_ + WS_Y); for (size_t i = (size_t)bx * NTHR + tid_; i < (size_t)MP * 256; i += (size_t)G * NTHR) { const size_t r = i / 256, c8 = i % 256; *(u32x4*)(Yd + r * D + 8 * c8) = (u32x4){0u, 0u, 0u, 0u}; } }
#endif
        } SEAM(pb + 2);
        if (IN(pb + 3)) { FRESH()
            pg8::DualOrder S; S.init(ws_ + WS_Y, (const bf16_t*)(ws_ + WS_WEOUT) + (size_t)jp * D * D, MP, D, nullptr, nullptr, 0, 0, D, G, bx, 1 << 30, 0);
            pg8::EpiF32 E{(float*)(ws_ + WS_OUT), D};
            pg8::gemm_phase<pg8::EpiF32, pg8::DualOrder, GEMM_ALIGN, GEMM_SP2>(lds, D, S, E);
        } SEAM(pb + 3);
        if (IN(pb + 4)) { FRESH() phase_postnorm(q, 2 * jp, gw_, NGW, lane_); } SEAM(pb + 4);
        if (IN(pb + 5)) { FRESH() const bf16_t* HN = (const bf16_t*)(ws_ + WS_HN);
            pg8::DualOrder S; S.init((const bf16_t*)(ws_ + WS_WOIN) + (size_t)jp * OIN * D, HN, OIN, MP, nullptr, nullptr, 0, 0, D, G, bx, 1 << 30, 0);
            pg8::EpiOddIn E{(bf16_t*)(ws_ + WS_P), MP, 48};
            pg8::gemm_phase<pg8::EpiOddIn, pg8::DualOrder, GEMM_ALIGN, GEMM_SP2>(lds, D, S, E);
        } SEAM(pb + 5);
        if (IN(pb + 6)) { FRESH() phase_longconv(q, lds, jp, vcu_, G, tid_, wave_, lane_); } SEAM(pb + 6);
        if (IN(pb + 7)) { FRESH() phase_transpose(q, lds, gw_, NGW, wave_, lane_); } SEAM(pb + 7);
        if (IN(pb + 8)) { FRESH()
            pg8::DualOrder S; S.init(ws_ + WS_Y, (const bf16_t*)(ws_ + WS_WOOUT) + (size_t)jp * D * D, MP, D, nullptr, nullptr, 0, 0, D, G, bx, 1 << 30, 0);
            pg8::EpiF32 E{(float*)(ws_ + WS_OUT), D};
            pg8::gemm_phase<pg8::EpiF32, pg8::DualOrder, GEMM_ALIGN, GEMM_SP2>(lds, D, S, E);
        } SEAM(pb + 8);
        if (IN(pb + 9)) { FRESH() phase_postnorm(q, 2 * jp + 1, gw_, NGW, lane_); } SEAM(pb + 9);
    }
#undef IN
#undef SEAM
}

extern "C" void kernel_launch(void* const* d_in, const int* in_sizes, int n_in, void* d_out, int out_size, void* d_ws, size_t ws_size, hipStream_t stream) {
    static int grid = 0;
    if (grid == 0) {
        if (n_in != 21 || ws_size < WS_END) { fprintf(stderr, "kernel_launch: expected 21 inputs and >= %zu bytes of workspace; got %d, %zu\n", (size_t)WS_END, n_in, ws_size); grid = -1; return; }
        int dev = 0, cus = 0, per_cu = 0;
        if (hipGetDevice(&dev) != hipSuccess || hipDeviceGetAttribute(&cus, hipDeviceAttributeMultiprocessorCount, dev) != hipSuccess) { grid = -1; return; }
        if (hipFuncSetAttribute((const void*)mk_fwd, hipFuncAttributeMaxDynamicSharedMemorySize, LDS_BYTES) != hipSuccess) { fprintf(stderr, "kernel_launch: hipFuncSetAttribute failed\n"); grid = -1; return; }
        if (hipOccupancyMaxActiveBlocksPerMultiprocessor(&per_cu, (const void*)mk_fwd, NTHR, LDS_BYTES) != hipSuccess || per_cu < 1)
            fprintf(stderr, "kernel_launch: note: occupancy query reports %d workgroups per CU\n", per_cu);
        (void)hipGetLastError();
        grid = cus;
    }
    if (grid < 0) return;
    if (hipMemsetAsync((char*)d_ws + WS_CTL, 0, CTL_ZERO_BYTES, stream) != hipSuccess) return;
    Params a{};
    for (int i = 0; i < 21; ++i) a.in[i] = (const float*)d_in[i];
    a.out = (float*)d_out; a.ws = (unsigned char*)d_ws;
#if MK_PER_PHASE
    for (int ph = 0; ph < 2 + 5 * MK_NLAYERS; ++ph) { a.ph_lo = ph; a.ph_hi = ph + 1; hipLaunchKernelGGL(mk_fwd, dim3(grid), dim3(NTHR), LDS_BYTES, stream, a); }
#else
    a.ph_lo = 0; a.ph_hi = 2 + 5 * MK_NLAYERS; hipLaunchKernelGGL(mk_fwd, dim3(grid), dim3(NTHR), LDS_BYTES, stream, a);
#endif
    const hipError_t le = hipPeekAtLastError();
    if (le != hipSuccess) fprintf(stderr, "kernel_launch: launch failed: %s\n", hipGetErrorName(le));
}
```

```cpp
#include <hip/hip_runtime.h>
#include <cstdio>
#include <cstdint>
#ifndef MK_PER_PHASE
#define MK_PER_PHASE 0
#endif
#ifndef MK_TIME_MASK
#define MK_TIME_MASK 0u
#endif
#ifndef MK_TIME_MULT
#define MK_TIME_MULT 4
#endif
#ifndef MK_SUBPROBE
#define MK_SUBPROBE 0
#endif
#ifndef MK_LCX
#define MK_LCX 0
#endif
namespace pg8 {
#define PG8_LAS __attribute__((address_space(3)))
typedef unsigned short bf16_t;
typedef short bf16x8 __attribute__((ext_vector_type(8)));
typedef float f32x4 __attribute__((ext_vector_type(4)));
typedef unsigned u32x4 __attribute__((ext_vector_type(4)));
constexpr int BM = 256, BK = 64, HALF = 128, HTB = HALF * BK * 2  , STAGE_BYTES = 8 * HTB, NXCD = 8, WGM = 8;

__host__ __device__ __forceinline__ int lds_byte(int r, int c) { const int st = (r >> 4) * 2 + (c >> 5), rr = r & 15, cc = c & 31, ob = rr * 64 + cc * 2; return st * 1024 + (ob ^ (((ob >> 9) & 1) << 5)); }
__host__ __device__ __forceinline__ void stage_rc(int b, int& R, int& C) { const int st = b / 1024, sb = b % 1024, swz = sb ^ (((sb >> 9) & 1) << 5); R = (st >> 1) * 16 + swz / 64; C = (st & 1) * 32 + (swz % 64) / 2; }
__host__ __device__ __forceinline__ int perm32(int rho) { const int n = rho >> 4, i = rho & 15; return 8 * (i >> 2) + 4 * n + (i & 3); }

struct Unit { int pm, pn, kind; };

struct DualOrder {
    const char *A0, *B0, *A1, *B1; int nM0, nN0, n0, nM1, nN1, n1, G, c, skip_lo, skip_n; size_t tstep;
    __device__ void init(const void* a0, const void* b0, int M0, int N0, const void* a1, const void* b1, int M1, int N1, int K, int G_, int c_, int sl, int sn) {
        A0 = (const char*)a0; B0 = (const char*)b0; A1 = (const char*)a1; B1 = (const char*)b1; nM0 = M0 / BM; nN0 = N0 / BM; n0 = nM0 * nN0; nM1 = M1 / BM; nN1 = N1 / BM; n1 = nM1 * nN1;
        G = G_; c = c_; skip_lo = sl; skip_n = sn; tstep = (size_t)BM * K * 2; }
    __device__ bool next(int i, Unit& u) const {
        const long L = (long)i * G + c; const int nwg = n0 + n1; if (L >= nwg) return false;
        int wgid = (int)L; { const int q = nwg / NXCD, r = nwg % NXCD, xcd = wgid % NXCD, off = wgid / NXCD; wgid = (xcd < r ? xcd * (q + 1) : r * (q + 1) + (xcd - r) * q) + off; }
        int nM, nN, kind;
        if (wgid < n0) { nM = nM0; nN = nN0; kind = 0; } else { wgid -= n0; nM = nM1; nN = nN1; kind = 1; }
        const int nig = WGM * nN, gid = wgid / nig, fm = gid * WGM, gsz = (nM - fm) < WGM ? (nM - fm) : WGM;
        u.pm = fm + ((wgid % nig) % gsz); int pn = (wgid % nig) / gsz; if (kind == 0 && pn >= skip_lo) pn += skip_n; u.pn = pn; u.kind = kind; return true;
    }
    __device__ __forceinline__ const char* abase(const Unit& u) const { return (u.kind ? A1 : A0) + (size_t)u.pm * tstep; }
    __device__ __forceinline__ const char* bbase(const Unit& u) const { return (u.kind ? B1 : B0) + (size_t)u.pn * tstep; }
    __device__ __forceinline__ void a_ready(const Unit&) const {}
    __device__ __forceinline__ void done(const Unit&) const {}
};

typedef __bf16 bf16x2_t __attribute__((ext_vector_type(2)));
typedef float f32x2_t __attribute__((ext_vector_type(2)));
__device__ __forceinline__ unsigned cvt_pk_bf16(float lo, float hi) { const f32x2_t v = {lo, hi}; const bf16x2_t b = __builtin_convertvector(v, bf16x2_t); return __builtin_bit_cast(unsigned, b); }

struct EpiF32 {
    static constexpr bool PERM = false, AFTER_DRAIN = false;
    float* C; int ldc;
    __device__ __forceinline__ void operator()(const f32x4 (&acc)[2][2][4][2], const Unit& u, int wr, int wc, int fr, int fq) const {
        const int row0 = u.pm * BM + wr * 64 + fr, col0 = u.pn * BM + wc * 32 + 4 * fq;
#pragma unroll
        for (int ai = 0; ai < 2; ++ai)
#pragma unroll
            for (int m = 0; m < 4; ++m) { float* rowp = C + (size_t)(row0 + ai * HALF + m * 16) * ldc + col0;
#pragma unroll
                for (int bj = 0; bj < 2; ++bj)
#pragma unroll
                    for (int n = 0; n < 2; ++n) *(f32x4*)(rowp + bj * HALF + n * 16) = acc[ai][bj][m][n]; }
    }
};
struct EpiBf16Plain {
    static constexpr bool PERM = true, AFTER_DRAIN = false;
    bf16_t* O; int ldc;
    __device__ __forceinline__ void operator()(const f32x4 (&acc)[2][2][4][2], const Unit& u, int wr, int wc, int fr, int fq) const {
        const int row0 = u.pm * BM + wr * 64 + fr; const int col0 = u.pn * BM + wc * 32 + 8 * fq;
#pragma unroll
        for (int ai = 0; ai < 2; ++ai)
#pragma unroll
            for (int m = 0; m < 4; ++m) { bf16_t* rowp = O + (size_t)(row0 + ai * HALF + m * 16) * ldc + col0;
#pragma unroll
                for (int bj = 0; bj < 2; ++bj) { const f32x4 v0 = acc[ai][bj][m][0], v1 = acc[ai][bj][m][1];
                    u32x4 w; w.x = cvt_pk_bf16(v0[0], v0[1]); w.y = cvt_pk_bf16(v0[2], v0[3]); w.z = cvt_pk_bf16(v1[0], v1[1]); w.w = cvt_pk_bf16(v1[2], v1[3]);
                    *(u32x4*)(rowp + bj * HALF) = w; } }
    }
};
__device__ __forceinline__ float silu_f(float x) { return x * __builtin_amdgcn_rcpf(1.0f + __expf(-x)); }
struct EpiEvenIn {
    static constexpr bool PERM = true, AFTER_DRAIN = false;
    bf16_t* P; int ldp; bf16_t* VT; int ldv; const float* lb;
    __device__ __forceinline__ void operator()(const f32x4 (&acc)[2][2][4][2], const Unit& u, int wr, int wc, int fr, int fq) const {
        const int row0 = u.pm * BM + wr * 64 + fr; const int col0 = u.pn * BM + wc * 32 + 8 * fq;
        bf16_t* base = u.kind ? VT : P; const int ldc = u.kind ? ldv : ldp;
        const int seg = u.kind ? 1 : (u.pn >> 3);
        const int mode = (seg == 0) ? 1 : (seg == 3) ? 2 : (seg == 5 || seg == 6) ? 3 : (seg >= 7) ? 4 : 0;
        f32x4 lbv[2][2];
#pragma unroll
        for (int bj = 0; bj < 2; ++bj)
#pragma unroll
            for (int n = 0; n < 2; ++n) lbv[bj][n] = (mode == 3) ? *(const f32x4*)(lb + (seg - 5) * 2048 + ((col0 + bj * HALF + 4 * n) & 2047)) : (f32x4){0.f, 0.f, 0.f, 0.f};
#pragma unroll
        for (int ai = 0; ai < 2; ++ai)
#pragma unroll
            for (int m = 0; m < 4; ++m) { bf16_t* rowp = base + (size_t)(row0 + ai * HALF + m * 16) * ldc + col0;
#pragma unroll
                for (int bj = 0; bj < 2; ++bj) { f32x4 v[2] = {acc[ai][bj][m][0], acc[ai][bj][m][1]};
                    if (mode == 1) { v[0] = v[0] * 0.08838834764831845f; v[1] = v[1] * 0.08838834764831845f; }
                    else if (mode == 2) {
#pragma unroll
                        for (int n = 0; n < 2; ++n)
#pragma unroll
                            for (int k = 0; k < 4; ++k) v[n][k] = silu_f(v[n][k]) * 0.08838834764831845f; }
                    else if (mode == 3) {
#pragma unroll
                        for (int n = 0; n < 2; ++n)
#pragma unroll
                            for (int k = 0; k < 4; ++k) { const float x = fminf(fmaxf(v[n][k], -80.f), 80.f); const float sg = __builtin_amdgcn_rcpf(1.0f + __expf(-x)); const float l0 = lbv[bj][n][k];
                                v[n][k] = __logf(l0 + (1.0f - l0) * sg); } }
                    else if (mode == 4) {
#pragma unroll
                        for (int n = 0; n < 2; ++n)
#pragma unroll
                            for (int k = 0; k < 4; ++k) v[n][k] = silu_f(v[n][k]); }
                    u32x4 w; w.x = cvt_pk_bf16(v[0][0], v[0][1]); w.y = cvt_pk_bf16(v[0][2], v[0][3]); w.z = cvt_pk_bf16(v[1][0], v[1][1]); w.w = cvt_pk_bf16(v[1][2], v[1][3]);
                    *(u32x4*)(rowp + bj * HALF) = w; } }
    }
};
struct EpiOddIn {
    static constexpr bool PERM = true, AFTER_DRAIN = false;
    bf16_t* O; int ldc; int gate_pm0;
    __device__ __forceinline__ void operator()(const f32x4 (&acc)[2][2][4][2], const Unit& u, int wr, int wc, int fr, int fq) const {
        const int row0 = u.pm * BM + wr * 64 + fr; const int col0 = u.pn * BM + wc * 32 + 8 * fq; const bool gate = u.pm >= gate_pm0;
#pragma unroll
        for (int ai = 0; ai < 2; ++ai)
#pragma unroll
            for (int m = 0; m < 4; ++m) { bf16_t* rowp = O + (size_t)(row0 + ai * HALF + m * 16) * ldc + col0;
#pragma unroll
                for (int bj = 0; bj < 2; ++bj) { f32x4 v[2] = {acc[ai][bj][m][0], acc[ai][bj][m][1]};
                    if (gate) {
#pragma unroll
                        for (int n = 0; n < 2; ++n)
#pragma unroll
                            for (int k = 0; k < 4; ++k) v[n][k] = silu_f(v[n][k]); }
                    u32x4 w; w.x = cvt_pk_bf16(v[0][0], v[0][1]); w.y = cvt_pk_bf16(v[0][2], v[0][3]); w.z = cvt_pk_bf16(v[1][0], v[1][1]); w.w = cvt_pk_bf16(v[1][2], v[1][3]);
                    *(u32x4*)(rowp + bj * HALF) = w; } }
    }
};
template <class Epi, class Sched, bool ALIGN_EPI = false, bool SP2 = false>
__device__ __forceinline__ void gemm_phase(PG8_LAS unsigned char* lds, const int K, const Sched& S, const Epi& E) {
    int tid = threadIdx.x; asm volatile("" : "+v"(tid));
    const int wid = __builtin_amdgcn_readfirstlane(tid >> 6), lane = tid & 63, wr = wid >> 2, wc = wid & 3, fr = lane & 15, fq = lane >> 4;
    const int nt = K / BK;
    unsigned voffA[2], voffB[2];
#pragma unroll
    for (int i = 0; i < 2; ++i) { int R, C; stage_rc(tid * 16 + i * 8192, R, C); const int Rb = Epi::PERM ? ((R & ~31) + perm32(R & 31)) : R;
        voffA[i] = (unsigned)(R * K + C) * 2u; voffB[i] = (unsigned)(Rb * K + C) * 2u; }
    const size_t kstep = (size_t)(BK * 2);
    const size_t hstep = (size_t)HALF * K * 2;
    const size_t tstep = 2 * hstep;
    const unsigned ldsw = (unsigned)wid * 1024u;
    const int aoff = lds_byte(wr * 64 + fr, fq * 8), boff = lds_byte(wc * 32 + fr, fq * 8);
#define PG8_SA(b, h) (((b) * 2 + (h)) * HTB)
#define PG8_SB(b, h) ((4 + (b) * 2 + (h)) * HTB)
#define PG8_STAGE(bufoff, gbase, voff) do { _Pragma("unroll") for (int _i = 0; _i < 2; ++_i) \
        __builtin_amdgcn_global_load_lds((const unsigned*)((const char*)(gbase) + (voff)[_i]), (PG8_LAS unsigned*)(lds + (bufoff) + ldsw + _i * 8192), 16, 0, 0); } while (0)
#define PG8_LDA(dst, b, h) do { _Pragma("unroll") for (int m = 0; m < 4; ++m) _Pragma("unroll") for (int k = 0; k < 2; ++k) dst[m][k] = *(const PG8_LAS bf16x8*)(lds + PG8_SA(b, h) + aoff + m * 2048 + k * 1024); } while (0)
#define PG8_LDB(dst, b, h) do { _Pragma("unroll") for (int n = 0; n < 2; ++n) _Pragma("unroll") for (int k = 0; k < 2; ++k) dst[n][k] = *(const PG8_LAS bf16x8*)(lds + PG8_SB(b, h) + boff + n * 2048 + k * 1024); } while (0)
#define PG8_MMA(ai, bj, At, Bt) do { __builtin_amdgcn_s_setprio(1); _Pragma("unroll") for (int m = 0; m < 4; ++m) _Pragma("unroll") for (int n = 0; n < 2; ++n) _Pragma("unroll") for (int k = 0; k < 2; ++k) \
        acc[ai][bj][m][n] = __builtin_amdgcn_mfma_f32_16x16x32_bf16(Bt[n][k], At[m][k], acc[ai][bj][m][n], 0, 0, 0); __builtin_amdgcn_s_setprio(0); } while (0)
#define PG8_WAIT_V(n) asm volatile("s_waitcnt vmcnt(" #n ")" ::: "memory")
#define PG8_WAIT_L(n) asm volatile("s_waitcnt lgkmcnt(" #n ")" ::: "memory")
#define PG8_BAR __builtin_amdgcn_s_barrier()
#define PG8_SCHED __builtin_amdgcn_sched_barrier(0)
    Unit cur, nxt; int ui = 0;
    if (!S.next(0, cur)) return;
    f32x4 acc[2][2][4][2];
#pragma unroll
    for (int a = 0; a < 2; ++a)
#pragma unroll
        for (int b = 0; b < 2; ++b)
#pragma unroll
            for (int m = 0; m < 4; ++m)
#pragma unroll
                for (int n = 0; n < 2; ++n) acc[a][b][m][n] = (f32x4){0.f, 0.f, 0.f, 0.f};
    bf16x8 At[4][2], B0[2][2], B1[2][2];
    const char* cA = S.abase(cur); const char* cB = S.bbase(cur);
    S.a_ready(cur);
    if constexpr (SP2) {
        PG8_STAGE(PG8_SB(0, 0), cB, voffB); PG8_STAGE(PG8_SB(0, 1), cB + hstep, voffB); PG8_STAGE(PG8_SA(0, 0), cA, voffA); PG8_STAGE(PG8_SA(0, 1), cA + hstep, voffA);
        if (wr == 1) PG8_BAR;
        PG8_WAIT_V(2); PG8_BAR;
        PG8_STAGE(PG8_SB(1, 0), cB + kstep, voffB); PG8_STAGE(PG8_SA(1, 0), cA + kstep, voffA); PG8_STAGE(PG8_SB(1, 1), cB + hstep + kstep, voffB);
        PG8_WAIT_V(6); PG8_BAR;
    } else {
        PG8_STAGE(PG8_SB(0, 0), cB, voffB); PG8_STAGE(PG8_SA(0, 0), cA, voffA); PG8_STAGE(PG8_SB(0, 1), cB + hstep, voffB); PG8_STAGE(PG8_SA(0, 1), cA + hstep, voffA);
        if (wr == 1) PG8_BAR;
        PG8_WAIT_V(4); PG8_BAR;
        PG8_STAGE(PG8_SB(1, 0), cB + kstep, voffB); PG8_STAGE(PG8_SA(1, 0), cA + kstep, voffA); PG8_STAGE(PG8_SB(1, 1), cB + hstep + kstep, voffB);
        PG8_WAIT_V(6); PG8_BAR;
    }
    for (;;) {
        const bool has_next = S.next(ui + 1, nxt);
        const char* nA = has_next ? S.abase(nxt) : cA; const char* nB = has_next ? S.bbase(nxt) : cB;
        for (int t = 0; t < nt; t += 2) {
            const bool last = (t == nt - 2);
            const char* a1 = cA + (size_t)(t + 1) * kstep;
            const char* a2 = last ? nA : cA + (size_t)(t + 2) * kstep; const char* b2 = last ? nB : cB + (size_t)(t + 2) * kstep;
            const char* a3 = a2 + kstep; const char* b3 = b2 + kstep;
            if (last && has_next) S.a_ready(nxt);
            if constexpr (SP2) {
            PG8_LDB(B0, 0, 0); PG8_LDB(B1, 0, 1); PG8_SCHED; PG8_LDA(At, 0, 0); PG8_STAGE(PG8_SA(1, 1), a1 + hstep, voffA);
            PG8_WAIT_V(8); PG8_WAIT_L(0); PG8_BAR; PG8_MMA(0, 0, At, B0); PG8_MMA(0, 1, At, B1); PG8_BAR; PG8_SCHED;
            PG8_LDA(At, 0, 1); PG8_STAGE(PG8_SB(0, 0), b2, voffB); PG8_STAGE(PG8_SB(0, 1), b2 + hstep, voffB); PG8_STAGE(PG8_SA(0, 0), a2, voffA);
            PG8_WAIT_V(8); PG8_WAIT_L(0); PG8_BAR; PG8_MMA(1, 0, At, B0); PG8_MMA(1, 1, At, B1); PG8_BAR; PG8_SCHED;
            PG8_LDB(B0, 1, 0); PG8_LDB(B1, 1, 1); PG8_SCHED; PG8_LDA(At, 1, 0); PG8_STAGE(PG8_SA(0, 1), a2 + hstep, voffA);
            PG8_WAIT_V(8); PG8_WAIT_L(0); PG8_BAR; PG8_MMA(0, 0, At, B0); PG8_MMA(0, 1, At, B1); PG8_BAR; PG8_SCHED;
            PG8_LDA(At, 1, 1); PG8_STAGE(PG8_SB(1, 0), b3, voffB); PG8_STAGE(PG8_SB(1, 1), b3 + hstep, voffB); PG8_STAGE(PG8_SA(1, 0), a3, voffA);
            PG8_WAIT_V(8); PG8_WAIT_L(0); PG8_BAR; PG8_MMA(1, 0, At, B0); PG8_MMA(1, 1, At, B1); PG8_BAR; PG8_SCHED;
            } else {
            PG8_LDB(B0, 0, 0); PG8_SCHED; PG8_LDA(At, 0, 0); PG8_STAGE(PG8_SA(1, 1), a1 + hstep, voffA);
            PG8_WAIT_L(8); PG8_BAR; PG8_WAIT_L(0); PG8_MMA(0, 0, At, B0); PG8_BAR; PG8_SCHED;
            PG8_LDB(B1, 0, 1); PG8_STAGE(PG8_SB(0, 0), b2, voffB);
            PG8_BAR; PG8_WAIT_L(0); PG8_MMA(0, 1, At, B1); PG8_BAR;
            PG8_LDA(At, 0, 1); PG8_STAGE(PG8_SA(0, 0), a2, voffA);
            PG8_BAR; PG8_WAIT_L(0); PG8_MMA(1, 0, At, B0); PG8_BAR; PG8_SCHED;
            PG8_STAGE(PG8_SB(0, 1), b2 + hstep, voffB);
            PG8_WAIT_V(6); PG8_BAR; PG8_MMA(1, 1, At, B1); PG8_BAR;
            PG8_LDB(B0, 1, 0); PG8_SCHED; PG8_LDA(At, 1, 0); PG8_STAGE(PG8_SA(0, 1), a2 + hstep, voffA);
            PG8_WAIT_L(8); PG8_BAR; PG8_WAIT_L(0); PG8_MMA(0, 0, At, B0); PG8_BAR; PG8_SCHED;
            PG8_LDB(B1, 1, 1); PG8_STAGE(PG8_SB(1, 0), b3, voffB);
            PG8_BAR; PG8_WAIT_L(0); PG8_MMA(0, 1, At, B1); PG8_BAR;
            PG8_LDA(At, 1, 1); PG8_STAGE(PG8_SA(1, 0), a3, voffA);
            PG8_BAR; PG8_WAIT_L(0); PG8_MMA(1, 0, At, B0); PG8_BAR; PG8_SCHED;
            PG8_STAGE(PG8_SB(1, 1), b3 + hstep, voffB);
            PG8_WAIT_V(6); PG8_BAR; PG8_MMA(1, 1, At, B1); PG8_BAR;
            }
        }
        if constexpr (ALIGN_EPI) { if (wr == 0) PG8_BAR; }
        if constexpr (!Epi::AFTER_DRAIN) { E(acc, cur, wr, wc, fr, fq); S.done(cur); }
        if (!has_next) break;
#pragma unroll
        for (int a = 0; a < 2; ++a)
#pragma unroll
            for (int b = 0; b < 2; ++b)
#pragma unroll
                for (int m = 0; m < 4; ++m)
#pragma unroll
                    for (int n = 0; n < 2; ++n) acc[a][b][m][n] = (f32x4){0.f, 0.f, 0.f, 0.f};
        cur = nxt; cA = nA; cB = nB; ++ui;
        if constexpr (ALIGN_EPI) { if (wr == 1) PG8_BAR; }
    }
    PG8_WAIT_V(0);
    if constexpr (!ALIGN_EPI) { if (wr == 0) PG8_BAR; }
    PG8_BAR;

#undef PG8_SA
#undef PG8_SB
#undef PG8_STAGE
#undef PG8_LDA
#undef PG8_LDB
#undef PG8_MMA
#undef PG8_WAIT_V
#undef PG8_WAIT_L
#undef PG8_BAR
#undef PG8_SCHED
}
}
constexpr int NB = 2, T = 4096, NMETA = 16, L = T + NMETA, D = 4096;
constexpr int MV = NB * L;
constexpr int MP = 8448;
constexpr int EIN = 18432, OIN = 16384, HD = 128;
constexpr int QA_OFF = 0, KA_OFF = 2048, QB_OFF = 6144, IB_OFF = 8192, FF_OFF = 10240, FB_OFF = 12288, GATE_OFF = 14336;
constexpr int KOFF = 4128, KLEN = 8256;
constexpr int LPAD = 4128;
constexpr float EPS = 1e-6f;
constexpr int NWAVES = 8, NTHR = 512;
constexpr int NPHASE = 24;
constexpr int NA_SPLIT = 0, NA_TAIL = 7680;

constexpr size_t MiB = 1u << 20;
constexpr size_t WS_CTL = 0, CTL_ZERO_BYTES = 1 * MiB;
constexpr size_t WS_WEIN = 1 * MiB;
constexpr size_t WS_WEOUT = WS_WEIN + 2 * (size_t)EIN * D * 2;
constexpr size_t WS_WOIN = WS_WEOUT + 2 * (size_t)D * D * 2;
constexpr size_t WS_WOOUT = WS_WOIN + 2 * (size_t)OIN * D * 2;
constexpr size_t WS_H = WS_WOOUT + 2 * (size_t)D * D * 2;
constexpr size_t WS_HN = WS_H + (size_t)MP * D * 4;
constexpr size_t WS_P = WS_HN + (size_t)MP * D * 2;
constexpr size_t WS_VT = WS_P + (size_t)MP * EIN * 2;
constexpr size_t WS_Y = WS_VT + (size_t)2048 * MP * 2;
constexpr size_t WS_YT = WS_Y + (size_t)MP * D * 2;
constexpr size_t WS_OBP = WS_YT + (size_t)MP * D * 2;
constexpr size_t WS_OUT = WS_OBP + (size_t)2 * MP * 2048 * 4;
constexpr size_t WS_KT = WS_OUT + (size_t)MP * D * 4;
constexpr size_t WS_HID2 = WS_KT + (size_t)2 * 2 * 4096 * KLEN * 2;
constexpr size_t WS_LB = WS_HID2 + (size_t)2 * LPAD * 64 * 2;
constexpr size_t WS_QSG = WS_LB + (size_t)2 * 2 * 2048 * 4;
constexpr size_t WS_KSG = WS_QSG + (size_t)4160 * 8192 * 2;
constexpr size_t WS_VTG = WS_KSG + (size_t)4160 * 8192 * 2;
constexpr size_t WS_DECG = WS_VTG + (size_t)4160 * 8192 * 2;
constexpr size_t WS_END = WS_DECG + (size_t)4160 * 128 * 4;
static_assert(WS_WEIN % 256 == 0 && WS_H % 256 == 0 && WS_P % 256 == 0 && WS_KT % 256 == 0 && WS_HID2 % 256 == 0 && WS_LB % 256 == 0, "alignment");
constexpr int CW_BAR = 4096;

constexpr int LDS_BYTES = 163840;
constexpr int MISC_OFF = 162816;

#define LAS __attribute__((address_space(3)))
typedef unsigned short bf16_t;
typedef short bf16x8 __attribute__((ext_vector_type(8)));
typedef short bf16x4 __attribute__((ext_vector_type(4)));
typedef float f32x4 __attribute__((ext_vector_type(4)));
typedef float f32x16 __attribute__((ext_vector_type(16)));
typedef unsigned u32x4 __attribute__((ext_vector_type(4)));
typedef unsigned u32x2 __attribute__((ext_vector_type(2)));
#define LDS_WAIT() asm volatile("s_waitcnt lgkmcnt(0)" ::: "memory")
#define VM_WAIT() asm volatile("s_waitcnt vmcnt(0)" ::: "memory")
__device__ __forceinline__ unsigned f2bf(float f) { return pg8::cvt_pk_bf16(f, 0.f) & 0xffffu; }
__device__ __forceinline__ unsigned pk2(float lo, float hi) { return pg8::cvt_pk_bf16(lo, hi); }
__device__ __forceinline__ float bflo(unsigned w) { return __builtin_bit_cast(float, w << 16); }
__device__ __forceinline__ float bfhi(unsigned w) { return __builtin_bit_cast(float, w & 0xffff0000u); }
__device__ __forceinline__ float bf1(bf16_t w) { return __builtin_bit_cast(float, ((unsigned)w) << 16); }
__device__ __forceinline__ void lds_barrier() { asm volatile("s_waitcnt lgkmcnt(0)" ::: "memory"); __builtin_amdgcn_s_barrier(); asm volatile("" ::: "memory"); }
__device__ __forceinline__ float wave_sum(float v) {
#pragma unroll
    for (int o = 1; o < 64; o <<= 1) v += __shfl_xor(v, o);
    return v;
}

#define XB_TMO      128
#define XB_XCNT(j)  (256  + 64 * (j))
#define XB_XSUB(j)  (1280 + 64 * (j))
#define XB_XGEN(j)  (2304 + 64 * (j))
#define XB_TOP      3328
#define XB_TOPGEN   3392
#define XCD_BAR_WORDS 3456
#define XB_SPIN_CAP (1u << 20)
__device__ __forceinline__ unsigned xb_ld(unsigned* p)              { return __hip_atomic_load(p, __ATOMIC_RELAXED, __HIP_MEMORY_SCOPE_AGENT); }
__device__ __forceinline__ unsigned xb_add(unsigned* p, unsigned v) { return __hip_atomic_fetch_add(p, v, __ATOMIC_RELAXED, __HIP_MEMORY_SCOPE_AGENT); }
__device__ __forceinline__ unsigned xb_xcc_id() { return (unsigned)__builtin_amdgcn_s_getreg((3 << 11) | 20) & 0xFu; }
#define XB_SPIN(cond, bar) do { unsigned _sp = 0; while (cond) { __builtin_amdgcn_s_sleep(1); \
    if ((++_sp & 255u) == 0u) { if (xb_ld(&(bar)[XB_TMO])) break; if (_sp > XB_SPIN_CAP) { atomicAdd(&(bar)[XB_TMO], 1u); break; } } } } while (0)
struct XcdBarrier { unsigned* bar; unsigned x; volatile LAS unsigned* st; };
__device__ __forceinline__ XcdBarrier xcd_barrier_post(unsigned* bar, volatile LAS unsigned* st) {
    XcdBarrier b; b.bar = bar; b.x = xb_xcc_id(); b.st = st;
    if (threadIdx.x == 0) (void)xb_add(&bar[XB_XCNT(b.x)], 1u);
    return b;
}
__device__ __forceinline__ void xcd_barrier_complete(unsigned* bar, unsigned x, unsigned& nloc, unsigned& nx) {
    const unsigned G = gridDim.x * gridDim.y * gridDim.z;
    unsigned sum, cnt, mine, sp = 0u;
    for (;;) {
        sum = 0u; cnt = 0u; mine = 0u;
#pragma unroll
        for (unsigned j = 0; j < 16; ++j) { const unsigned c = xb_ld(&bar[XB_XCNT(j)]); sum += c; cnt += (c > 0u) ? 1u : 0u; mine = (j == x) ? c : mine; }
        if (sum == G) break;
        __builtin_amdgcn_s_sleep(1);
        if ((++sp & 255u) == 0u) { if (xb_ld(&bar[XB_TMO])) break; if (sp > XB_SPIN_CAP) { atomicAdd(&bar[XB_TMO], 1u); break; } }
    }
    nloc = mine > 0u ? mine : 1u; nx = cnt > 0u ? cnt : 1u;
}
__device__ __forceinline__ void xcd_barrier(const XcdBarrier& b) {
    asm volatile("s_waitcnt vmcnt(0)" ::: "memory");
    __syncthreads();
    if (threadIdx.x == 0) {
        unsigned* bar = b.bar;
        __builtin_amdgcn_s_waitcnt(0);
        unsigned nloc = b.st[0], nx = b.st[1];
        if (nloc == 0u) { xcd_barrier_complete(bar, b.x, nloc, nx); b.st[0] = nloc; b.st[1] = nx; }
        const unsigned old = xb_add(&bar[XB_XSUB(b.x)], 1u);
        const unsigned gen = old / nloc;
        if (old + 1u == (gen + 1u) * nloc) {
            __builtin_amdgcn_fence(__ATOMIC_RELEASE, "agent");
            asm volatile("s_waitcnt vmcnt(0)" ::: "memory");
            const unsigned og = xb_add(&bar[XB_TOP], 1u);
            const unsigned tg = og / nx;
            if (og + 1u == (tg + 1u) * nx) xb_add(&bar[XB_TOPGEN], 1u);
            else XB_SPIN(xb_ld(&bar[XB_TOPGEN]) == tg, bar);
            __builtin_amdgcn_fence(__ATOMIC_ACQUIRE, "agent");
            xb_add(&bar[XB_XGEN(b.x)], 1u);
            asm volatile("s_waitcnt vmcnt(0)" ::: "memory");
        } else {
            XB_SPIN(xb_ld(&bar[XB_XGEN(b.x)]) == gen, bar);
            __builtin_amdgcn_fence(__ATOMIC_ACQUIRE, "agent");
            asm volatile("s_waitcnt vmcnt(0)" ::: "memory");
        }
    }
    __syncthreads();
}

struct Params { const float* in[21]; float* out; unsigned char* ws; int ph_lo, ph_hi; };
enum { I_X = 0, I_META, I_NPRE, I_NPOST, I_EWIN, I_EWOUT, I_RPB, I_MBIAS, I_HGLOW, I_HGNORM, I_OWIN, I_OWOUT, I_HYSHORT, I_W1, I_B1, I_FR1, I_W2, I_B2, I_FR2, I_W3, I_HYBIAS };

#if MK_SUBPROBE
#define SUBP_T0(id) unsigned long long sp_t0_##id = 0; if (MK_SUBPROBE == (id)) sp_t0_##id = wall_clock64();
#define SUBP_T1(id) if (MK_SUBPROBE == (id) && threadIdx.x == 0) { volatile LAS unsigned* M_ = (volatile LAS unsigned*)(lds + MISC_OFF); const unsigned long long d_ = wall_clock64() - sp_t0_##id + (((unsigned long long)M_[5] << 32) | M_[4]); M_[4] = (unsigned)d_; M_[5] = (unsigned)(d_ >> 32); }
#else
#define SUBP_T0(id)
#define SUBP_T1(id)
#endif
struct P0Item { const float* W; bf16_t* WT; int N, k0, n0; };
__device__ __forceinline__ P0Item p0_item(const Params& p, int it) {
    constexpr int I_EIN = (D / 64) * (EIN / 256), I_SQ = (D / 64) * (D / 256), I_OIN = (D / 64) * (OIN / 256), I_LAYER = I_EIN + 2 * I_SQ + I_OIN;
    const int j = it / I_LAYER; int r = it % I_LAYER; P0Item x;
    if (r < I_EIN) { x.W = p.in[I_EWIN] + (size_t)j * D * EIN; x.WT = (bf16_t*)(p.ws + WS_WEIN) + (size_t)j * EIN * D; x.N = EIN; }
    else if ((r -= I_EIN) < I_SQ) { x.W = p.in[I_EWOUT] + (size_t)j * D * D; x.WT = (bf16_t*)(p.ws + WS_WEOUT) + (size_t)j * D * D; x.N = D; }
    else if ((r -= I_SQ) < I_OIN) { x.W = p.in[I_OWIN] + (size_t)j * D * OIN; x.WT = (bf16_t*)(p.ws + WS_WOIN) + (size_t)j * OIN * D; x.N = OIN; }
    else { r -= I_OIN; x.W = p.in[I_OWOUT] + (size_t)j * D * D; x.WT = (bf16_t*)(p.ws + WS_WOOUT) + (size_t)j * D * D; x.N = D; }
    const int nblk = x.N / 256; x.k0 = 64 * (r / nblk); x.n0 = 256 * (r % nblk); return x;
}
__device__ __forceinline__ void p0_load(const P0Item& x, int tid, f32x4 (&v)[8]) {
#pragma unroll
    for (int j = 0; j < 8; ++j) { const int q = tid + NTHR * j; v[j] = *(const f32x4*)(x.W + (size_t)(x.k0 + (q >> 6)) * x.N + x.n0 + 4 * (q & 63)); }
}
__device__ __forceinline__ void rms_row_to_bf16(const f32x4 (&v)[16], const float* g, bf16_t* orow, int lane) {
    float s = 0.f;
#pragma unroll
    for (int j = 0; j < 16; ++j) s += (v[j].x * v[j].x + v[j].y * v[j].y) + (v[j].z * v[j].z + v[j].w * v[j].w);
    const float rstd = 1.0f / sqrtf(wave_sum(s) * (1.0f / D) + EPS);
    const f32x4* g4 = (const f32x4*)g + lane; u32x2* o8 = (u32x2*)orow + lane;
#pragma unroll
    for (int j = 0; j < 16; ++j) { const f32x4 gg = g4[64 * j]; u32x2 w; w.x = pk2(v[j].x * rstd * gg.x, v[j].y * rstd * gg.y); w.y = pk2(v[j].z * rstd * gg.z, v[j].w * rstd * gg.w); o8[64 * j] = w; }
}
__device__ __forceinline__ void phase_prologue(const Params& p, LAS unsigned char* lds, int gw, int NGW, int wave, int lane) {
    unsigned char* ws = p.ws;
    {
        LAS float* tile = (LAS float*)lds;
        constexpr int NITEMS = 2 * ((D / 64) * (EIN / 256) + 2 * (D / 64) * (D / 256) + (D / 64) * (OIN / 256));
        const int vcu = gw / NWAVES, G = NGW / NWAVES, tid = wave * 64 + lane;
        f32x4 v[8]; P0Item cur;
        if (vcu < NITEMS) { cur = p0_item(p, vcu); p0_load(cur, tid, v); }
        for (int it = vcu; it < NITEMS; it += G) {
#pragma unroll
            for (int j = 0; j < 8; ++j) { const int q = tid + NTHR * j; *(LAS f32x4*)(tile + (q >> 6) * 260 + 4 * (q & 63)) = v[j]; }
            lds_barrier();
            const P0Item me = cur;
            if (it + G < NITEMS) { cur = p0_item(p, it + G); p0_load(cur, tid, v); }
#pragma unroll
            for (int half = 0; half < 2; ++half) { const int n = 128 * half + (tid >> 2), kq = tid & 3; const LAS float* s = tile + (16 * kq) * 260 + n;
                u32x4 o0, o1;
                o0.x = pk2(s[0 * 260], s[1 * 260]); o0.y = pk2(s[2 * 260], s[3 * 260]); o0.z = pk2(s[4 * 260], s[5 * 260]); o0.w = pk2(s[6 * 260], s[7 * 260]);
                o1.x = pk2(s[8 * 260], s[9 * 260]); o1.y = pk2(s[10 * 260], s[11 * 260]); o1.z = pk2(s[12 * 260], s[13 * 260]); o1.w = pk2(s[14 * 260], s[15 * 260]);
                bf16_t* d = me.WT + (size_t)(me.n0 + n) * D + me.k0 + 16 * kq;
                *(u32x4*)d = o0; *(u32x4*)(d + 8) = o1; }
            lds_barrier();
        }
    }
    float* H = (float*)(ws + WS_H); bf16_t* HN = (bf16_t*)(ws + WS_HN);
    for (int m = gw; m < MP; m += NGW) {
        f32x4 v[16];
        if (m < MV) {
            const float* src = (m < NB * T) ? p.in[I_X] + (size_t)m * D : p.in[I_META] + (size_t)((m - NB * T) & 15) * D;
#pragma unroll
            for (int j = 0; j < 16; ++j) v[j] = ((const f32x4*)src)[lane + 64 * j];
#pragma unroll
            for (int j = 0; j < 16; ++j) ((f32x4*)(H + (size_t)m * D))[lane + 64 * j] = v[j];
            rms_row_to_bf16(v, p.in[I_NPRE], HN + (size_t)m * D, lane);
        } else {
#pragma unroll
            for (int j = 0; j < 16; ++j) ((u32x2*)(HN + (size_t)m * D))[lane + 64 * j] = (u32x2){0u, 0u};
        }
    }
    { float* LB = (float*)(ws + WS_LB); const float* hl = p.in[I_HGLOW];
      for (int i = gw * 64 + lane; i < 2 * 2048; i += NGW * 64) { LB[i] = 0.f; LB[4096 + i] = 1.0f / (1.0f + __expf(hl[i] - hl[4096 + i])); } }
    { bf16_t* HID2 = (bf16_t*)(ws + WS_HID2);
      for (int it = gw; it < 2 * LPAD; it += NGW) {
        const int jl = it / LPAD, l = it % LPAD; float h2 = 0.f;
        if (l < L) {
            float z = 0.f;
            if (lane == 0) z = (float)l * (1.0f / (float)(L - 1));
            else if (lane < 33) { const int k = (lane - 1) & 15; const float band = 1e-4f + (float)k * ((15.0f - 1e-4f) / 15.0f); float rev = band * ((float)l / (float)L); rev -= floorf(rev);
                z = (lane < 17) ? __builtin_amdgcn_cosf(rev) : -__builtin_amdgcn_sinf(rev); }
            const float* w1 = p.in[I_W1] + (size_t)jl * 33 * 64; const float* w2 = p.in[I_W2] + (size_t)jl * 64 * 64;
            float a = p.in[I_B1][jl * 64 + lane];
#pragma unroll
            for (int i = 0; i < 33; ++i) a += __shfl(z, i) * w1[i * 64 + lane];
            const float h1 = __sinf(p.in[I_FR1][jl * 64 + lane] * a);
            float a2 = p.in[I_B2][jl * 64 + lane];
#pragma unroll 16
            for (int i = 0; i < 64; ++i) a2 += __shfl(h1, i) * w2[i * 64 + lane];
            h2 = __sinf(p.in[I_FR2][jl * 64 + lane] * a2);
        }
        HID2[(size_t)it * 64 + lane] = (bf16_t)f2bf(h2);
      } }
}

__device__ __forceinline__ void phase_filtergen(const Params& p, LAS unsigned char* lds, int gw, int NGW, int wave, int lane) {
    unsigned char* ws = p.ws; const bf16_t* HID2 = (const bf16_t*)(ws + WS_HID2); bf16_t* KT = (bf16_t*)(ws + WS_KT);
    const int r32 = lane & 31, h = lane >> 5;
    LAS bf16_t* tile = (LAS bf16_t*)(lds + wave * 5120);
    for (int wi = gw; wi < 2048; wi += NGW) {
        const int lpart = wi & 3, cb = (wi >> 2) & 127, n = (wi >> 9) & 1, jl = wi >> 10; const int c0 = cb * 32;
        const float* w3 = p.in[I_W3] + (size_t)jl * 64 * 16384;
        bf16x8 A[2][4];
#pragma unroll
        for (int dir = 0; dir < 2; ++dir)
#pragma unroll
            for (int st = 0; st < 4; ++st) { const float* src = w3 + (size_t)(16 * st + 8 * h) * 16384 + (dir * 2 + n) * 4096 + c0 + r32;
                u32x4 w; w.x = pk2(src[0], src[16384]); w.y = pk2(src[2 * 16384], src[3 * 16384]); w.z = pk2(src[4 * 16384], src[5 * 16384]); w.w = pk2(src[6 * 16384], src[7 * 16384]);
                A[dir][st] = __builtin_bit_cast(bf16x8, w); }
        const int lb0 = lpart * 33, lb1 = (lb0 + 33 < 129) ? lb0 + 33 : 129;
        const bf16_t* hrow = HID2 + (size_t)jl * LPAD * 64 + 8 * h;
        bf16x8 Bf[4], Bb[4];
#define FG_LOAD(lb) do { const int lb_ = (lb) * 32 + r32; const int lf_ = lb_ + 1 < LPAD ? lb_ + 1 : LPAD - 1; \
        _Pragma("unroll") for (int st = 0; st < 4; ++st) { Bf[st] = *(const bf16x8*)(hrow + (size_t)lf_ * 64 + 16 * st); Bb[st] = *(const bf16x8*)(hrow + (size_t)lb_ * 64 + 16 * st); } } while (0)
        FG_LOAD(lb0);
        for (int lb = lb0; lb < lb1; ++lb) {
            f32x16 acc0, acc1, accc;
#pragma unroll
            for (int i = 0; i < 16; ++i) { acc0[i] = 0.f; acc1[i] = 0.f; accc[i] = 0.f; }
#pragma unroll
            for (int st = 0; st < 4; ++st) { acc0 = __builtin_amdgcn_mfma_f32_32x32x16_bf16(A[0][st], Bf[st], acc0, 0, 0, 0); acc1 = __builtin_amdgcn_mfma_f32_32x32x16_bf16(A[1][st], Bb[st], acc1, 0, 0, 0); }
            if (lb == 0) {
#pragma unroll
                for (int st = 0; st < 4; ++st) accc = __builtin_amdgcn_mfma_f32_32x32x16_bf16(A[0][st], Bb[st], accc, 0, 0, 0);
            }
            if (lb + 1 < lb1) FG_LOAD(lb + 1);
            const int lbk = lb * 32 + r32, lfw = lbk + 1;
            const float tb = (float)lbk * (1.0f / (float)(L - 1)), tf = (float)lfw * (1.0f / (float)(L - 1));
#pragma unroll
            for (int reg = 0; reg < 16; ++reg) { const int cl = (reg & 3) + 8 * (reg >> 2) + 4 * h;
                const float delta = 3.0701134f + (15.350567f - 3.0701134f) * ((float)(c0 + cl) * (1.0f / 4095.0f));
                float v1 = acc1[reg] * __expf(-tb * delta); if (lbk == 0) v1 += accc[reg];
                const float v0 = acc0[reg] * __expf(-tf * delta);
                tile[cl * 40 + (31 - r32)] = (bf16_t)f2bf(v0); tile[(32 + cl) * 40 + r32] = (bf16_t)f2bf(v1); }
            LDS_WAIT(); asm volatile("" ::: "memory");
#pragma unroll
            for (int k = 0; k < 2; ++k) { const int cl = (lane >> 2) + 16 * k, ch = lane & 3;
                bf16_t* R = KT + ((size_t)(jl * 2 + n) * 4096 + c0 + cl) * KLEN;
                *(u32x4*)(R + (KOFF - 32 - 32 * lb) + 8 * ch) = *(const LAS u32x4*)(tile + cl * 40 + 8 * ch);
                *(u32x4*)(R + (KOFF + 32 * lb) + 8 * ch) = *(const LAS u32x4*)(tile + (32 + cl) * 40 + 8 * ch); }
            LDS_WAIT(); asm volatile("" ::: "memory");
        }
#undef FG_LOAD
    }
}
constexpr int HG_QM = 0, HG_KM = 17408, HG_KST = 34816, HG_VT = 53248, HG_TOT = 71680, HG_OUT = 79872, HG_END1 = 97280;
constexpr int HG_STB = 0;
__device__ __forceinline__ int hg_row(int dir, int b, int ci, int tau) {
    if (dir == 0) { if (ci == 0) return tau < 16 ? 8192 + 16 * b + tau : -1; return b * 4096 + 64 * (ci - 1) + tau; }
    if (ci == 64) return tau < 16 ? 8192 + 16 * b + 15 - tau : -1;
    return b * 4096 + 4095 - (64 * ci + tau);
}
struct HgRaw { u32x2 q[4], l[4]; u32x4 v[2]; };
__device__ __forceinline__ void hg1_load(const bf16_t* P, int item, int tid, HgRaw& r) {
    const int ci = item % 65, hd = (item / 65) & 15, b = (item / (65 * 16)) & 1, dir = item / (65 * 32);
    const int qcol = QB_OFF + hd * 128, vcol = IB_OFF + hd * 128, fcol = (dir ? FB_OFF : FF_OFF) + hd * 128;
    const int dg = tid & 31, tg = tid >> 5, tv = tid >> 3, dvq = tid & 7;
#pragma unroll
    for (int i = 0; i < 4; ++i) { const int row = hg_row(dir, b, ci, 4 * tg + i); const int rc = row < 0 ? 0 : row;
        r.q[i] = *(const u32x2*)(P + (size_t)rc * EIN + qcol + 4 * dg); r.l[i] = *(const u32x2*)(P + (size_t)rc * EIN + fcol + 4 * dg); }
    { const int row = hg_row(dir, b, ci, tv); const int rc = row < 0 ? 0 : row;
      r.v[0] = *(const u32x4*)(P + (size_t)rc * EIN + vcol + 16 * dvq); r.v[1] = *(const u32x4*)(P + (size_t)rc * EIN + vcol + 16 * dvq + 8); }
}
__device__ __forceinline__ void hgrn_stage1(const Params& p, LAS unsigned char* lds, int vcu, int G, int tid, int wave, int lane) {
    const bf16_t* P = (const bf16_t*)(p.ws + WS_P);
    bf16_t* QSG = (bf16_t*)(p.ws + WS_QSG); bf16_t* KSG = (bf16_t*)(p.ws + WS_KSG); bf16_t* VTG = (bf16_t*)(p.ws + WS_VTG); float* DECG = (float*)(p.ws + WS_DECG);
    const int dg = tid & 31, tg = tid >> 5, tv = tid >> 3, dvq = tid & 7, r32 = lane & 31, h = lane >> 5;
    LAS bf16_t* QM = (LAS bf16_t*)(lds + HG_QM); LAS bf16_t* KM = (LAS bf16_t*)(lds + HG_KM); LAS bf16_t* KST = (LAS bf16_t*)(lds + HG_KST); LAS bf16_t* VTL = (LAS bf16_t*)(lds + HG_VT);
    LAS float* TOT = (LAS float*)(lds + HG_TOT);
    HgRaw raw;
    if (vcu < 4160) hg1_load(P, vcu, tid, raw);
    for (int item = vcu; item < 4160; item += G) {
        const int ci = item % 65, hd = (item / 65) & 15, b = (item / (65 * 16)) & 1, dir = item / (65 * 32);
        SUBP_T0(20)
        float qs[4][4], lg[4][4], kk[4][4], cs[4][4];
#pragma unroll
        for (int i = 0; i < 4; ++i) if (hg_row(dir, b, ci, 4 * tg + i) < 0) { raw.q[i] = (u32x2){0u, 0u}; raw.l[i] = (u32x2){0u, 0u}; }
        if (hg_row(dir, b, ci, tv) < 0) { raw.v[0] = (u32x4){0u, 0u, 0u, 0u}; raw.v[1] = (u32x4){0u, 0u, 0u, 0u}; }
#pragma unroll
        for (int i = 0; i < 4; ++i) { qs[i][0] = bflo(raw.q[i].x); qs[i][1] = bfhi(raw.q[i].x); qs[i][2] = bflo(raw.q[i].y); qs[i][3] = bfhi(raw.q[i].y);
            lg[i][0] = bflo(raw.l[i].x); lg[i][1] = bfhi(raw.l[i].x); lg[i][2] = bflo(raw.l[i].y); lg[i][3] = bfhi(raw.l[i].y); }
#pragma unroll
        for (int i = 0; i < 4; ++i)
#pragma unroll
            for (int k = 0; k < 4; ++k) kk[i][k] = 1.0f - __expf(lg[i][k]);
#pragma unroll
        for (int k = 0; k < 4; ++k) { cs[0][k] = lg[0][k]; cs[1][k] = cs[0][k] + lg[1][k]; cs[2][k] = cs[1][k] + lg[2][k]; cs[3][k] = cs[2][k] + lg[3][k]; }
        *(LAS f32x4*)(TOT + tg * 128 + 4 * dg) = (f32x4){cs[3][0], cs[3][1], cs[3][2], cs[3][3]};
        { const unsigned vw[8] = {raw.v[0].x, raw.v[0].y, raw.v[0].z, raw.v[0].w, raw.v[1].x, raw.v[1].y, raw.v[1].z, raw.v[1].w};
#pragma unroll
          for (int k = 0; k < 8; ++k) { VTL[(16 * dvq + 2 * k) * 72 + tv] = (bf16_t)(vw[k] & 0xffffu); VTL[(16 * dvq + 2 * k + 1) * 72 + tv] = (bf16_t)(vw[k] >> 16); } }
        lds_barrier(); SUBP_T1(20) SUBP_T0(21)
        f32x4 pre = (f32x4){0.f, 0.f, 0.f, 0.f}, mid = pre, end = pre;
#pragma unroll
        for (int g = 0; g < 16; ++g) { const f32x4 t4 = *(const LAS f32x4*)(TOT + g * 128 + 4 * dg); if (g < tg) pre += t4; if (g < 8) mid += t4; end += t4; }
        if (item + G < 4160) hg1_load(P, item + G, tid, raw);
        bf16_t* qsg = QSG + (size_t)item * 8192; bf16_t* ksg = KSG + (size_t)item * 8192; bf16_t* vtg = VTG + (size_t)item * 8192;
        float qsv[4][4], qmv[4][4], kmv[4][4];
#pragma unroll
        for (int k = 0; k < 4; ++k) {
            const float emid = __expf(mid[k]), eem = __expf(end[k] - mid[k]);
            float ksv[4];
#pragma unroll
            for (int i = 0; i < 4; ++i) { const float Gc = pre[k] + cs[i][k]; const float e1 = __expf(Gc - mid[k]), e2 = __expf(mid[k] - Gc);
                const float qm = qs[i][k] * e1, km = kk[i][k] * e2; qmv[i][k] = qm; kmv[i][k] = km; qsv[i][k] = qm * emid; ksv[i] = km * eem; }
            *(LAS u32x2*)(KST + (4 * dg + k) * 72 + 4 * tg) = (u32x2){pk2(ksv[0], ksv[1]), pk2(ksv[2], ksv[3])};
            if (tg == 0) DECG[(size_t)item * 128 + 4 * dg + k] = emid * eem;
        }
#pragma unroll
        for (int i = 0; i < 4; ++i) { const int tau = 4 * tg + i;
            *(LAS u32x2*)(QM + tau * 136 + 4 * dg) = (u32x2){pk2(qmv[i][0], qmv[i][1]), pk2(qmv[i][2], qmv[i][3])};
            *(LAS u32x2*)(KM + tau * 136 + 4 * dg) = (u32x2){pk2(kmv[i][0], kmv[i][1]), pk2(kmv[i][2], kmv[i][3])};
            *(u32x2*)(qsg + tau * 128 + 4 * dg) = (u32x2){pk2(qsv[i][0], qsv[i][1]), pk2(qsv[i][2], qsv[i][3])}; }
        lds_barrier(); SUBP_T1(21) SUBP_T0(22)
        {
            const int dvt = wave & 3, tb = wave >> 2;
            f32x16 accO;
#pragma unroll
            for (int i = 0; i < 16; ++i) accO[i] = 0.f;
            for (int sb = 0; sb <= tb; ++sb) {
                f32x16 sT;
#pragma unroll
                for (int i = 0; i < 16; ++i) sT[i] = 0.f;
#pragma unroll
                for (int stp = 0; stp < 8; ++stp) { const bf16x8 a = *(const LAS bf16x8*)(KM + (32 * sb + r32) * 136 + 16 * stp + 8 * h); const bf16x8 bq = *(const LAS bf16x8*)(QM + (32 * tb + r32) * 136 + 16 * stp + 8 * h);
                    sT = __builtin_amdgcn_mfma_f32_32x32x16_bf16(a, bq, sT, 0, 0, 0); }
                if (sb == tb) {
#pragma unroll
                    for (int reg = 0; reg < 16; ++reg) { const int sl = (reg & 3) + 8 * (reg >> 2) + 4 * h; if (sl > r32) sT[reg] = 0.f; }
                }
#pragma unroll
                for (int st2 = 0; st2 < 2; ++st2) {
                    u32x4 pw; pw.x = pk2(sT[8 * st2 + 0], sT[8 * st2 + 1]); pw.y = pk2(sT[8 * st2 + 2], sT[8 * st2 + 3]); pw.z = pk2(sT[8 * st2 + 4], sT[8 * st2 + 5]); pw.w = pk2(sT[8 * st2 + 6], sT[8 * st2 + 7]);
                    const LAS bf16_t* vp = VTL + (32 * dvt + r32) * 72 + 32 * sb + 16 * st2 + 4 * h;
                    const u32x2 a0 = *(const LAS u32x2*)vp, a1 = *(const LAS u32x2*)(vp + 8);
                    const u32x4 aw = (u32x4){a0.x, a0.y, a1.x, a1.y};
                    accO = __builtin_amdgcn_mfma_f32_32x32x16_bf16(__builtin_bit_cast(bf16x8, aw), __builtin_bit_cast(bf16x8, pw), accO, 0, 0, 0);
                }
            }
            { LAS bf16_t* ot = (LAS bf16_t*)(lds + HG_OUT) + (32 * tb + r32) * 136 + 32 * dvt + 4 * h;
#pragma unroll
              for (int g4 = 0; g4 < 4; ++g4) *(LAS u32x2*)(ot + 8 * g4) = (u32x2){pk2(accO[4 * g4], accO[4 * g4 + 1]), pk2(accO[4 * g4 + 2], accO[4 * g4 + 3])}; }
#pragma unroll
            for (int j = 0; j < 2; ++j) { const int pc = tid + NTHR * j, rr = pc >> 3, ch = pc & 7;
                *(u32x4*)(ksg + rr * 64 + 8 * ch) = *(const LAS u32x4*)(KST + rr * 72 + 8 * ch); *(u32x4*)(vtg + rr * 64 + 8 * ch) = *(const LAS u32x4*)(VTL + rr * 72 + 8 * ch); }
        }
        lds_barrier(); SUBP_T1(22)
        { bf16_t* OB = (bf16_t*)(p.ws + WS_OBP) + (size_t)dir * MP * 2048;
#pragma unroll
          for (int j = 0; j < 2; ++j) { const int q = tid + NTHR * j, tau = q >> 4, c16 = q & 15; const int row = hg_row(dir, b, ci, tau);
              if (row >= 0) *(u32x4*)(OB + (size_t)row * 2048 + hd * 128 + 8 * c16) = *(const LAS u32x4*)(lds + HG_OUT + tau * 272 + 16 * c16); } }
    }
}
constexpr int HG2_SLOT0 = 17408, HG2_QS = 0, HG2_KST = 17408, HG2_VT = 35840, HG2_DEC = 40448, HG2_SLOT = 40960;
struct Hg2L { u32x4 r[7]; };
struct Hg2Map { unsigned g[7]; unsigned stride[7]; unsigned l[7]; };
__device__ __forceinline__ void hg2_map(const Params& p, size_t item0, int dv0, int tid, Hg2Map& m) {
    const int t = tid - 128;
#pragma unroll
    for (int j = 0; j < 7; ++j) { const int q = t + 384 * j;
        if (t < 0 || q >= 2336) { m.g[j] = (unsigned)WS_QSG; m.stride[j] = 0u; m.l[j] = 0xffffffffu; }
        else if (q < 1024) { m.g[j] = (unsigned)(WS_QSG + (item0 * 8192 + 8 * (size_t)q) * 2); m.stride[j] = 16384u; m.l[j] = HG2_QS + (q >> 4) * 272 + 16 * (q & 15); }
        else if (q < 2048) { const int q1 = q - 1024; m.g[j] = (unsigned)(WS_KSG + (item0 * 8192 + 8 * (size_t)q1) * 2); m.stride[j] = 16384u; m.l[j] = HG2_KST + (q1 >> 3) * 144 + 16 * (q1 & 7); }
        else if (q < 2304) { const int q2 = q - 2048; m.g[j] = (unsigned)(WS_VTG + (item0 * 8192 + (size_t)dv0 * 64 + 8 * (size_t)q2) * 2); m.stride[j] = 16384u; m.l[j] = HG2_VT + (q2 >> 3) * 144 + 16 * (q2 & 7); }
        else { const int q3 = q - 2304; m.g[j] = (unsigned)(WS_DECG + (item0 * 128 + 4 * (size_t)q3) * 4); m.stride[j] = 512u; m.l[j] = HG2_DEC + 16 * q3; } }
}
__device__ __forceinline__ void hg2_ld(const unsigned char* wsb, const Hg2Map& m, int ci, Hg2L& x) {
    if (ci >= 65) return;
#pragma unroll
    for (int j = 0; j < 7; ++j) x.r[j] = *(const u32x4*)(wsb + ((size_t)m.g[j] + (size_t)ci * m.stride[j]));
}
__device__ __forceinline__ void hg2_st(LAS unsigned char* slot, const Hg2Map& m, int ci, const Hg2L& x) {
    if (ci >= 65) return;
#pragma unroll
    for (int j = 0; j < 7; ++j) if (m.l[j] != 0xffffffffu) *(LAS u32x4*)(slot + m.l[j]) = x.r[j];
}
struct Hg2O { u32x2 o[4]; };
__device__ __forceinline__ void hg2_load_o(const Params& p, int dir, int b, int hd, int dv0, int ci, int wave, int lane, Hg2O& x) {
    if (wave < 2 && ci < 65) { const int r32 = lane & 31, h = lane >> 5; const int row = hg_row(dir, b, ci, 32 * wave + r32); const int rc = row < 0 ? 0 : row;
        const bf16_t* op = (const bf16_t*)(p.ws + WS_OBP) + (size_t)dir * MP * 2048 + (size_t)rc * 2048 + hd * 128 + dv0 + 4 * h;
#pragma unroll
        for (int g4 = 0; g4 < 4; ++g4) x.o[g4] = *(const u32x2*)(op + 8 * g4); }
}
__device__ __forceinline__ void hgrn_stage2(const Params& p, LAS unsigned char* lds, int item, int tid, int wave, int lane) {
    const int dvs = item & 3, hd = (item >> 2) & 15, b = (item >> 6) & 1, dir = item >> 7, dv0 = dvs * 32;
    const int r32 = lane & 31, h = lane >> 5; const size_t item0 = (size_t)(((dir * 2 + b) * 16 + hd) * 65);
    LAS bf16_t* STB = (LAS bf16_t*)lds;
    for (int i = tid; i < 2 * 32 * 136 / 2; i += NTHR) ((LAS unsigned*)STB)[i] = 0u;
    f32x16 st;
#pragma unroll
    for (int i = 0; i < 16; ++i) st[i] = 0.f;
    Hg2L RA; Hg2O oA, oB;
    Hg2Map map; hg2_map(p, item0, dv0, tid, map);
    if (wave >= 2) { hg2_ld(p.ws, map, 0, RA); hg2_st(lds + HG2_SLOT0 + 0 * HG2_SLOT, map, 0, RA); hg2_ld(p.ws, map, 1, RA); hg2_st(lds + HG2_SLOT0 + 1 * HG2_SLOT, map, 1, RA);
        hg2_ld(p.ws, map, 2, RA); }
    hg2_load_o(p, dir, b, hd, dv0, 0, wave, lane, oA);
    int cur = 0;
    lds_barrier();
#pragma unroll 1
    for (int ci = 0; ci < 65; ++ci) {
        const int sl = ci % 3; LAS unsigned char* slot_ = lds + HG2_SLOT0 + sl * HG2_SLOT;
        if (wave >= 2) { const int sn = (sl == 0) ? 2 : sl - 1;
            hg2_st(lds + HG2_SLOT0 + sn * HG2_SLOT, map, ci + 2, RA); hg2_ld(p.ws, map, ci + 3, RA); }
        if (wave < 2) {
            hg2_load_o(p, dir, b, hd, dv0, ci + 1, wave, lane, oB);
            f32x16 accO;
#pragma unroll
            for (int g4 = 0; g4 < 4; ++g4) { accO[4 * g4] = bflo(oA.o[g4].x); accO[4 * g4 + 1] = bfhi(oA.o[g4].x); accO[4 * g4 + 2] = bflo(oA.o[g4].y); accO[4 * g4 + 3] = bfhi(oA.o[g4].y); }
            const LAS bf16_t* sbp = STB + cur * (32 * 136); const LAS bf16_t* qsl = (const LAS bf16_t*)(slot_ + HG2_QS) + (32 * wave + r32) * 136 + 8 * h;
#pragma unroll
            for (int sp = 0; sp < 2; ++sp) {
                bf16x8 a4[4], b4[4];
#pragma unroll
                for (int k = 0; k < 4; ++k) { a4[k] = *(const LAS bf16x8*)(sbp + r32 * 136 + 16 * (4 * sp + k) + 8 * h); b4[k] = *(const LAS bf16x8*)(qsl + 16 * (4 * sp + k)); }
#pragma unroll
                for (int k = 0; k < 4; ++k) accO = __builtin_amdgcn_mfma_f32_32x32x16_bf16(a4[k], b4[k], accO, 0, 0, 0);
                __builtin_amdgcn_sched_barrier(0);
            }
            const int row = hg_row(dir, b, ci, 32 * wave + r32);
            if (row >= 0) { bf16_t* op = (bf16_t*)(p.ws + WS_OBP) + (size_t)dir * MP * 2048 + (size_t)row * 2048 + hd * 128 + dv0 + 4 * h;
#pragma unroll
                for (int g4 = 0; g4 < 4; ++g4) *(u32x2*)(op + 8 * g4) = (u32x2){pk2(accO[4 * g4], accO[4 * g4 + 1]), pk2(accO[4 * g4 + 2], accO[4 * g4 + 3])}; }
            oA = oB;
        } else if (wave < 6) {
            const int db = wave - 2; const float dec = ((const LAS float*)(slot_ + HG2_DEC))[32 * db + r32];
            const LAS bf16_t* vtl = (const LAS bf16_t*)(slot_ + HG2_VT) + r32 * 72 + 8 * h; const LAS bf16_t* ksl = (const LAS bf16_t*)(slot_ + HG2_KST) + (32 * db + r32) * 72 + 8 * h;
#pragma unroll
            for (int i = 0; i < 16; ++i) st[i] *= dec;
#pragma unroll
            for (int stp = 0; stp < 4; ++stp) st = __builtin_amdgcn_mfma_f32_32x32x16_bf16(*(const LAS bf16x8*)(vtl + 16 * stp), *(const LAS bf16x8*)(ksl + 16 * stp), st, 0, 0, 0);
            LAS bf16_t* sbn = STB + (cur ^ 1) * (32 * 136);
#pragma unroll
            for (int reg = 0; reg < 16; ++reg) { const int dvl = (reg & 3) + 8 * (reg >> 2) + 4 * h; sbn[dvl * 136 + 32 * db + r32] = (bf16_t)f2bf(st[reg]); }
        }
        cur ^= 1; lds_barrier();
    }
}

constexpr int HF_STB = 0, HF_SLOT0 = 34816, HF_QS = 0, HF_KST = 17408, HF_VT = 35840, HF_DEC = 54272, HF_SLOT = 54784, HF_OUT = HF_SLOT0 + 2 * HF_SLOT;
static_assert(HF_OUT + 64 * 272 <= MISC_OFF, "stage-2 LDS map");
__device__ __forceinline__ void hgrn_stage2f(const Params& p, LAS unsigned char* lds, int item, int tid, int wave, int lane) {
    const int hd = item & 15, b = (item >> 4) & 1, dir = item >> 5;
    const int r32 = lane & 31, h = lane >> 5, dvt = wave & 3, tb = wave >> 2; const size_t item0 = (size_t)(((dir * 2 + b) * 16 + hd) * 65);
    LAS bf16_t* STB = (LAS bf16_t*)(lds + HF_STB);
    for (int i = tid; i < 128 * 136 / 2; i += NTHR) ((LAS unsigned*)STB)[i] = 0u;
    f32x16 st0, st1;
#pragma unroll
    for (int i = 0; i < 16; ++i) { st0[i] = 0.f; st1[i] = 0.f; }
    u32x4 R[7], R2[7];
    const unsigned lqs = HF_QS + (tid >> 4) * 272 + 16 * (tid & 15), lk = (tid >> 3) * 144 + 16 * (tid & 7);
#define HF_LD(R, ci) do { if ((ci) < 65) { const size_t it_ = item0 + (ci); const bf16_t* q_ = (const bf16_t*)(p.ws + WS_QSG) + it_ * 8192 + 8 * tid; const bf16_t* k_ = (const bf16_t*)(p.ws + WS_KSG) + it_ * 8192 + 8 * tid; \
        const bf16_t* v_ = (const bf16_t*)(p.ws + WS_VTG) + it_ * 8192 + 8 * tid; \
        R[0] = *(const u32x4*)q_; R[1] = *(const u32x4*)(q_ + 4096); R[2] = *(const u32x4*)k_; R[3] = *(const u32x4*)(k_ + 4096); R[4] = *(const u32x4*)v_; R[5] = *(const u32x4*)(v_ + 4096); \
        if (tid < 32) R[6] = *(const u32x4*)((const float*)(p.ws + WS_DECG) + it_ * 128 + 4 * tid); } } while (0)
#define HF_ST(R, ci) do { if ((ci) < 65) { LAS unsigned char* sl_ = lds + HF_SLOT0 + ((ci) & 1) * HF_SLOT; \
        *(LAS u32x4*)(sl_ + lqs) = R[0]; *(LAS u32x4*)(sl_ + lqs + 32 * 272) = R[1]; *(LAS u32x4*)(sl_ + HF_KST + lk) = R[2]; *(LAS u32x4*)(sl_ + HF_KST + lk + 64 * 144) = R[3]; \
        *(LAS u32x4*)(sl_ + HF_VT + lk) = R[4]; *(LAS u32x4*)(sl_ + HF_VT + lk + 64 * 144) = R[5]; if (tid < 32) *(LAS u32x4*)(sl_ + HF_DEC + 16 * tid) = R[6]; } } while (0)
    HF_LD(R, 0); HF_ST(R, 0); HF_LD(R, 1); HF_LD(R2, 2);
    bf16_t* OB2 = (bf16_t*)(p.ws + WS_OBP) + (size_t)2 * MP * 2048 + (size_t)dir * MP * 2048;
    lds_barrier();
    auto step = [&](int ci, u32x4 (&RX)[7]) {
        const LAS unsigned char* slot = lds + HF_SLOT0 + (ci & 1) * HF_SLOT;
        HF_ST(RX, ci + 1);
        HF_LD(RX, ci + 3);
        {
            f32x16 accO;
#pragma unroll
            for (int i = 0; i < 16; ++i) accO[i] = 0.f;
            const LAS bf16_t* sbp = STB + (32 * dvt + r32) * 136 + 8 * h; const LAS bf16_t* qsl = (const LAS bf16_t*)(slot + HF_QS) + (32 * tb + r32) * 136 + 8 * h;
#pragma unroll
            for (int stp = 0; stp < 8; ++stp) accO = __builtin_amdgcn_mfma_f32_32x32x16_bf16(*(const LAS bf16x8*)(sbp + 16 * stp), *(const LAS bf16x8*)(qsl + 16 * stp), accO, 0, 0, 0);
            LAS bf16_t* ot = (LAS bf16_t*)(lds + HF_OUT) + (32 * tb + r32) * 136 + 32 * dvt + 4 * h;
#pragma unroll
            for (int g4 = 0; g4 < 4; ++g4) *(LAS u32x2*)(ot + 8 * g4) = (u32x2){pk2(accO[4 * g4], accO[4 * g4 + 1]), pk2(accO[4 * g4 + 2], accO[4 * g4 + 3])};
        }
        lds_barrier();
#pragma unroll
        for (int j = 0; j < 2; ++j) { const int q = tid + 512 * j, tau = q >> 4, c16 = q & 15; const int row = hg_row(dir, b, ci, tau);
            if (row >= 0) *(u32x4*)(OB2 + (size_t)row * 2048 + hd * 128 + 8 * c16) = *(const LAS u32x4*)(lds + HF_OUT + tau * 272 + 16 * c16); }
        {
            const LAS bf16_t* vtl = (const LAS bf16_t*)(slot + HF_VT) + (32 * dvt + r32) * 72 + 8 * h;
            const int db0 = 2 * tb; const LAS float* decp = (const LAS float*)(slot + HF_DEC) + 32 * db0 + 4 * h;
            const LAS bf16_t* ks0 = (const LAS bf16_t*)(slot + HF_KST) + (32 * db0 + r32) * 72 + 8 * h; const LAS bf16_t* ks1 = ks0 + 32 * 72;
#pragma unroll
            for (int g4 = 0; g4 < 4; ++g4) { const f32x4 d0 = *(const LAS f32x4*)(decp + 8 * g4), d1 = *(const LAS f32x4*)(decp + 32 + 8 * g4);
#pragma unroll
                for (int k = 0; k < 4; ++k) { st0[4 * g4 + k] *= d0[k]; st1[4 * g4 + k] *= d1[k]; } }
#pragma unroll
            for (int stp = 0; stp < 4; ++stp) { const bf16x8 bv = *(const LAS bf16x8*)(vtl + 16 * stp);
                st0 = __builtin_amdgcn_mfma_f32_32x32x16_bf16(*(const LAS bf16x8*)(ks0 + 16 * stp), bv, st0, 0, 0, 0); st1 = __builtin_amdgcn_mfma_f32_32x32x16_bf16(*(const LAS bf16x8*)(ks1 + 16 * stp), bv, st1, 0, 0, 0); }
            LAS bf16_t* srow = STB + (32 * dvt + r32) * 136 + 32 * db0 + 4 * h;
#pragma unroll
            for (int g4 = 0; g4 < 4; ++g4) { *(LAS u32x2*)(srow + 8 * g4) = (u32x2){pk2(st0[4 * g4], st0[4 * g4 + 1]), pk2(st0[4 * g4 + 2], st0[4 * g4 + 3])};
                *(LAS u32x2*)(srow + 32 + 8 * g4) = (u32x2){pk2(st1[4 * g4], st1[4 * g4 + 1]), pk2(st1[4 * g4 + 2], st1[4 * g4 + 3])}; }
        }
        lds_barrier();
    };
#pragma unroll 1
    for (int c2 = 0; c2 < 64; c2 += 2) { step(c2, R); step(c2 + 1, R2); }
    step(64, R);
#undef HF_LD
#undef HF_ST
}

typedef float f32x4v __attribute__((ext_vector_type(4)));
__device__ __forceinline__ void natten_item(const Params& p, LAS float* tbl, int item, int jl, int lane) {
    const bf16_t* P = (const bf16_t*)(p.ws + WS_P); const bf16_t* VT = (const bf16_t*)(p.ws + WS_VT); bf16_t* Y = (bf16_t*)(p.ws + WS_Y);
    const bool ismeta = item >= 8192;
    int b, hd, r, j;
    if (ismeta) { const int t = item - 8192; b = t >> 4; hd = t & 15; r = 0; j = 0; } else { j = item & 3; r = (item >> 2) & 63; hd = (item >> 8) & 15; b = item >> 12; }
    const int q16 = lane & 15, h4 = lane >> 4;
    const int qrow = ismeta ? 8192 + 16 * b + q16 : b * 4096 + 64 * r + 16 * j + q16;
    const int kw0 = (j == 0) ? 0 : (j == 1) ? 8 : (j == 2) ? 24 : 32;
    const int r0 = (r - 4 < 0) ? 0 : ((r - 4 > 56) ? 56 : r - 4);
    const float* rpb = p.in[I_RPB] + ((size_t)jl * 16 + hd) * 15 * 31; const float* mb = p.in[I_MBIAS] + ((size_t)jl * 16 + hd) * 16;
    { float tv[8];
#pragma unroll
      for (int k = 0; k < 8; ++k) { const int idx = lane + 64 * k; tv[k] = rpb[idx < 465 ? idx : 464]; }
#pragma unroll
      for (int k = 0; k < 8; ++k) tbl[lane + 64 * k] = tv[k]; }
    bf16x8 QF[4];
#pragma unroll
    for (int stp = 0; stp < 4; ++stp) QF[stp] = *(const bf16x8*)(P + (size_t)qrow * EIN + QA_OFF + hd * 128 + 32 * stp + 8 * h4);
    f32x4 S[17];
    auto rowbase = [&](int i) -> int { return b * 4096 + 64 * (r0 + i) + kw0; };
    auto keyrow = [&](int kt) -> int { if (kt == 0) return 8192 + 16 * b + q16; const int i = (kt - 1) >> 1, half = (kt - 1) & 1; return rowbase(i) + 8 * (q16 >> 2) + 4 * half + (q16 & 3); };
    {
        const bf16_t* kb = P + KA_OFF + hd * 128 + 8 * h4;
        bf16x8 KF[2][3][4];
#define NA_LDK(buf, bt) do { _Pragma("unroll") for (int t_ = 0; t_ < 3; ++t_) { const int kt_ = 3 * (bt) + t_; if (kt_ < 17) { const bf16_t* kp_ = kb + (size_t)keyrow(kt_) * EIN; \
            _Pragma("unroll") for (int stp = 0; stp < 4; ++stp) KF[buf][t_][stp] = *(const bf16x8*)(kp_ + 32 * stp); } } } while (0)
#define NA_MMK(buf, bt) do { _Pragma("unroll") for (int t_ = 0; t_ < 3; ++t_) { const int kt_ = 3 * (bt) + t_; if (kt_ < 17) { f32x4 s_ = (f32x4){0.f, 0.f, 0.f, 0.f}; \
            _Pragma("unroll") for (int stp = 0; stp < 4; ++stp) s_ = __builtin_amdgcn_mfma_f32_16x16x32_bf16(KF[buf][t_][stp], QF[stp], s_, 0, 0, 0); S[kt_] = s_; } } } while (0)
        NA_LDK(0, 0); __builtin_amdgcn_sched_barrier(0);
        NA_LDK(1, 1); __builtin_amdgcn_sched_barrier(0); NA_MMK(0, 0); __builtin_amdgcn_sched_barrier(0);
        NA_LDK(0, 2); __builtin_amdgcn_sched_barrier(0); NA_MMK(1, 1); __builtin_amdgcn_sched_barrier(0);
        NA_LDK(1, 3); __builtin_amdgcn_sched_barrier(0); NA_MMK(0, 2); __builtin_amdgcn_sched_barrier(0);
        NA_LDK(0, 4); __builtin_amdgcn_sched_barrier(0); NA_MMK(1, 3); __builtin_amdgcn_sched_barrier(0);
        NA_LDK(1, 5); __builtin_amdgcn_sched_barrier(0); NA_MMK(0, 4); __builtin_amdgcn_sched_barrier(0);
        NA_MMK(1, 5);
#undef NA_LDK
#undef NA_MMK
    }
    const int qc = 16 * j + q16; const int c0 = (qc - 8 < 0) ? 0 : ((qc - 8 > 48) ? 48 : qc - 8);
    float mx = -3.0e38f;
#pragma unroll
    for (int reg = 0; reg < 4; ++reg) { S[0][reg] += mb[4 * h4 + reg]; mx = fmaxf(mx, S[0][reg]); }
    float rb[16][4];
#pragma unroll
    for (int kt = 1; kt < 17; ++kt) { const int i = (kt - 1) >> 1, half = (kt - 1) & 1;
#pragma unroll
        for (int reg = 0; reg < 4; ++reg) { int ci = kw0 + 8 * h4 + 4 * half + reg - qc + 15; ci = ci < 0 ? 0 : (ci > 30 ? 30 : ci); rb[kt - 1][reg] = tbl[((r0 + i) - r + 7) * 31 + ci]; } }
    __builtin_amdgcn_sched_barrier(0);
#pragma unroll
    for (int kt = 1; kt < 17; ++kt) { const int half = (kt - 1) & 1;
#pragma unroll
        for (int reg = 0; reg < 4; ++reg) { const int kc = kw0 + 8 * h4 + 4 * half + reg; const bool ok = !ismeta && kc >= c0 && kc < c0 + 16;
            const float v = ok ? S[kt][reg] + rb[kt - 1][reg] : -3.0e38f; S[kt][reg] = v; mx = fmaxf(mx, v); } }
    mx = fmaxf(mx, __shfl_xor(mx, 16)); mx = fmaxf(mx, __shfl_xor(mx, 32));
    float sum = 0.f;
#pragma unroll
    for (int kt = 0; kt < 17; ++kt)
#pragma unroll
        for (int reg = 0; reg < 4; ++reg) { const float e = (S[kt][reg] > -1.0e38f) ? __expf(S[kt][reg] - mx) : 0.f; S[kt][reg] = e; sum += e; }
    sum += __shfl_xor(sum, 16); sum += __shfl_xor(sum, 32);
    const float inv = 1.0f / sum;
    f32x4 O[8];
#pragma unroll
    for (int dt = 0; dt < 8; ++dt) O[dt] = (f32x4){0.f, 0.f, 0.f, 0.f};
    u32x4 PW[9];
    PW[0].x = pk2(S[0][0], S[0][1]); PW[0].y = pk2(S[0][2], S[0][3]); PW[0].z = 0u; PW[0].w = 0u;
#pragma unroll
    for (int u = 1; u < 9; ++u) { const int k0t = 2 * u - 1, k1t = 2 * u;
        PW[u].x = pk2(S[k0t][0], S[k0t][1]); PW[u].y = pk2(S[k0t][2], S[k0t][3]); PW[u].z = pk2(S[k1t][0], S[k1t][1]); PW[u].w = pk2(S[k1t][2], S[k1t][3]); }
    {
        const bf16_t* vb = VT + (size_t)(hd * 128 + q16) * MP;
        u32x4 VF[3][8];
#define NA_LDV(buf, u) do { if ((u) == 0) { _Pragma("unroll") for (int dt = 0; dt < 8; ++dt) { const u32x2 m_ = *(const u32x2*)(vb + (size_t)(16 * dt) * MP + 8192 + 16 * b + 4 * h4); VF[buf][dt] = (u32x4){m_.x, m_.y, 0u, 0u}; } } \
        else { const int t0_ = rowbase((u) - 1) + 8 * h4; _Pragma("unroll") for (int dt = 0; dt < 8; ++dt) VF[buf][dt] = *(const u32x4*)(vb + (size_t)(16 * dt) * MP + t0_); } } while (0)
#define NA_MMV(buf, u) do { _Pragma("unroll") for (int dt = 0; dt < 8; ++dt) \
        O[dt] = __builtin_amdgcn_mfma_f32_16x16x32_bf16(__builtin_bit_cast(bf16x8, VF[buf][dt]), __builtin_bit_cast(bf16x8, PW[u]), O[dt], 0, 0, 0); } while (0)
        NA_LDV(0, 0); NA_LDV(1, 1); __builtin_amdgcn_sched_barrier(0);
        NA_LDV(2, 2); __builtin_amdgcn_sched_barrier(0); NA_MMV(0, 0); __builtin_amdgcn_sched_barrier(0);
        NA_LDV(0, 3); __builtin_amdgcn_sched_barrier(0); NA_MMV(1, 1); __builtin_amdgcn_sched_barrier(0);
        NA_LDV(1, 4); __builtin_amdgcn_sched_barrier(0); NA_MMV(2, 2); __builtin_amdgcn_sched_barrier(0);
        NA_LDV(2, 5); __builtin_amdgcn_sched_barrier(0); NA_MMV(0, 3); __builtin_amdgcn_sched_barrier(0);
        NA_LDV(0, 6); __builtin_amdgcn_sched_barrier(0); NA_MMV(1, 4); __builtin_amdgcn_sched_barrier(0);
        NA_LDV(1, 7); __builtin_amdgcn_sched_barrier(0); NA_MMV(2, 5); __builtin_amdgcn_sched_barrier(0);
        NA_LDV(2, 8); __builtin_amdgcn_sched_barrier(0); NA_MMV(0, 6); __builtin_amdgcn_sched_barrier(0);
        NA_MMV(1, 7); NA_MMV(2, 8);
#undef NA_LDV
#undef NA_MMV
    }
#pragma unroll
    for (int dt = 0; dt < 8; ++dt) { const int col = hd * 128 + 16 * dt + 4 * h4;
        const u32x2 g = *(const u32x2*)(P + (size_t)qrow * EIN + GATE_OFF + col);
        u32x2 w; w.x = pk2(O[dt][0] * inv * bflo(g.x), O[dt][1] * inv * bfhi(g.x)); w.y = pk2(O[dt][2] * inv * bflo(g.y), O[dt][3] * inv * bfhi(g.y));
        *(u32x2*)(Y + (size_t)qrow * D + col) = w; }
}
__device__ __forceinline__ void phase_combine(const Params& p, int jl, int gw, int NGW, int lane) {
    const bf16_t* OB0 = (const bf16_t*)(p.ws + WS_OBP); const bf16_t* OB1 = OB0 + (size_t)MP * 2048; const bf16_t* OB2 = OB0 + (size_t)2 * MP * 2048; const bf16_t* OB3 = OB0 + (size_t)3 * MP * 2048;
    const bf16_t* P = (const bf16_t*)(p.ws + WS_P); bf16_t* Y = (bf16_t*)(p.ws + WS_Y);
    const float* gain = p.in[I_HGNORM] + (size_t)jl * 2048;
    f32x4 gv[8];
#pragma unroll
    for (int k = 0; k < 8; ++k) gv[k] = *(const f32x4*)(gain + 32 * lane + 4 * k);
    u32x4 a8[4], b8[4], c8[4], d8[4], g8[4], an[4], bn[4], cn[4], dn[4], gn[4];
#define CB_LOAD(A, B, C, Dd, Gt, m) do { _Pragma("unroll") for (int k = 0; k < 4; ++k) { A[k] = *(const u32x4*)(OB0 + (size_t)(m) * 2048 + 32 * lane + 8 * k); B[k] = *(const u32x4*)(OB1 + (size_t)(m) * 2048 + 32 * lane + 8 * k); \
        C[k] = *(const u32x4*)(OB2 + (size_t)(m) * 2048 + 32 * lane + 8 * k); Dd[k] = *(const u32x4*)(OB3 + (size_t)(m) * 2048 + 32 * lane + 8 * k); \
        Gt[k] = *(const u32x4*)(P + (size_t)(m) * EIN + GATE_OFF + 2048 + 32 * lane + 8 * k); } } while (0)
    int m = gw;
    if (m < MV) CB_LOAD(a8, b8, c8, d8, g8, m);
    for (; m < MV; m += NGW) {
        if (m + NGW < MV) CB_LOAD(an, bn, cn, dn, gn, m + NGW);
        f32x4 o[8]; float ss = 0.f;
#pragma unroll
        for (int k = 0; k < 4; ++k) {
            o[2 * k] = (f32x4){(bflo(a8[k].x) + bflo(c8[k].x)) + (bflo(b8[k].x) + bflo(d8[k].x)), (bfhi(a8[k].x) + bfhi(c8[k].x)) + (bfhi(b8[k].x) + bfhi(d8[k].x)),
                               (bflo(a8[k].y) + bflo(c8[k].y)) + (bflo(b8[k].y) + bflo(d8[k].y)), (bfhi(a8[k].y) + bfhi(c8[k].y)) + (bfhi(b8[k].y) + bfhi(d8[k].y))};
            o[2 * k + 1] = (f32x4){(bflo(a8[k].z) + bflo(c8[k].z)) + (bflo(b8[k].z) + bflo(d8[k].z)), (bfhi(a8[k].z) + bfhi(c8[k].z)) + (bfhi(b8[k].z) + bfhi(d8[k].z)),
                                   (bflo(a8[k].w) + bflo(c8[k].w)) + (bflo(b8[k].w) + bflo(d8[k].w)), (bfhi(a8[k].w) + bfhi(c8[k].w)) + (bfhi(b8[k].w) + bfhi(d8[k].w))}; }
#pragma unroll
        for (int k = 0; k < 8; ++k) ss += (o[k].x * o[k].x + o[k].y * o[k].y) + (o[k].z * o[k].z + o[k].w * o[k].w);
        ss += __shfl_xor(ss, 1); ss += __shfl_xor(ss, 2);
        const float rstd = 1.0f / sqrtf(ss * (1.0f / 128.0f) + EPS);
#pragma unroll
        for (int k2 = 0; k2 < 4; ++k2) { const u32x4 g = g8[k2]; const f32x4 ga = gv[2 * k2], gb = gv[2 * k2 + 1]; const f32x4 a = o[2 * k2], bq = o[2 * k2 + 1];
            u32x4 w; w.x = pk2(a.x * rstd * ga.x * bflo(g.x), a.y * rstd * ga.y * bfhi(g.x)); w.y = pk2(a.z * rstd * ga.z * bflo(g.y), a.w * rstd * ga.w * bfhi(g.y));
            w.z = pk2(bq.x * rstd * gb.x * bflo(g.z), bq.y * rstd * gb.y * bfhi(g.z)); w.w = pk2(bq.z * rstd * gb.z * bflo(g.w), bq.w * rstd * gb.w * bfhi(g.w));
            *(u32x4*)(Y + (size_t)m * D + 2048 + 32 * lane + 8 * k2) = w; }
#pragma unroll
        for (int k = 0; k < 4; ++k) { a8[k] = an[k]; b8[k] = bn[k]; c8[k] = cn[k]; d8[k] = dn[k]; g8[k] = gn[k]; }
    }
#undef CB_LOAD
}
__device__ __forceinline__ void phase_postnorm(const Params& p, LAS unsigned char* lds, int layer, int vcu, int G, int tid, int wave, int lane) {
    const bf16_t* OUT = (const bf16_t*)(p.ws + WS_OUT); float* H = (float*)(p.ws + WS_H); bf16_t* HN = (bf16_t*)(p.ws + WS_HN);
    const bool last = (layer == 3); const int MR = last ? NB * T : MV;
    const f32x4* gp4 = (const f32x4*)(p.in[I_NPOST] + (size_t)layer * D) + 2 * tid; const f32x4* gq4 = (const f32x4*)(p.in[I_NPRE] + (size_t)(last ? 0 : layer + 1) * D) + 2 * tid;
    const f32x4 gpa = gp4[0], gpb = gp4[1], gqa = gq4[0], gqb = gq4[1];
    LAS float* RED = (LAS float*)lds;
    f32x4 oa[3], ob[3], ha[3], hb[3];
#define PN_LOAD(s, m) do { const u32x4 o8_ = *(const u32x4*)(OUT + (size_t)(m) * D + 8 * tid); const f32x4* h4_ = (const f32x4*)(H + (size_t)(m) * D) + 2 * tid; \
        oa[s] = (f32x4){bflo(o8_.x), bfhi(o8_.x), bflo(o8_.y), bfhi(o8_.y)}; ob[s] = (f32x4){bflo(o8_.z), bfhi(o8_.z), bflo(o8_.w), bfhi(o8_.w)}; ha[s] = h4_[0]; hb[s] = h4_[1]; } while (0)
#define PN_ROW(s, m, par) do { \
        float ss = (oa[s].x * oa[s].x + oa[s].y * oa[s].y) + (oa[s].z * oa[s].z + oa[s].w * oa[s].w) + (ob[s].x * ob[s].x + ob[s].y * ob[s].y) + (ob[s].z * ob[s].z + ob[s].w * ob[s].w); \
        ss = wave_sum(ss); if (lane == 0) RED[(par) * 8 + wave] = ss; lds_barrier(); \
        float tot = 0.f; _Pragma("unroll") for (int w = 0; w < 8; ++w) tot += RED[(par) * 8 + w]; \
        const float rstd = 1.0f / sqrtf(tot * (1.0f / D) + EPS); \
        const f32x4 na = ha[s] + oa[s] * rstd * gpa, nb = hb[s] + ob[s] * rstd * gpb; \
        if (last) { f32x4* d4_ = (f32x4*)(p.out + (size_t)(m) * D) + 2 * tid; d4_[0] = na; d4_[1] = nb; } \
        else { f32x4* d4_ = (f32x4*)(H + (size_t)(m) * D) + 2 * tid; d4_[0] = na; d4_[1] = nb; \
            float s2 = (na.x * na.x + na.y * na.y) + (na.z * na.z + na.w * na.w) + (nb.x * nb.x + nb.y * nb.y) + (nb.z * nb.z + nb.w * nb.w); \
            s2 = wave_sum(s2); if (lane == 0) RED[16 + (par) * 8 + wave] = s2; lds_barrier(); \
            float t2 = 0.f; _Pragma("unroll") for (int w = 0; w < 8; ++w) t2 += RED[16 + (par) * 8 + w]; \
            const float r2 = 1.0f / sqrtf(t2 * (1.0f / D) + EPS); \
            *(u32x4*)(HN + (size_t)(m) * D + 8 * tid) = (u32x4){pk2(na.x * r2 * gqa.x, na.y * r2 * gqa.y), pk2(na.z * r2 * gqa.z, na.w * r2 * gqa.w), pk2(nb.x * r2 * gqb.x, nb.y * r2 * gqb.y), pk2(nb.z * r2 * gqb.z, nb.w * r2 * gqb.w)}; } \
    } while (0)
    int m0 = vcu;
    if (m0 < MR) PN_LOAD(0, m0); if (m0 + G < MR) PN_LOAD(1, m0 + G);
    int par = 0;
    for (; m0 < MR; m0 += 3 * G) {
        if (m0 + 2 * G < MR) PN_LOAD(2, m0 + 2 * G);
        PN_ROW(0, m0, par); par ^= 1;
        if (m0 + G < MR) { if (m0 + 3 * G < MR) PN_LOAD(0, m0 + 3 * G); PN_ROW(1, m0 + G, par); par ^= 1; }
        if (m0 + 2 * G < MR) { if (m0 + 4 * G < MR) PN_LOAD(1, m0 + 4 * G); PN_ROW(2, m0 + 2 * G, par); par ^= 1; }
    }
#undef PN_LOAD
#undef PN_ROW
    lds_barrier();
}
constexpr int LC_KCS = 16704;
constexpr int LC_KC = 0, LC_U1 = 4 * LC_KCS  , LC_US = 20480, LC_U2 = LC_U1 + LC_US, LC_X1 = LC_U2 + LC_US  , LC_XS = 16512, LC_X2 = LC_X1 + LC_XS, LC_TAIL = LC_X2 + LC_XS  , LC_END = LC_TAIL + 256;
static_assert(LC_END <= MISC_OFF, "long-conv LDS map");
__device__ __forceinline__ int lc_ugran(int b, int G) { return b * 10240 + (G & 3) * 2560 + (G >> 2) * 16; }
__device__ __forceinline__ int lc_tokrow(int b, int l) { return l < 16 ? 8192 + 16 * b + l : b * 4096 + l - 16; }
struct LcRaw { u32x4 mid; unsigned left, right; };
__device__ __forceinline__ void lc_load_raw(const bf16_t* urow, int b, int gl, LcRaw& r) {
    const int l0 = 8 * gl; r.mid = *(const u32x4*)(urow + lc_tokrow(b, l0));
    r.left = urow[lc_tokrow(b, l0 > 0 ? l0 - 1 : 0)]; r.right = urow[lc_tokrow(b, l0 + 8 < L ? l0 + 8 : L - 1)];
}
__device__ __forceinline__ void lc_load_raw_x(const bf16_t* urow, int b, int gl, int lane, LcRaw& r) {
    const int l0 = 8 * gl; r.mid = *(const u32x4*)(urow + lc_tokrow(b, l0));
    unsigned edge = 0u;
    if (lane == 0 || lane == 63) edge = urow[lc_tokrow(b, lane == 0 ? l0 - 1 : (l0 + 8 < L ? l0 + 8 : L - 1))];
    r.left = edge; r.right = edge;
}
__device__ __forceinline__ void lc_fix_edges(LcRaw& r, int lane) {
    const unsigned up = (unsigned)__shfl_up((int)(r.mid.w >> 16), 1), dn = (unsigned)__shfl_down((int)(r.mid.x & 0xffffu), 1);
    if (lane != 0) r.left = up; if (lane != 63) r.right = dn;
}
__device__ __forceinline__ u32x4 lc_conv3(const LcRaw& r, int gl, float w0, float w1, float w2) {
    float x[10]; x[0] = (gl > 0) ? bf1((bf16_t)r.left) : 0.f; x[9] = (8 * gl + 8 < L) ? bf1((bf16_t)r.right) : 0.f;
    x[1] = bflo(r.mid.x); x[2] = bfhi(r.mid.x); x[3] = bflo(r.mid.y); x[4] = bfhi(r.mid.y); x[5] = bflo(r.mid.z); x[6] = bfhi(r.mid.z); x[7] = bflo(r.mid.w); x[8] = bfhi(r.mid.w);
    float o[8];
#pragma unroll
    for (int k = 0; k < 8; ++k) o[k] = w0 * x[k] + w1 * x[k + 1] + w2 * x[k + 2];
    return (u32x4){pk2(o[0], o[1]), pk2(o[2], o[3]), pk2(o[4], o[5]), pk2(o[6], o[7])};
}
struct LcFilt { u32x4 a[3]; u32x2 n[3]; };
__device__ __forceinline__ void lc_load_filter(const bf16_t* krow, int tid, LcFilt& f) {
#pragma unroll
    for (int j = 0; j < 3; ++j) { const int m = tid + NTHR * j; const int mc = m < KLEN / 8 ? m : KLEN / 8 - 1, mn = mc + 1 < KLEN / 8 ? mc + 1 : KLEN / 8 - 1;
        f.a[j] = *(const u32x4*)(krow + 8 * mc); f.n[j] = *(const u32x2*)(krow + 8 * mn); }
}
__device__ __forceinline__ void lc_store_filter(const LcFilt& f, LAS unsigned char* lds, int tid) {
#pragma unroll
    for (int j = 0; j < 3; ++j) { const int m = tid + NTHR * j;
        if (m < KLEN / 8) { const bool lastc = (m + 1 >= KLEN / 8); const unsigned w[6] = {f.a[j].x, f.a[j].y, f.a[j].z, f.a[j].w, lastc ? 0u : f.n[j].x, lastc ? 0u : f.n[j].y};
            *(LAS u32x4*)(lds + LC_KC + 0 * LC_KCS + 16 * m) = (u32x4){__builtin_amdgcn_alignbit(w[1], w[0], 16), __builtin_amdgcn_alignbit(w[2], w[1], 16), __builtin_amdgcn_alignbit(w[3], w[2], 16), __builtin_amdgcn_alignbit(w[4], w[3], 16)};
            *(LAS u32x4*)(lds + LC_KC + 1 * LC_KCS + 16 * m) = (u32x4){w[1], w[2], w[3], w[4]};
            *(LAS u32x4*)(lds + LC_KC + 2 * LC_KCS + 16 * m) = (u32x4){__builtin_amdgcn_alignbit(w[2], w[1], 16), __builtin_amdgcn_alignbit(w[3], w[2], 16), __builtin_amdgcn_alignbit(w[4], w[3], 16), __builtin_amdgcn_alignbit(w[5], w[4], 16)};
            *(LAS u32x4*)(lds + LC_KC + 3 * LC_KCS + 16 * m) = (u32x4){w[2], w[3], w[4], w[5]}; } }
}
template <int VAR = 0> __device__ __forceinline__ void lc_conv(LAS unsigned char* lds, int uin_off, int wave, int lane, f32x16& accm) {
    const int g = wave; const int i32 = lane & 31, h = lane >> 5, n16 = lane & 15, b = (lane >> 4) & 1;
    const int e0 = 32 * g - 257;
    const int p0 = KOFF - 16 * e0 - i32 + 8 * h; const int sh = ((p0 - 1) & 3) + 1; const int q0 = p0 - sh;
    const LAS unsigned char* kpA = lds + LC_KC + (sh - 1) * LC_KCS + 2 * q0;
    const int I = 16 * g + n16;
    const int G0 = 4 * I - 2 * e0 + h + 60, G1 = G0 - 2;
    const LAS unsigned char* up0 = lds + uin_off + lc_ugran(b, G0); const LAS unsigned char* up1 = lds + uin_off + lc_ugran(b, G1);
    f32x16 acc0, acc1;
#pragma unroll
    for (int r = 0; r < 16; ++r) { acc0[r] = 0.f; acc1[r] = 0.f; }
    u32x2 fa[4], fb[4]; u32x4 fu[4];
    if (VAR != 0) { for (int j = 0; j < 4; ++j) { fa[j] = (u32x2){0u, 0u}; fb[j] = (u32x2){0u, 0u}; fu[j] = (u32x4){0u, 0u, 0u, 0u}; } }
    unsigned ka = (unsigned)(size_t)kpA - 96u, u0 = (unsigned)(size_t)up0 - 16u, u1 = (unsigned)(size_t)up1 - 16u;
#define LC_LD(j, jo, ko, uo) do { if (VAR == 0) asm volatile("ds_read_b64 %0, %3 offset:" #ko "\n\tds_read_b64 %1, %3 offset:" #ko "+8\n\tds_read_b128 %2, %4 offset:" #uo \
        : "=v"(fa[j]), "=v"(fb[j]), "=v"(fu[j]) : "v"(ka), "v"(((jo) & 1) ? u1 : u0) : "memory"); \
        else if (VAR == 1) asm volatile("ds_read_b64 %0, %2 offset:" #ko "\n\tds_read_b64 %1, %2 offset:" #ko "+8" : "=v"(fa[j]), "=v"(fb[j]) : "v"(ka) : "memory"); } while (0)
#define LC_WAIT(n, j) do { if (VAR == 0) asm volatile("s_waitcnt lgkmcnt(" #n ")" : "+v"(fa[j]), "+v"(fb[j]), "+v"(fu[j])); else if (VAR == 1) asm volatile("s_waitcnt lgkmcnt(" #n "*2/3)" : "+v"(fa[j]), "+v"(fb[j]), "+v"(fu[j])); else asm volatile("" : "+v"(fa[j]), "+v"(fb[j]), "+v"(fu[j])); } while (0)
#define LC_MM(j, acc) acc = __builtin_amdgcn_mfma_f32_32x32x16_bf16(__builtin_bit_cast(bf16x8, (u32x4){fa[j].x, fa[j].y, fb[j].x, fb[j].y}), __builtin_bit_cast(bf16x8, fu[j]), acc, 0, 0, 0)
    LC_LD(0, 0, 96, 16); LC_LD(1, 1, 64, 16); LC_LD(2, 2, 32, 0); LC_LD(3, 3, 0, 0);
    for (int k = 0; k < 71; ++k) {
        ka -= 128u; u0 -= 32u; u1 -= 32u;
        LC_WAIT(9, 0); LC_MM(0, acc0); LC_LD(0, 0, 96, 16);
        LC_WAIT(9, 1); LC_MM(1, acc1); LC_LD(1, 1, 64, 16);
        LC_WAIT(9, 2); LC_MM(2, acc0); LC_LD(2, 2, 32, 0);
        LC_WAIT(9, 3); LC_MM(3, acc1); LC_LD(3, 3, 0, 0);
    }
    LC_WAIT(9, 0); LC_MM(0, acc0); LC_WAIT(6, 1); LC_MM(1, acc1); LC_WAIT(3, 2); LC_MM(2, acc0); LC_WAIT(0, 3); LC_MM(3, acc1);
#undef LC_LD
#undef LC_WAIT
#undef LC_MM
    accm = acc0 + acc1;
    {
        const int h4 = lane >> 4; f32x4 t = (f32x4){0.f, 0.f, 0.f, 0.f};
        const int s_lo = 17 * wave, s_hi = (s_lo + 17 < 129) ? s_lo + 17 : 129;
        const int pt = 32 - n16 + 8 * h4; const int st_ = ((pt - 1) & 3) + 1; const LAS unsigned char* kt = lds + LC_KC + (st_ - 1) * LC_KCS + 2 * (pt - st_);
        const LAS unsigned char* ut = lds + uin_off + (n16 & 1) * 10240 + h4 * 2560 + 16 * 15;
        for (int s = s_lo; s < s_hi; ++s) {
            const u32x2 a0 = *(const LAS u32x2*)(kt + 64 * s), a1 = *(const LAS u32x2*)(kt + 64 * s + 8);
            u32x4 bw = *(const LAS u32x4*)(ut + 16 * s); if (n16 >= 2) bw = (u32x4){0u, 0u, 0u, 0u};
            t = __builtin_amdgcn_mfma_f32_16x16x32_bf16(__builtin_bit_cast(bf16x8, (u32x4){a0.x, a0.y, a1.x, a1.y}), __builtin_bit_cast(bf16x8, bw), t, 0, 0, 0);
        }
        if (n16 < 2) { LAS float* tl = (LAS float*)(lds + LC_TAIL) + n16 * 16 + 4 * h4;
#pragma unroll
            for (int r = 0; r < 4; ++r) (void)__hip_atomic_fetch_add(tl + r, t[r], __ATOMIC_RELAXED, __HIP_MEMORY_SCOPE_WORKGROUP); }
    }
}
__device__ __forceinline__ void lc_item(int tid, int j, int& b, int& gl) { if (j < 2) { b = j; gl = 2 + tid; } else { b = (tid >> 1) & 1; gl = tid & 1; } }
__device__ __forceinline__ void phase_longconv(const Params& p, LAS unsigned char* lds, int jl, int vcu, int G, int tid, int wave, int lane) {
    const bf16_t* UT = (const bf16_t*)(p.ws + WS_P); bf16_t* YT = (bf16_t*)(p.ws + WS_YT); const bf16_t* KT = (const bf16_t*)(p.ws + WS_KT);
    const float* wsh = p.in[I_HYSHORT] + (size_t)jl * 3 * 4096 * 3; const float* hb = p.in[I_HYBIAS] + (size_t)jl * 2 * 4096;
    for (int i = tid; i < 2 * LC_US / 16; i += NTHR) *(LAS u32x4*)(lds + LC_U1 + 16 * i) = (u32x4){0u, 0u, 0u, 0u};
    const int h = lane >> 5, n16 = lane & 15, bl = (lane >> 4) & 1;
    LcRaw rv[3], r1[3], r2[3]; LcFilt flt; float wv[9], nb0 = 0.f, nb1 = 0.f, nb0n = 0.f, nb1n = 0.f;
    auto load_channel = [&](int c) {
#pragma unroll
        for (int k = 0; k < 3; ++k) { wv[k] = wsh[c * 3 + k]; wv[3 + k] = wsh[(4096 + c) * 3 + k]; wv[6 + k] = wsh[(8192 + c) * 3 + k]; }
        nb0n = hb[c]; nb1n = hb[4096 + c];
#pragma unroll
        for (int j = 0; j < 2; ++j) { int b, gl; lc_item(tid, j, b, gl);
            lc_load_raw_x(UT + (size_t)c * MP, b, gl, lane, rv[j]); lc_load_raw_x(UT + (size_t)(4096 + c) * MP, b, gl, lane, r1[j]); lc_load_raw_x(UT + (size_t)(8192 + c) * MP, b, gl, lane, r2[j]); }
        if (tid < 4) { int b, gl; lc_item(tid, 2, b, gl);
            lc_load_raw(UT + (size_t)c * MP, b, gl, rv[2]); lc_load_raw(UT + (size_t)(4096 + c) * MP, b, gl, r1[2]); lc_load_raw(UT + (size_t)(8192 + c) * MP, b, gl, r2[2]); }
        lc_load_filter(KT + ((size_t)(jl * 2 + 0) * 4096 + c) * KLEN, tid, flt);
    };
    if (vcu < 4096) { load_channel(vcu); nb0 = nb0n; nb1 = nb1n; }
    lds_barrier();
    for (int c = vcu; c < 4096; c += G) {
        const bf16_t* grow = UT + (size_t)(12288 + c) * MP;
        const float bias0 = nb0, bias1 = nb1;
        SUBP_T0(10)
#pragma unroll
        for (int j = 0; j < 2; ++j) { lc_fix_edges(rv[j], lane); lc_fix_edges(r1[j], lane); lc_fix_edges(r2[j], lane); }
#pragma unroll
        for (int j = 0; j < 3; ++j) { if (j < 2 || tid < 4) { int b, gl; lc_item(tid, j, b, gl);
            *(LAS u32x4*)(lds + LC_U1 + lc_ugran(b, gl + 60)) = lc_conv3(rv[j], gl, wv[0], wv[1], wv[2]);
            *(LAS u32x4*)(lds + LC_X1 + b * 8224 + 16 * gl) = lc_conv3(r1[j], gl, wv[3], wv[4], wv[5]);
            *(LAS u32x4*)(lds + LC_X2 + b * 8224 + 16 * gl) = lc_conv3(r2[j], gl, wv[6], wv[7], wv[8]); } }
        lc_store_filter(flt, lds, tid);
        if (tid < 32) ((LAS float*)(lds + LC_TAIL))[tid] = 0.f;
        lc_load_filter(KT + ((size_t)(jl * 2 + 1) * 4096 + c) * KLEN, tid, flt);
        lds_barrier(); SUBP_T1(10)
        SUBP_T0(11)
        f32x16 acc;
#if MK_LCX
        { lc_conv<MK_LCX - 1>(lds, LC_U1, wave, lane, acc); asm volatile("" :: "v"(acc)); lds_barrier(); if (tid < 32) ((LAS float*)(lds + LC_TAIL))[tid] = 0.f; lds_barrier(); }
#endif
        lc_conv(lds, LC_U1, wave, lane, acc);
        lds_barrier(); SUBP_T1(11) SUBP_T0(12)
        {
            const int I = 16 * wave + n16;
#pragma unroll
            for (int rg = 0; rg < 4; ++rg) { const int t = 32 * I + 8 * rg + 4 * h; const int G8 = (t + 480) >> 3; const int uoff = lc_ugran(bl, G8) + 2 * (t & 7);
                const u32x2 uu = *(const LAS u32x2*)(lds + LC_U1 + uoff); const u32x2 xx = *(const LAS u32x2*)(lds + LC_X1 + bl * 8224 + 2 * t);
                const float z0 = bflo(xx.x) * (acc[4 * rg + 0] + bias0 * bflo(uu.x)), z1 = bfhi(xx.x) * (acc[4 * rg + 1] + bias0 * bfhi(uu.x));
                const float z2 = bflo(xx.y) * (acc[4 * rg + 2] + bias0 * bflo(uu.y)), z3 = bfhi(xx.y) * (acc[4 * rg + 3] + bias0 * bfhi(uu.y));
                *(LAS u32x2*)(lds + LC_U2 + uoff) = (u32x2){pk2(z0, z1), pk2(z2, z3)}; }
            if (tid < 32) { const int b = tid >> 4, i = tid & 15, t = 4096 + i; const int uoff = lc_ugran(b, (t + 480) >> 3) + 2 * (t & 7);
                const float u = bf1(*(const LAS bf16_t*)(lds + LC_U1 + uoff)), x = bf1(*(const LAS bf16_t*)(lds + LC_X1 + b * 8224 + 2 * t));
                const float y = ((LAS float*)(lds + LC_TAIL))[b * 16 + i];
                *(LAS bf16_t*)(lds + LC_U2 + uoff) = (bf16_t)f2bf(x * (y + bias0 * u)); }
        }
        lc_store_filter(flt, lds, tid);
        lds_barrier(); SUBP_T1(12) SUBP_T0(13)
        if (tid < 32) ((LAS float*)(lds + LC_TAIL))[tid] = 0.f;
        u32x2 gg[4]; bf16_t gtail = 0;
#pragma unroll
        for (int rg = 0; rg < 4; ++rg) gg[rg] = *(const u32x2*)(grow + lc_tokrow(bl, 32 * (16 * wave + n16) + 8 * rg + 4 * h));
        gtail = grow[lc_tokrow((tid >> 4) & 1, 4096 + (tid & 15))];
        if (c + G < 4096) load_channel(c + G);
        lds_barrier(); SUBP_T1(13) SUBP_T0(14)
        lc_conv(lds, LC_U2, wave, lane, acc);
        lds_barrier(); SUBP_T1(14) SUBP_T0(15)
        {
            const int I = 16 * wave + n16;
#pragma unroll
            for (int rg = 0; rg < 4; ++rg) { const int t = 32 * I + 8 * rg + 4 * h; const int G8 = (t + 480) >> 3; const int uoff = lc_ugran(bl, G8) + 2 * (t & 7);
                const u32x2 zz = *(const LAS u32x2*)(lds + LC_U2 + uoff); const u32x2 xx = *(const LAS u32x2*)(lds + LC_X2 + bl * 8224 + 2 * t);
                const int row = lc_tokrow(bl, t); const u32x2 g2 = gg[rg];
                const float o0 = bflo(xx.x) * (acc[4 * rg + 0] + bias1 * bflo(zz.x)) * bflo(g2.x), o1 = bfhi(xx.x) * (acc[4 * rg + 1] + bias1 * bfhi(zz.x)) * bfhi(g2.x);
                const float o2 = bflo(xx.y) * (acc[4 * rg + 2] + bias1 * bflo(zz.y)) * bflo(g2.y), o3 = bfhi(xx.y) * (acc[4 * rg + 3] + bias1 * bfhi(zz.y)) * bfhi(g2.y);
                *(u32x2*)(YT + (size_t)c * MP + row) = (u32x2){pk2(o0, o1), pk2(o2, o3)}; }
            if (tid < 32) { const int b = tid >> 4, i = tid & 15, t = 4096 + i; const int uoff = lc_ugran(b, (t + 480) >> 3) + 2 * (t & 7);
                const float z = bf1(*(const LAS bf16_t*)(lds + LC_U2 + uoff)), x = bf1(*(const LAS bf16_t*)(lds + LC_X2 + b * 8224 + 2 * t));
                const float y = ((LAS float*)(lds + LC_TAIL))[b * 16 + i]; const int row = lc_tokrow(b, t);
                YT[(size_t)c * MP + row] = (bf16_t)f2bf(x * (y + bias1 * z) * bf1(gtail)); }
        }
        asm volatile("" : "+v"(nb0n), "+v"(nb1n));
        nb0 = nb0n; nb1 = nb1n;
        lds_barrier(); SUBP_T1(15)
    }
}
__device__ __forceinline__ void phase_transpose(const Params& p, LAS unsigned char* lds, int gw, int NGW, int wave, int lane) {
    const bf16_t* YT = (const bf16_t*)(p.ws + WS_YT); bf16_t* Y = (bf16_t*)(p.ws + WS_Y);
    LAS bf16_t* tile = (LAS bf16_t*)(lds + wave * 8704);
    constexpr int NTT = MP / 64;
    for (int it = gw; it < (D / 64) * NTT; it += NGW) {
        const int ct = it / NTT, tt = it % NTT; const int c0 = 64 * ct, t0 = 64 * tt;
#pragma unroll
        for (int k = 0; k < 8; ++k) { const int cl = 8 * k + (lane >> 3), ch = lane & 7; const u32x4 v = *(const u32x4*)(YT + (size_t)(c0 + cl) * MP + t0 + 8 * ch);
            LAS unsigned* d = (LAS unsigned*)(tile + cl * 68 + 8 * ch); d[0] = v.x; d[1] = v.y; d[2] = v.z; d[3] = v.w; }
        LDS_WAIT(); asm volatile("" ::: "memory");
#pragma unroll
        for (int k = 0; k < 8; ++k) { const int tl = 8 * k + (lane >> 3), ch = lane & 7; const LAS bf16_t* s = tile + (8 * ch) * 68 + tl;
            u32x4 o; o.x = (unsigned)s[0] | ((unsigned)s[68] << 16); o.y = (unsigned)s[2 * 68] | ((unsigned)s[3 * 68] << 16); o.z = (unsigned)s[4 * 68] | ((unsigned)s[5 * 68] << 16); o.w = (unsigned)s[6 * 68] | ((unsigned)s[7 * 68] << 16);
            *(u32x4*)(Y + (size_t)(t0 + tl) * D + c0 + 8 * ch) = o; }
        LDS_WAIT(); asm volatile("" ::: "memory");
    }
}
constexpr int TG_ROWB = 528;
constexpr int TG_A = 0, TG_B = 32 * TG_ROWB, TG_BUF = 96 * TG_ROWB;
__device__ __forceinline__ void thin_gemm(const Params& p, LAS unsigned char* lds, int mode, int jp, const bf16_t* Ameta, const bf16_t* W, int N, int vcu, int G, int tid, int wave, int lane) {
    const int r32 = lane & 31, h = lane >> 5, nt = wave & 1, kq = wave >> 1; LAS float* RED = (LAS float*)lds;
    for (int nb = vcu; nb < N / 64; nb += G) {
        const int n0 = 64 * nb;
        u32x4 st[6];
#define TG_LOAD(kc) do { _Pragma("unroll") for (int j = 0; j < 6; ++j) { const int q_ = tid + NTHR * j; const int row_ = (q_ >> 5) & 63, col_ = q_ & 31; \
            const bf16_t* src_ = (j < 2) ? Ameta + (size_t)(q_ >> 5) * D : W + (size_t)(n0 + row_ - (j < 2 ? 0 : 0)) * D; \
            st[j] = *(const u32x4*)((j < 2 ? Ameta + (size_t)(q_ >> 5) * D : W + (size_t)(n0 + ((q_ - 1024) >> 5)) * D) + 256 * (kc) + 8 * col_); (void)src_; (void)row_; } } while (0)
#define TG_STORE(buf) do { _Pragma("unroll") for (int j = 0; j < 6; ++j) { const int q_ = tid + NTHR * j; const int col_ = q_ & 31; \
            const int off_ = (j < 2) ? TG_A + (q_ >> 5) * TG_ROWB : TG_B + ((q_ - 1024) >> 5) * TG_ROWB; *(LAS u32x4*)(lds + (buf) * TG_BUF + off_ + 16 * col_) = st[j]; } } while (0)
        f32x16 acc;
#pragma unroll
        for (int i = 0; i < 16; ++i) acc[i] = 0.f;
        TG_LOAD(0); TG_STORE(0); lds_barrier();
        for (int kc = 0; kc < 16; ++kc) {
            const int buf = kc & 1;
            if (kc + 1 < 16) TG_LOAD(kc + 1);
            const LAS unsigned char* ab = lds + buf * TG_BUF + TG_A + r32 * TG_ROWB + 128 * kq + 16 * h; const LAS unsigned char* bb = lds + buf * TG_BUF + TG_B + (32 * nt + r32) * TG_ROWB + 128 * kq + 16 * h;
#pragma unroll
            for (int s4 = 0; s4 < 4; ++s4) acc = __builtin_amdgcn_mfma_f32_32x32x16_bf16(*(const LAS bf16x8*)(ab + 32 * s4), *(const LAS bf16x8*)(bb + 32 * s4), acc, 0, 0, 0);
            if (kc + 1 < 16) TG_STORE(buf ^ 1);
            lds_barrier();
        }
#undef TG_LOAD
#undef TG_STORE
#pragma unroll
        for (int reg = 0; reg < 16; ++reg) RED[(wave * 32 + (reg & 3) + 8 * (reg >> 2) + 4 * h) * 33 + r32] = acc[reg];
        lds_barrier();
#pragma unroll
        for (int half = 0; half < 2; ++half) {
            const int nh0 = n0 + 32 * half;
            const int seg = (mode == 0) ? (nh0 >> 11) : 0; const bool transposed = (mode == 2) || (mode == 0 && seg == 2);
            float v[2]; int tok[2], nn[2];
#pragma unroll
            for (int k = 0; k < 2; ++k) { tok[k] = transposed ? 2 * (tid & 15) + k : (tid >> 4); nn[k] = transposed ? (tid >> 4) : 2 * (tid & 15) + k; float s = 0.f;
#pragma unroll
                for (int q4 = 0; q4 < 4; ++q4) s += RED[((2 * q4 + half) * 32 + tok[k]) * 33 + nn[k]];
                v[k] = s; }
            if (mode == 0) {
                const float* lb = (const float*)(p.ws + WS_LB) + (size_t)jp * 4096;
#pragma unroll
                for (int k = 0; k < 2; ++k) { const int n = nh0 + nn[k];
                    if (seg == 0) v[k] *= 0.08838834764831845f; else if (seg == 3) v[k] = pg8::silu_f(v[k]) * 0.08838834764831845f;
                    else if (seg == 5 || seg == 6) { const float x = fminf(fmaxf(v[k], -80.f), 80.f); const float sg = __builtin_amdgcn_rcpf(1.0f + __expf(-x)); const float l0 = lb[(seg - 5) * 2048 + (n & 2047)]; v[k] = __logf(l0 + (1.0f - l0) * sg); }
                    else if (seg >= 7) v[k] = pg8::silu_f(v[k]); }
                if (seg == 2) *(unsigned*)((bf16_t*)(p.ws + WS_VT) + (size_t)(nh0 - 4096 + nn[0]) * MP + 8192 + tok[0]) = pk2(v[0], v[1]);
                else *(unsigned*)((bf16_t*)(p.ws + WS_P) + (size_t)(8192 + tok[0]) * EIN + nh0 + nn[0]) = pk2(v[0], v[1]);
            } else if (mode == 1) {
                *(unsigned*)((bf16_t*)(p.ws + WS_OUT) + (size_t)(8192 + tok[0]) * D + nh0 + nn[0]) = pk2(v[0], v[1]);
            } else {
                if (nh0 >= 12288) { v[0] = pg8::silu_f(v[0]); v[1] = pg8::silu_f(v[1]); }
                *(unsigned*)((bf16_t*)(p.ws + WS_P) + (size_t)(nh0 + nn[0]) * MP + 8192 + tok[0]) = pk2(v[0], v[1]);
            }
        }
        lds_barrier();
    }
}
#define GEMM_ALIGN true
#define GEMM_SP2 true
__global__ void __launch_bounds__(NTHR, 2) mk_fwd(Params p) {
    extern __shared__ __attribute__((aligned(16))) unsigned char lds_raw[];
    LAS unsigned char* lds = (LAS unsigned char*)lds_raw;
    volatile LAS unsigned* MISC = (volatile LAS unsigned*)(lds + MISC_OFF);
    const int tid = threadIdx.x, lane = tid & 63, wave = __builtin_amdgcn_readfirstlane(tid >> 6);
    const int G = gridDim.x; const int bx = blockIdx.x; const int vcu = (G % 8 == 0) ? (bx % 8) * (G / 8) + bx / 8 : bx;
    const int gw = vcu * NWAVES + wave, NGW = G * NWAVES;
    unsigned char* ws = p.ws;
    for (int u = tid; u < (LDS_BYTES - MISC_OFF) / 4; u += NTHR) MISC[u] = 0u;
    __syncthreads();
    XcdBarrier bar; bar.bar = (unsigned*)(ws + WS_CTL) + CW_BAR; bar.x = 0; bar.st = nullptr;
#if !MK_PER_PHASE
    bar = xcd_barrier_post((unsigned*)(ws + WS_CTL) + CW_BAR, MISC);
#endif
    const int lo = p.ph_lo, hi = p.ph_hi;
#define FRESH() int tid_ = threadIdx.x; asm volatile("" : "+v"(tid_)); const int lane_ = tid_ & 63, wave_ = __builtin_amdgcn_readfirstlane(tid_ >> 6); \
    int vcu_ = vcu; asm volatile("" : "+s"(vcu_)); const int gw_ = vcu_ * NWAVES + wave_; Params q = p; { unsigned char* w_ = q.ws; asm volatile("" : "+s"(w_)); q.ws = w_; } unsigned char* ws_ = q.ws; (void)lane_; (void)gw_; (void)ws_;
#define IN(k) (lo <= (k) && (k) < hi)
#if MK_PER_PHASE
#define SEAM(k) do { } while (0)
#elif MK_TIME_MASK || MK_SUBPROBE
    unsigned long long t_prev = wall_clock64(), t_acc = 0;
#define SEAM(k) do { if (IN(k) && IN((k) + 1)) xcd_barrier(bar); { const unsigned long long now_ = wall_clock64(); if ((MK_TIME_MASK >> (k)) & 1u) t_acc += now_ - t_prev; t_prev = now_; } } while (0)
#else
#define SEAM(k) do { if (IN(k) && IN((k) + 1)) xcd_barrier(bar); } while (0)
#endif
    if (IN(0)) { FRESH() phase_prologue(q, lds, gw_, NGW, wave_, lane_); } SEAM(0);
    if (IN(1)) { FRESH() phase_filtergen(q, lds, gw_, NGW, wave_, lane_); } SEAM(1);
    for (int jp = 0; jp < 2; ++jp) {
        const int pb = 2 + 11 * jp;
        if (IN(pb + 0)) { FRESH() const bf16_t* HN = (const bf16_t*)(ws_ + WS_HN);
            const bf16_t* W = (const bf16_t*)(ws_ + WS_WEIN) + (size_t)jp * EIN * D;
            pg8::DualOrder S; S.init(HN, W, NB * T, EIN - 2048, W + (size_t)4096 * D, HN, 2048, NB * T, D, G, bx, 16, 8);
            pg8::EpiEvenIn E{(bf16_t*)(ws_ + WS_P), EIN, (bf16_t*)(ws_ + WS_VT), MP, (const float*)(ws_ + WS_LB) + (size_t)jp * 4096};
            pg8::gemm_phase<pg8::EpiEvenIn, pg8::DualOrder, GEMM_ALIGN, GEMM_SP2>(lds, D, S, E);
            SUBP_T0(3) thin_gemm(q, lds, 0, jp, HN + (size_t)NB * T * D, W, EIN, vcu_, G, tid_, wave_, lane_); SUBP_T1(3)
        } SEAM(pb + 0);
        if (IN(pb + 1)) { FRESH()
            SUBP_T0(1) hgrn_stage1(q, lds, vcu_, G, tid_, wave_, lane_); SUBP_T1(1)
            SUBP_T0(2) for (int it = gw_; it < NA_SPLIT; it += NGW) natten_item(q, (LAS float*)(lds + wave_ * 2048), it, jp, lane_); SUBP_T1(2)
        } SEAM(pb + 1);
        if (IN(pb + 2)) { FRESH()
            if (G >= 128) {
                if (bx < 64) { SUBP_T0(30) hgrn_stage2f(q, lds, bx, tid_, wave_, lane_); SUBP_T1(30)
                    const int u = (bx & 7) * 8 + (bx >> 3);
                    for (int it = NA_TAIL + u * NWAVES + wave_; it < 8192 + 32; it += 64 * NWAVES) natten_item(q, (LAS float*)(lds + wave_ * 2048), it, jp, lane_); }
                else { const int nw = G - 64, b2 = bx - 64; const int u = ((nw & 7) == 0) ? (b2 & 7) * (nw >> 3) + (b2 >> 3) : b2;
                    for (int it = NA_SPLIT + u * NWAVES + wave_; it < NA_TAIL; it += nw * NWAVES) natten_item(q, (LAS float*)(lds + wave_ * 2048), it, jp, lane_); }
            } else {
                for (int item = bx; item < 64; item += G) hgrn_stage2f(q, lds, item, tid_, wave_, lane_);
                for (int it = NA_SPLIT + gw_; it < 8192 + 32; it += NGW) natten_item(q, (LAS float*)(lds + wave_ * 2048), it, jp, lane_);
            }
        } SEAM(pb + 2);
        if (IN(pb + 3)) { FRESH() phase_combine(q, jp, gw_, NGW, lane_); } SEAM(pb + 3);
        if (IN(pb + 4)) { FRESH()
            pg8::DualOrder S; S.init(ws_ + WS_Y, (const bf16_t*)(ws_ + WS_WEOUT) + (size_t)jp * D * D, NB * T, D, nullptr, nullptr, 0, 0, D, G, bx, 1 << 30, 0);
            pg8::EpiBf16Plain E{(bf16_t*)(ws_ + WS_OUT), D};
            pg8::gemm_phase<pg8::EpiBf16Plain, pg8::DualOrder, GEMM_ALIGN, GEMM_SP2>(lds, D, S, E);
            thin_gemm(q, lds, 1, jp, (const bf16_t*)(ws_ + WS_Y) + (size_t)NB * T * D, (const bf16_t*)(ws_ + WS_WEOUT) + (size_t)jp * D * D, D, vcu_, G, tid_, wave_, lane_);
        } SEAM(pb + 4);
        if (IN(pb + 5)) { FRESH() phase_postnorm(q, lds, 2 * jp, vcu_, G, tid_, wave_, lane_); } SEAM(pb + 5);
        if (IN(pb + 6)) { FRESH() const bf16_t* HN = (const bf16_t*)(ws_ + WS_HN);
            pg8::DualOrder S; S.init((const bf16_t*)(ws_ + WS_WOIN) + (size_t)jp * OIN * D, HN, OIN, NB * T, nullptr, nullptr, 0, 0, D, G, bx, 1 << 30, 0);
            pg8::EpiOddIn E{(bf16_t*)(ws_ + WS_P), MP, 48};
            pg8::gemm_phase<pg8::EpiOddIn, pg8::DualOrder, GEMM_ALIGN, GEMM_SP2>(lds, D, S, E);
            SUBP_T0(5) thin_gemm(q, lds, 2, jp, HN + (size_t)NB * T * D, (const bf16_t*)(ws_ + WS_WOIN) + (size_t)jp * OIN * D, OIN, vcu_, G, tid_, wave_, lane_); SUBP_T1(5)
        } SEAM(pb + 6);
        if (IN(pb + 7)) { FRESH() phase_longconv(q, lds, jp, vcu_, G, tid_, wave_, lane_); } SEAM(pb + 7);
        if (IN(pb + 8)) { FRESH() phase_transpose(q, lds, gw_, NGW, wave_, lane_); } SEAM(pb + 8);
        if (IN(pb + 9)) { FRESH()
            pg8::DualOrder S; S.init(ws_ + WS_Y, (const bf16_t*)(ws_ + WS_WOOUT) + (size_t)jp * D * D, NB * T, D, nullptr, nullptr, 0, 0, D, G, bx, 1 << 30, 0);
            pg8::EpiBf16Plain E{(bf16_t*)(ws_ + WS_OUT), D};
            pg8::gemm_phase<pg8::EpiBf16Plain, pg8::DualOrder, GEMM_ALIGN, GEMM_SP2>(lds, D, S, E);
            thin_gemm(q, lds, 1, jp, (const bf16_t*)(ws_ + WS_Y) + (size_t)NB * T * D, (const bf16_t*)(ws_ + WS_WOOUT) + (size_t)jp * D * D, D, vcu_, G, tid_, wave_, lane_);
        } SEAM(pb + 9);
        if (IN(pb + 10)) { FRESH() phase_postnorm(q, lds, 2 * jp + 1, vcu_, G, tid_, wave_, lane_); } SEAM(pb + 10);
    }
#if (MK_TIME_MASK || MK_SUBPROBE) && !MK_PER_PHASE
    if (blockIdx.x == 0) { __syncthreads(); const unsigned long long sub_ = ((unsigned long long)MISC[5] << 32) | MISC[4]; const unsigned long long t_end = wall_clock64(); while (wall_clock64() - t_end < (unsigned long long)MK_TIME_MULT * (t_acc + sub_)) __builtin_amdgcn_s_sleep(8); }
#endif
#undef IN
#undef SEAM
}

extern "C" void kernel_launch(void* const* d_in, const int* in_sizes, int n_in, void* d_out, int out_size, void* d_ws, size_t ws_size, hipStream_t stream) {
    static int grid = 0;
    if (grid == 0) {
        if (n_in != 21 || ws_size < WS_END) { fprintf(stderr, "kernel_launch: expected 21 inputs and >= %zu bytes of workspace; got %d, %zu\n", (size_t)WS_END, n_in, ws_size); grid = -1; return; }
        int dev = 0, cus = 0, per_cu = 0;
        if (hipGetDevice(&dev) != hipSuccess || hipDeviceGetAttribute(&cus, hipDeviceAttributeMultiprocessorCount, dev) != hipSuccess) { grid = -1; return; }
        if (hipFuncSetAttribute((const void*)mk_fwd, hipFuncAttributeMaxDynamicSharedMemorySize, LDS_BYTES) != hipSuccess) { fprintf(stderr, "kernel_launch: hipFuncSetAttribute failed\n"); grid = -1; return; }
        if (hipOccupancyMaxActiveBlocksPerMultiprocessor(&per_cu, (const void*)mk_fwd, NTHR, LDS_BYTES) != hipSuccess || per_cu < 1)
            fprintf(stderr, "kernel_launch: note: occupancy query reports %d workgroups per CU\n", per_cu);
        (void)hipGetLastError();
        grid = cus;
    }
    if (grid < 0) return;
    if (hipMemsetAsync((char*)d_ws + WS_CTL, 0, CTL_ZERO_BYTES, stream) != hipSuccess) return;
    Params a{};
    for (int i = 0; i < 21; ++i) a.in[i] = (const float*)d_in[i];
    a.out = (float*)d_out; a.ws = (unsigned char*)d_ws;
#if MK_PER_PHASE
    for (int ph = 0; ph < NPHASE; ++ph) { a.ph_lo = ph; a.ph_hi = ph + 1; hipLaunchKernelGGL(mk_fwd, dim3(grid), dim3(NTHR), LDS_BYTES, stream, a); }
#else
    a.ph_lo = 0; a.ph_hi = NPHASE; hipLaunchKernelGGL(mk_fwd, dim3(grid), dim3(NTHR), LDS_BYTES, stream, a);
#endif
    const hipError_t le = hipPeekAtLastError();
    if (le != hipSuccess) fprintf(stderr, "kernel_launch: launch failed: %s\n", hipGetErrorName(le));
}
```

```cpp
#include <hip/hip_runtime.h>
#include <cstdio>
#include <cstdint>
#ifndef MK_PER_PHASE
#define MK_PER_PHASE 0
#endif
#ifndef MK_TIME_MASK
#define MK_TIME_MASK 0u
#endif
#ifndef MK_TIME_MULT
#define MK_TIME_MULT 4
#endif
#ifndef MK_SUBPROBE
#define MK_SUBPROBE 0
#endif
#ifndef MK_LCX
#define MK_LCX 0
#endif
namespace pg8 {
#define PG8_LAS __attribute__((address_space(3)))
typedef unsigned short bf16_t;
typedef short bf16x8 __attribute__((ext_vector_type(8)));
typedef float f32x4 __attribute__((ext_vector_type(4)));
typedef unsigned u32x4 __attribute__((ext_vector_type(4)));
constexpr int BM = 256, BK = 64, HALF = 128, HTB = HALF * BK * 2  , STAGE_BYTES = 8 * HTB, NXCD = 8, WGM = 8;

__host__ __device__ __forceinline__ int lds_byte(int r, int c) { const int st = (r >> 4) * 2 + (c >> 5), rr = r & 15, cc = c & 31, ob = rr * 64 + cc * 2; return st * 1024 + (ob ^ (((ob >> 9) & 1) << 5)); }
__host__ __device__ __forceinline__ void stage_rc(int b, int& R, int& C) { const int st = b / 1024, sb = b % 1024, swz = sb ^ (((sb >> 9) & 1) << 5); R = (st >> 1) * 16 + swz / 64; C = (st & 1) * 32 + (swz % 64) / 2; }
__host__ __device__ __forceinline__ int perm32(int rho) { const int n = rho >> 4, i = rho & 15; return 8 * (i >> 2) + 4 * n + (i & 3); }

struct Unit { int pm, pn, kind; };

struct DualOrder {
    const char *A0, *B0, *A1, *B1; int nM0, nN0, n0, nM1, nN1, n1, G, c, skip_lo, skip_n; size_t tstep;
    __device__ void init(const void* a0, const void* b0, int M0, int N0, const void* a1, const void* b1, int M1, int N1, int K, int G_, int c_, int sl, int sn) {
        A0 = (const char*)a0; B0 = (const char*)b0; A1 = (const char*)a1; B1 = (const char*)b1; nM0 = M0 / BM; nN0 = N0 / BM; n0 = nM0 * nN0; nM1 = M1 / BM; nN1 = N1 / BM; n1 = nM1 * nN1;
        G = G_; c = c_; skip_lo = sl; skip_n = sn; tstep = (size_t)BM * K * 2; }
    __device__ bool next(int i, Unit& u) const {
        const long L = (long)i * G + c; const int nwg = n0 + n1; if (L >= nwg) return false;
        int wgid = (int)L; { const int q = nwg / NXCD, r = nwg % NXCD, xcd = wgid % NXCD, off = wgid / NXCD; wgid = (xcd < r ? xcd * (q + 1) : r * (q + 1) + (xcd - r) * q) + off; }
        int nM, nN, kind;
        if (wgid < n0) { nM = nM0; nN = nN0; kind = 0; } else { wgid -= n0; nM = nM1; nN = nN1; kind = 1; }
        const int nig = WGM * nN, gid = wgid / nig, fm = gid * WGM, gsz = (nM - fm) < WGM ? (nM - fm) : WGM;
        u.pm = fm + ((wgid % nig) % gsz); int pn = (wgid % nig) / gsz; if (kind == 0 && pn >= skip_lo) pn += skip_n; u.pn = pn; u.kind = kind; return true;
    }
    __device__ __forceinline__ const char* abase(const Unit& u) const { return (u.kind ? A1 : A0) + (size_t)u.pm * tstep; }
    __device__ __forceinline__ const char* bbase(const Unit& u) const { return (u.kind ? B1 : B0) + (size_t)u.pn * tstep; }
    __device__ __forceinline__ void a_ready(const Unit&) const {}
    __device__ __forceinline__ void done(const Unit&) const {}
};

typedef __bf16 bf16x2_t __attribute__((ext_vector_type(2)));
typedef float f32x2_t __attribute__((ext_vector_type(2)));
__device__ __forceinline__ unsigned cvt_pk_bf16(float lo, float hi) { const f32x2_t v = {lo, hi}; const bf16x2_t b = __builtin_convertvector(v, bf16x2_t); return __builtin_bit_cast(unsigned, b); }

struct EpiF32 {
    static constexpr bool PERM = false, AFTER_DRAIN = false;
    float* C; int ldc;
    __device__ __forceinline__ void operator()(const f32x4 (&acc)[2][2][4][2], const Unit& u, int wr, int wc, int fr, int fq) const {
        const int row0 = u.pm * BM + wr * 64 + fr, col0 = u.pn * BM + wc * 32 + 4 * fq;
#pragma unroll
        for (int ai = 0; ai < 2; ++ai)
#pragma unroll
            for (int m = 0; m < 4; ++m) { float* rowp = C + (size_t)(row0 + ai * HALF + m * 16) * ldc + col0;
#pragma unroll
                for (int bj = 0; bj < 2; ++bj)
#pragma unroll
                    for (int n = 0; n < 2; ++n) *(f32x4*)(rowp + bj * HALF + n * 16) = acc[ai][bj][m][n]; }
    }
};
struct EpiBf16Plain {
    static constexpr bool PERM = true, AFTER_DRAIN = false;
    bf16_t* O; int ldc;
    __device__ __forceinline__ void operator()(const f32x4 (&acc)[2][2][4][2], const Unit& u, int wr, int wc, int fr, int fq) const {
        const int row0 = u.pm * BM + wr * 64 + fr; const int col0 = u.pn * BM + wc * 32 + 8 * fq;
#pragma unroll
        for (int ai = 0; ai < 2; ++ai)
#pragma unroll
            for (int m = 0; m < 4; ++m) { bf16_t* rowp = O + (size_t)(row0 + ai * HALF + m * 16) * ldc + col0;
#pragma unroll
                for (int bj = 0; bj < 2; ++bj) { const f32x4 v0 = acc[ai][bj][m][0], v1 = acc[ai][bj][m][1];
                    u32x4 w; w.x = cvt_pk_bf16(v0[0], v0[1]); w.y = cvt_pk_bf16(v0[2], v0[3]); w.z = cvt_pk_bf16(v1[0], v1[1]); w.w = cvt_pk_bf16(v1[2], v1[3]);
                    *(u32x4*)(rowp + bj * HALF) = w; } }
    }
};
__device__ __forceinline__ float silu_f(float x) { return x * __builtin_amdgcn_rcpf(1.0f + __expf(-x)); }
struct EpiEvenIn {
    static constexpr bool PERM = true, AFTER_DRAIN = false;
    bf16_t* P; int ldp; bf16_t* VT; int ldv; const float* lb;
    __device__ __forceinline__ void operator()(const f32x4 (&acc)[2][2][4][2], const Unit& u, int wr, int wc, int fr, int fq) const {
        const int row0 = u.pm * BM + wr * 64 + fr; const int col0 = u.pn * BM + wc * 32 + 8 * fq;
        bf16_t* base = u.kind ? VT : P; const int ldc = u.kind ? ldv : ldp;
        const int seg = u.kind ? 1 : (u.pn >> 3);
        const int mode = (seg == 0) ? 1 : (seg == 3) ? 2 : (seg == 5 || seg == 6) ? 3 : (seg >= 7) ? 4 : 0;
        f32x4 lbv[2][2];
#pragma unroll
        for (int bj = 0; bj < 2; ++bj)
#pragma unroll
            for (int n = 0; n < 2; ++n) lbv[bj][n] = (mode == 3) ? *(const f32x4*)(lb + (seg - 5) * 2048 + ((col0 + bj * HALF + 4 * n) & 2047)) : (f32x4){0.f, 0.f, 0.f, 0.f};
#pragma unroll
        for (int ai = 0; ai < 2; ++ai)
#pragma unroll
            for (int m = 0; m < 4; ++m) { bf16_t* rowp = base + (size_t)(row0 + ai * HALF + m * 16) * ldc + col0;
#pragma unroll
                for (int bj = 0; bj < 2; ++bj) { f32x4 v[2] = {acc[ai][bj][m][0], acc[ai][bj][m][1]};
                    if (mode == 1) { v[0] = v[0] * 0.08838834764831845f; v[1] = v[1] * 0.08838834764831845f; }
                    else if (mode == 2) {
#pragma unroll
                        for (int n = 0; n < 2; ++n)
#pragma unroll
                            for (int k = 0; k < 4; ++k) v[n][k] = silu_f(v[n][k]) * 0.08838834764831845f; }
                    else if (mode == 3) {
#pragma unroll
                        for (int n = 0; n < 2; ++n)
#pragma unroll
                            for (int k = 0; k < 4; ++k) { const float x = fminf(fmaxf(v[n][k], -80.f), 80.f); const float sg = __builtin_amdgcn_rcpf(1.0f + __expf(-x)); const float l0 = lbv[bj][n][k];
                                v[n][k] = __logf(l0 + (1.0f - l0) * sg); } }
                    else if (mode == 4) {
#pragma unroll
                        for (int n = 0; n < 2; ++n)
#pragma unroll
                            for (int k = 0; k < 4; ++k) v[n][k] = silu_f(v[n][k]); }
                    u32x4 w; w.x = cvt_pk_bf16(v[0][0], v[0][1]); w.y = cvt_pk_bf16(v[0][2], v[0][3]); w.z = cvt_pk_bf16(v[1][0], v[1][1]); w.w = cvt_pk_bf16(v[1][2], v[1][3]);
                    *(u32x4*)(rowp + bj * HALF) = w; } }
    }
};
struct EpiOddIn {
    static constexpr bool PERM = true, AFTER_DRAIN = false;
    bf16_t* O; int ldc; int gate_pm0;
    __device__ __forceinline__ void operator()(const f32x4 (&acc)[2][2][4][2], const Unit& u, int wr, int wc, int fr, int fq) const {
        const int row0 = u.pm * BM + wr * 64 + fr; const int col0 = u.pn * BM + wc * 32 + 8 * fq; const bool gate = u.pm >= gate_pm0;
#pragma unroll
        for (int ai = 0; ai < 2; ++ai)
#pragma unroll
            for (int m = 0; m < 4; ++m) { bf16_t* rowp = O + (size_t)(row0 + ai * HALF + m * 16) * ldc + col0;
#pragma unroll
                for (int bj = 0; bj < 2; ++bj) { f32x4 v[2] = {acc[ai][bj][m][0], acc[ai][bj][m][1]};
                    if (gate) {
#pragma unroll
                        for (int n = 0; n < 2; ++n)
#pragma unroll
                            for (int k = 0; k < 4; ++k) v[n][k] = silu_f(v[n][k]); }
                    u32x4 w; w.x = cvt_pk_bf16(v[0][0], v[0][1]); w.y = cvt_pk_bf16(v[0][2], v[0][3]); w.z = cvt_pk_bf16(v[1][0], v[1][1]); w.w = cvt_pk_bf16(v[1][2], v[1][3]);
                    *(u32x4*)(rowp + bj * HALF) = w; } }
    }
};
template <class Epi, class Sched, bool ALIGN_EPI = false, bool SP2 = false>
__device__ __forceinline__ void gemm_phase(PG8_LAS unsigned char* lds, const int K, const Sched& S, const Epi& E) {
    int tid = threadIdx.x; asm volatile("" : "+v"(tid));
    const int wid = __builtin_amdgcn_readfirstlane(tid >> 6), lane = tid & 63, wr = wid >> 2, wc = wid & 3, fr = lane & 15, fq = lane >> 4;
    const int nt = K / BK;
    unsigned voffA[2], voffB[2];
#pragma unroll
    for (int i = 0; i < 2; ++i) { int R, C; stage_rc(tid * 16 + i * 8192, R, C); const int Rb = Epi::PERM ? ((R & ~31) + perm32(R & 31)) : R;
        voffA[i] = (unsigned)(R * K + C) * 2u; voffB[i] = (unsigned)(Rb * K + C) * 2u; }
    const size_t kstep = (size_t)(BK * 2);
    const size_t hstep = (size_t)HALF * K * 2;
    const size_t tstep = 2 * hstep;
    const unsigned ldsw = (unsigned)wid * 1024u;
    const int aoff = lds_byte(wr * 64 + fr, fq * 8), boff = lds_byte(wc * 32 + fr, fq * 8);
#define PG8_SA(b, h) (((b) * 2 + (h)) * HTB)
#define PG8_SB(b, h) ((4 + (b) * 2 + (h)) * HTB)
#define PG8_STAGE(bufoff, gbase, voff) do { _Pragma("unroll") for (int _i = 0; _i < 2; ++_i) \
        __builtin_amdgcn_global_load_lds((const unsigned*)((const char*)(gbase) + (voff)[_i]), (PG8_LAS unsigned*)(lds + (bufoff) + ldsw + _i * 8192), 16, 0, 0); } while (0)
#define PG8_LDA(dst, b, h) do { _Pragma("unroll") for (int m = 0; m < 4; ++m) _Pragma("unroll") for (int k = 0; k < 2; ++k) dst[m][k] = *(const PG8_LAS bf16x8*)(lds + PG8_SA(b, h) + aoff + m * 2048 + k * 1024); } while (0)
#define PG8_LDB(dst, b, h) do { _Pragma("unroll") for (int n = 0; n < 2; ++n) _Pragma("unroll") for (int k = 0; k < 2; ++k) dst[n][k] = *(const PG8_LAS bf16x8*)(lds + PG8_SB(b, h) + boff + n * 2048 + k * 1024); } while (0)
#define PG8_MMA(ai, bj, At, Bt) do { __builtin_amdgcn_s_setprio(1); _Pragma("unroll") for (int m = 0; m < 4; ++m) _Pragma("unroll") for (int n = 0; n < 2; ++n) _Pragma("unroll") for (int k = 0; k < 2; ++k) \
        acc[ai][bj][m][n] = __builtin_amdgcn_mfma_f32_16x16x32_bf16(Bt[n][k], At[m][k], acc[ai][bj][m][n], 0, 0, 0); __builtin_amdgcn_s_setprio(0); } while (0)
#define PG8_WAIT_V(n) asm volatile("s_waitcnt vmcnt(" #n ")" ::: "memory")
#define PG8_WAIT_L(n) asm volatile("s_waitcnt lgkmcnt(" #n ")" ::: "memory")
#define PG8_BAR __builtin_amdgcn_s_barrier()
#define PG8_SCHED __builtin_amdgcn_sched_barrier(0)
    Unit cur, nxt; int ui = 0;
    if (!S.next(0, cur)) return;
    f32x4 acc[2][2][4][2];
#pragma unroll
    for (int a = 0; a < 2; ++a)
#pragma unroll
        for (int b = 0; b < 2; ++b)
#pragma unroll
            for (int m = 0; m < 4; ++m)
#pragma unroll
                for (int n = 0; n < 2; ++n) acc[a][b][m][n] = (f32x4){0.f, 0.f, 0.f, 0.f};
    bf16x8 At[4][2], B0[2][2], B1[2][2];
    const char* cA = S.abase(cur); const char* cB = S.bbase(cur);
    S.a_ready(cur);
    if constexpr (SP2) {
        PG8_STAGE(PG8_SB(0, 0), cB, voffB); PG8_STAGE(PG8_SB(0, 1), cB + hstep, voffB); PG8_STAGE(PG8_SA(0, 0), cA, voffA); PG8_STAGE(PG8_SA(0, 1), cA + hstep, voffA);
        if (wr == 1) PG8_BAR;
        PG8_WAIT_V(2); PG8_BAR;
        PG8_STAGE(PG8_SB(1, 0), cB + kstep, voffB); PG8_STAGE(PG8_SA(1, 0), cA + kstep, voffA); PG8_STAGE(PG8_SB(1, 1), cB + hstep + kstep, voffB);
        PG8_WAIT_V(6); PG8_BAR;
    } else {
        PG8_STAGE(PG8_SB(0, 0), cB, voffB); PG8_STAGE(PG8_SA(0, 0), cA, voffA); PG8_STAGE(PG8_SB(0, 1), cB + hstep, voffB); PG8_STAGE(PG8_SA(0, 1), cA + hstep, voffA);
        if (wr == 1) PG8_BAR;
        PG8_WAIT_V(4); PG8_BAR;
        PG8_STAGE(PG8_SB(1, 0), cB + kstep, voffB); PG8_STAGE(PG8_SA(1, 0), cA + kstep, voffA); PG8_STAGE(PG8_SB(1, 1), cB + hstep + kstep, voffB);
        PG8_WAIT_V(6); PG8_BAR;
    }
    for (;;) {
        const bool has_next = S.next(ui + 1, nxt);
        const char* nA = has_next ? S.abase(nxt) : cA; const char* nB = has_next ? S.bbase(nxt) : cB;
        for (int t = 0; t < nt; t += 2) {
            const bool last = (t == nt - 2);
            const char* a1 = cA + (size_t)(t + 1) * kstep;
            const char* a2 = last ? nA : cA + (size_t)(t + 2) * kstep; const char* b2 = last ? nB : cB + (size_t)(t + 2) * kstep;
            const char* a3 = a2 + kstep; const char* b3 = b2 + kstep;
            if (last && has_next) S.a_ready(nxt);
            if constexpr (SP2) {
            PG8_LDB(B0, 0, 0); PG8_LDB(B1, 0, 1); PG8_SCHED; PG8_LDA(At, 0, 0); PG8_STAGE(PG8_SA(1, 1), a1 + hstep, voffA);
            PG8_WAIT_V(8); PG8_WAIT_L(0); PG8_BAR; PG8_MMA(0, 0, At, B0); PG8_MMA(0, 1, At, B1); PG8_BAR; PG8_SCHED;
            PG8_LDA(At, 0, 1); PG8_STAGE(PG8_SB(0, 0), b2, voffB); PG8_STAGE(PG8_SB(0, 1), b2 + hstep, voffB); PG8_STAGE(PG8_SA(0, 0), a2, voffA);
            PG8_WAIT_V(8); PG8_WAIT_L(0); PG8_BAR; PG8_MMA(1, 0, At, B0); PG8_MMA(1, 1, At, B1); PG8_BAR; PG8_SCHED;
            PG8_LDB(B0, 1, 0); PG8_LDB(B1, 1, 1); PG8_SCHED; PG8_LDA(At, 1, 0); PG8_STAGE(PG8_SA(0, 1), a2 + hstep, voffA);
            PG8_WAIT_V(8); PG8_WAIT_L(0); PG8_BAR; PG8_MMA(0, 0, At, B0); PG8_MMA(0, 1, At, B1); PG8_BAR; PG8_SCHED;
            PG8_LDA(At, 1, 1); PG8_STAGE(PG8_SB(1, 0), b3, voffB); PG8_STAGE(PG8_SB(1, 1), b3 + hstep, voffB); PG8_STAGE(PG8_SA(1, 0), a3, voffA);
            PG8_WAIT_V(8); PG8_WAIT_L(0); PG8_BAR; PG8_MMA(1, 0, At, B0); PG8_MMA(1, 1, At, B1); PG8_BAR; PG8_SCHED;
            } else {
            PG8_LDB(B0, 0, 0); PG8_SCHED; PG8_LDA(At, 0, 0); PG8_STAGE(PG8_SA(1, 1), a1 + hstep, voffA);
            PG8_WAIT_L(8); PG8_BAR; PG8_WAIT_L(0); PG8_MMA(0, 0, At, B0); PG8_BAR; PG8_SCHED;
            PG8_LDB(B1, 0, 1); PG8_STAGE(PG8_SB(0, 0), b2, voffB);
            PG8_BAR; PG8_WAIT_L(0); PG8_MMA(0, 1, At, B1); PG8_BAR;
            PG8_LDA(At, 0, 1); PG8_STAGE(PG8_SA(0, 0), a2, voffA);
            PG8_BAR; PG8_WAIT_L(0); PG8_MMA(1, 0, At, B0); PG8_BAR; PG8_SCHED;
            PG8_STAGE(PG8_SB(0, 1), b2 + hstep, voffB);
            PG8_WAIT_V(6); PG8_BAR; PG8_MMA(1, 1, At, B1); PG8_BAR;
            PG8_LDB(B0, 1, 0); PG8_SCHED; PG8_LDA(At, 1, 0); PG8_STAGE(PG8_SA(0, 1), a2 + hstep, voffA);
            PG8_WAIT_L(8); PG8_BAR; PG8_WAIT_L(0); PG8_MMA(0, 0, At, B0); PG8_BAR; PG8_SCHED;
            PG8_LDB(B1, 1, 1); PG8_STAGE(PG8_SB(1, 0), b3, voffB);
            PG8_BAR; PG8_WAIT_L(0); PG8_MMA(0, 1, At, B1); PG8_BAR;
            PG8_LDA(At, 1, 1); PG8_STAGE(PG8_SA(1, 0), a3, voffA);
            PG8_BAR; PG8_WAIT_L(0); PG8_MMA(1, 0, At, B0); PG8_BAR; PG8_SCHED;
            PG8_STAGE(PG8_SB(1, 1), b3 + hstep, voffB);
            PG8_WAIT_V(6); PG8_BAR; PG8_MMA(1, 1, At, B1); PG8_BAR;
            }
        }
        if constexpr (ALIGN_EPI) { if (wr == 0) PG8_BAR; }
        if constexpr (!Epi::AFTER_DRAIN) { E(acc, cur, wr, wc, fr, fq); S.done(cur); }
        if (!has_next) break;
#pragma unroll
        for (int a = 0; a < 2; ++a)
#pragma unroll
            for (int b = 0; b < 2; ++b)
#pragma unroll
                for (int m = 0; m < 4; ++m)
#pragma unroll
                    for (int n = 0; n < 2; ++n) acc[a][b][m][n] = (f32x4){0.f, 0.f, 0.f, 0.f};
        cur = nxt; cA = nA; cB = nB; ++ui;
        if constexpr (ALIGN_EPI) { if (wr == 1) PG8_BAR; }
    }
    PG8_WAIT_V(0);
    if constexpr (!ALIGN_EPI) { if (wr == 0) PG8_BAR; }
    PG8_BAR;

#undef PG8_SA
#undef PG8_SB
#undef PG8_STAGE
#undef PG8_LDA
#undef PG8_LDB
#undef PG8_MMA
#undef PG8_WAIT_V
#undef PG8_WAIT_L
#undef PG8_BAR
#undef PG8_SCHED
}
}
constexpr int NB = 2, T = 4096, NMETA = 16, L = T + NMETA, D = 4096;
constexpr int MV = NB * L;
constexpr int MP = 8448;
constexpr int EIN = 18432, OIN = 16384, HD = 128;
constexpr int QA_OFF = 0, KA_OFF = 2048, QB_OFF = 6144, IB_OFF = 8192, FF_OFF = 10240, FB_OFF = 12288, GATE_OFF = 14336;
constexpr int KOFF = 4128, KLEN = 8256;
constexpr int LPAD = 4128;
constexpr float EPS = 1e-6f;
constexpr int NWAVES = 8, NTHR = 512;
constexpr int NPHASE = 24;
constexpr int NA_SPLIT = 0, NA_TAIL = 7680;

constexpr size_t MiB = 1u << 20;
constexpr size_t WS_CTL = 0, CTL_ZERO_BYTES = 1 * MiB;
constexpr size_t WS_WEIN = 1 * MiB;
constexpr size_t WS_WEOUT = WS_WEIN + 2 * (size_t)EIN * D * 2;
constexpr size_t WS_WOIN = WS_WEOUT + 2 * (size_t)D * D * 2;
constexpr size_t WS_WOOUT = WS_WOIN + 2 * (size_t)OIN * D * 2;
constexpr size_t WS_H = WS_WOOUT + 2 * (size_t)D * D * 2;
constexpr size_t WS_HN = WS_H + (size_t)MP * D * 4;
constexpr size_t WS_P = WS_HN + (size_t)MP * D * 2;
constexpr size_t WS_VT = WS_P + (size_t)MP * EIN * 2;
constexpr size_t WS_Y = WS_VT + (size_t)2048 * MP * 2;
constexpr size_t WS_YT = WS_Y + (size_t)MP * D * 2;
constexpr size_t WS_OBP = WS_YT + (size_t)MP * D * 2;
constexpr size_t WS_OUT = WS_OBP + (size_t)2 * MP * 2048 * 4;
constexpr size_t WS_KT = WS_OUT + (size_t)MP * D * 4;
constexpr size_t WS_HID2 = WS_KT + (size_t)2 * 2 * 4096 * KLEN * 2;
constexpr size_t WS_LB = WS_HID2 + (size_t)2 * LPAD * 64 * 2;
constexpr size_t WS_QSG = WS_LB + (size_t)2 * 2 * 2048 * 4;
constexpr size_t WS_KSG = WS_QSG + (size_t)4160 * 8192 * 2;
constexpr size_t WS_VTG = WS_KSG + (size_t)4160 * 8192 * 2;
constexpr size_t WS_DECG = WS_VTG + (size_t)4160 * 8192 * 2;
constexpr size_t WS_END = WS_DECG + (size_t)4160 * 128 * 4;
static_assert(WS_WEIN % 256 == 0 && WS_H % 256 == 0 && WS_P % 256 == 0 && WS_KT % 256 == 0 && WS_HID2 % 256 == 0 && WS_LB % 256 == 0, "alignment");
constexpr int CW_BAR = 4096;

constexpr int LDS_BYTES = 163840;
constexpr int MISC_OFF = 162816;

#define LAS __attribute__((address_space(3)))
typedef unsigned short bf16_t;
typedef short bf16x8 __attribute__((ext_vector_type(8)));
typedef short bf16x4 __attribute__((ext_vector_type(4)));
typedef float f32x4 __attribute__((ext_vector_type(4)));
typedef float f32x16 __attribute__((ext_vector_type(16)));
typedef unsigned u32x4 __attribute__((ext_vector_type(4)));
typedef unsigned u32x2 __attribute__((ext_vector_type(2)));
#define LDS_WAIT() asm volatile("s_waitcnt lgkmcnt(0)" ::: "memory")
#define VM_WAIT() asm volatile("s_waitcnt vmcnt(0)" ::: "memory")
__device__ __forceinline__ unsigned f2bf(float f) { return pg8::cvt_pk_bf16(f, 0.f) & 0xffffu; }
__device__ __forceinline__ unsigned pk2(float lo, float hi) { return pg8::cvt_pk_bf16(lo, hi); }
__device__ __forceinline__ float bflo(unsigned w) { return __builtin_bit_cast(float, w << 16); }
__device__ __forceinline__ float bfhi(unsigned w) { return __builtin_bit_cast(float, w & 0xffff0000u); }
__device__ __forceinline__ float bf1(bf16_t w) { return __builtin_bit_cast(float, ((unsigned)w) << 16); }
__device__ __forceinline__ void lds_barrier() { asm volatile("s_waitcnt lgkmcnt(0)" ::: "memory"); __builtin_amdgcn_s_barrier(); asm volatile("" ::: "memory"); }
__device__ __forceinline__ float wave_sum(float v) {
#pragma unroll
    for (int o = 1; o < 64; o <<= 1) v += __shfl_xor(v, o);
    return v;
}

#define XB_TMO      128
#define XB_XCNT(j)  (256  + 64 * (j))
#define XB_XSUB(j)  (1280 + 64 * (j))
#define XB_XGEN(j)  (2304 + 64 * (j))
#define XB_TOP      3328
#define XB_TOPGEN   3392
#define XCD_BAR_WORDS 3456
#define XB_SPIN_CAP (1u << 20)
__device__ __forceinline__ unsigned xb_ld(unsigned* p)              { return __hip_atomic_load(p, __ATOMIC_RELAXED, __HIP_MEMORY_SCOPE_AGENT); }
__device__ __forceinline__ unsigned xb_add(unsigned* p, unsigned v) { return __hip_atomic_fetch_add(p, v, __ATOMIC_RELAXED, __HIP_MEMORY_SCOPE_AGENT); }
__device__ __forceinline__ unsigned xb_xcc_id() { return (unsigned)__builtin_amdgcn_s_getreg((3 << 11) | 20) & 0xFu; }
#define XB_SPIN(cond, bar) do { unsigned _sp = 0; while (cond) { __builtin_amdgcn_s_sleep(1); \
    if ((++_sp & 255u) == 0u) { if (xb_ld(&(bar)[XB_TMO])) break; if (_sp > XB_SPIN_CAP) { atomicAdd(&(bar)[XB_TMO], 1u); break; } } } } while (0)
struct XcdBarrier { unsigned* bar; unsigned x; volatile LAS unsigned* st; };
__device__ __forceinline__ XcdBarrier xcd_barrier_post(unsigned* bar, volatile LAS unsigned* st) {
    XcdBarrier b; b.bar = bar; b.x = xb_xcc_id(); b.st = st;
    if (threadIdx.x == 0) (void)xb_add(&bar[XB_XCNT(b.x)], 1u);
    return b;
}
__device__ __forceinline__ void xcd_barrier_complete(unsigned* bar, unsigned x, unsigned& nloc, unsigned& nx) {
    const unsigned G = gridDim.x * gridDim.y * gridDim.z;
    unsigned sum, cnt, mine, sp = 0u;
    for (;;) {
        sum = 0u; cnt = 0u; mine = 0u;
#pragma unroll
        for (unsigned j = 0; j < 16; ++j) { const unsigned c = xb_ld(&bar[XB_XCNT(j)]); sum += c; cnt += (c > 0u) ? 1u : 0u; mine = (j == x) ? c : mine; }
        if (sum == G) break;
        __builtin_amdgcn_s_sleep(1);
        if ((++sp & 255u) == 0u) { if (xb_ld(&bar[XB_TMO])) break; if (sp > XB_SPIN_CAP) { atomicAdd(&bar[XB_TMO], 1u); break; } }
    }
    nloc = mine > 0u ? mine : 1u; nx = cnt > 0u ? cnt : 1u;
}
__device__ __forceinline__ void xcd_barrier(const XcdBarrier& b) {
    asm volatile("s_waitcnt vmcnt(0)" ::: "memory");
    __syncthreads();
    if (threadIdx.x == 0) {
        unsigned* bar = b.bar;
        __builtin_amdgcn_s_waitcnt(0);
        unsigned nloc = b.st[0], nx = b.st[1];
        if (nloc == 0u) { xcd_barrier_complete(bar, b.x, nloc, nx); b.st[0] = nloc; b.st[1] = nx; }
        const unsigned old = xb_add(&bar[XB_XSUB(b.x)], 1u);
        const unsigned gen = old / nloc;
        if (old + 1u == (gen + 1u) * nloc) {
            __builtin_amdgcn_fence(__ATOMIC_RELEASE, "agent");
            asm volatile("s_waitcnt vmcnt(0)" ::: "memory");
            const unsigned og = xb_add(&bar[XB_TOP], 1u);
            const unsigned tg = og / nx;
            if (og + 1u == (tg + 1u) * nx) xb_add(&bar[XB_TOPGEN], 1u);
            else XB_SPIN(xb_ld(&bar[XB_TOPGEN]) == tg, bar);
            __builtin_amdgcn_fence(__ATOMIC_ACQUIRE, "agent");
            xb_add(&bar[XB_XGEN(b.x)], 1u);
            asm volatile("s_waitcnt vmcnt(0)" ::: "memory");
        } else {
            XB_SPIN(xb_ld(&bar[XB_XGEN(b.x)]) == gen, bar);
            __builtin_amdgcn_fence(__ATOMIC_ACQUIRE, "agent");
            asm volatile("s_waitcnt vmcnt(0)" ::: "memory");
        }
    }
    __syncthreads();
}

struct Params { const float* in[21]; float* out; unsigned char* ws; int ph_lo, ph_hi; };
enum { I_X = 0, I_META, I_NPRE, I_NPOST, I_EWIN, I_EWOUT, I_RPB, I_MBIAS, I_HGLOW, I_HGNORM, I_OWIN, I_OWOUT, I_HYSHORT, I_W1, I_B1, I_FR1, I_W2, I_B2, I_FR2, I_W3, I_HYBIAS };

#if MK_SUBPROBE
#define SUBP_T0(id) unsigned long long sp_t0_##id = 0; if (MK_SUBPROBE == (id)) sp_t0_##id = wall_clock64();
#define SUBP_T1(id) if (MK_SUBPROBE == (id) && threadIdx.x == 0) { volatile LAS unsigned* M_ = (volatile LAS unsigned*)(lds + MISC_OFF); const unsigned long long d_ = wall_clock64() - sp_t0_##id + (((unsigned long long)M_[5] << 32) | M_[4]); M_[4] = (unsigned)d_; M_[5] = (unsigned)(d_ >> 32); }
#else
#define SUBP_T0(id)
#define SUBP_T1(id)
#endif
struct P0Item { const float* W; bf16_t* WT; int N, k0, n0; };
__device__ __forceinline__ P0Item p0_item(const Params& p, int it) {
    constexpr int I_EIN = (D / 64) * (EIN / 256), I_SQ = (D / 64) * (D / 256), I_OIN = (D / 64) * (OIN / 256), I_LAYER = I_EIN + 2 * I_SQ + I_OIN;
    const int j = it / I_LAYER; int r = it % I_LAYER; P0Item x;
    if (r < I_EIN) { x.W = p.in[I_EWIN] + (size_t)j * D * EIN; x.WT = (bf16_t*)(p.ws + WS_WEIN) + (size_t)j * EIN * D; x.N = EIN; }
    else if ((r -= I_EIN) < I_SQ) { x.W = p.in[I_EWOUT] + (size_t)j * D * D; x.WT = (bf16_t*)(p.ws + WS_WEOUT) + (size_t)j * D * D; x.N = D; }
    else if ((r -= I_SQ) < I_OIN) { x.W = p.in[I_OWIN] + (size_t)j * D * OIN; x.WT = (bf16_t*)(p.ws + WS_WOIN) + (size_t)j * OIN * D; x.N = OIN; }
    else { r -= I_OIN; x.W = p.in[I_OWOUT] + (size_t)j * D * D; x.WT = (bf16_t*)(p.ws + WS_WOOUT) + (size_t)j * D * D; x.N = D; }
    const int nblk = x.N / 256; x.k0 = 64 * (r / nblk); x.n0 = 256 * (r % nblk); return x;
}
__device__ __forceinline__ void p0_load(const P0Item& x, int tid, f32x4 (&v)[8]) {
#pragma unroll
    for (int j = 0; j < 8; ++j) { const int q = tid + NTHR * j; v[j] = *(const f32x4*)(x.W + (size_t)(x.k0 + (q >> 6)) * x.N + x.n0 + 4 * (q & 63)); }
}
__device__ __forceinline__ void rms_row_to_bf16(const f32x4 (&v)[16], const float* g, bf16_t* orow, int lane) {
    float s = 0.f;
#pragma unroll
    for (int j = 0; j < 16; ++j) s += (v[j].x * v[j].x + v[j].y * v[j].y) + (v[j].z * v[j].z + v[j].w * v[j].w);
    const float rstd = 1.0f / sqrtf(wave_sum(s) * (1.0f / D) + EPS);
    const f32x4* g4 = (const f32x4*)g + lane; u32x2* o8 = (u32x2*)orow + lane;
#pragma unroll
    for (int j = 0; j < 16; ++j) { const f32x4 gg = g4[64 * j]; u32x2 w; w.x = pk2(v[j].x * rstd * gg.x, v[j].y * rstd * gg.y); w.y = pk2(v[j].z * rstd * gg.z, v[j].w * rstd * gg.w); o8[64 * j] = w; }
}
__device__ __forceinline__ void phase_prologue(const Params& p, LAS unsigned char* lds, int gw, int NGW, int wave, int lane) {
    unsigned char* ws = p.ws;
    {
        LAS float* tile = (LAS float*)lds;
        constexpr int NITEMS = 2 * ((D / 64) * (EIN / 256) + 2 * (D / 64) * (D / 256) + (D / 64) * (OIN / 256));
        const int vcu = gw / NWAVES, G = NGW / NWAVES, tid = wave * 64 + lane;
        f32x4 v[8]; P0Item cur;
        if (vcu < NITEMS) { cur = p0_item(p, vcu); p0_load(cur, tid, v); }
        for (int it = vcu; it < NITEMS; it += G) {
#pragma unroll
            for (int j = 0; j < 8; ++j) { const int q = tid + NTHR * j; *(LAS f32x4*)(tile + (q >> 6) * 260 + 4 * (q & 63)) = v[j]; }
            lds_barrier();
            const P0Item me = cur;
            if (it + G < NITEMS) { cur = p0_item(p, it + G); p0_load(cur, tid, v); }
#pragma unroll
            for (int half = 0; half < 2; ++half) { const int n = 128 * half + (tid >> 2), kq = tid & 3; const LAS float* s = tile + (16 * kq) * 260 + n;
                u32x4 o0, o1;
                o0.x = pk2(s[0 * 260], s[1 * 260]); o0.y = pk2(s[2 * 260], s[3 * 260]); o0.z = pk2(s[4 * 260], s[5 * 260]); o0.w = pk2(s[6 * 260], s[7 * 260]);
                o1.x = pk2(s[8 * 260], s[9 * 260]); o1.y = pk2(s[10 * 260], s[11 * 260]); o1.z = pk2(s[12 * 260], s[13 * 260]); o1.w = pk2(s[14 * 260], s[15 * 260]);
                bf16_t* d = me.WT + (size_t)(me.n0 + n) * D + me.k0 + 16 * kq;
                *(u32x4*)d = o0; *(u32x4*)(d + 8) = o1; }
            lds_barrier();
        }
    }
    float* H = (float*)(ws + WS_H); bf16_t* HN = (bf16_t*)(ws + WS_HN);
    for (int m = gw; m < MP; m += NGW) {
        f32x4 v[16];
        if (m < MV) {
            const float* src = (m < NB * T) ? p.in[I_X] + (size_t)m * D : p.in[I_META] + (size_t)((m - NB * T) & 15) * D;
#pragma unroll
            for (int j = 0; j < 16; ++j) v[j] = ((const f32x4*)src)[lane + 64 * j];
#pragma unroll
            for (int j = 0; j < 16; ++j) ((f32x4*)(H + (size_t)m * D))[lane + 64 * j] = v[j];
            rms_row_to_bf16(v, p.in[I_NPRE], HN + (size_t)m * D, lane);
        } else {
#pragma unroll
            for (int j = 0; j < 16; ++j) ((u32x2*)(HN + (size_t)m * D))[lane + 64 * j] = (u32x2){0u, 0u};
        }
    }
    { float* LB = (float*)(ws + WS_LB); const float* hl = p.in[I_HGLOW];
      for (int i = gw * 64 + lane; i < 2 * 2048; i += NGW * 64) { LB[i] = 0.f; LB[4096 + i] = 1.0f / (1.0f + __expf(hl[i] - hl[4096 + i])); } }
    { bf16_t* HID2 = (bf16_t*)(ws + WS_HID2);
      for (int it = gw; it < 2 * LPAD; it += NGW) {
        const int jl = it / LPAD, l = it % LPAD; float h2 = 0.f;
        if (l < L) {
            float z = 0.f;
            if (lane == 0) z = (float)l * (1.0f / (float)(L - 1));
            else if (lane < 33) { const int k = (lane - 1) & 15; const float band = 1e-4f + (float)k * ((15.0f - 1e-4f) / 15.0f); float rev = band * ((float)l / (float)L); rev -= floorf(rev);
                z = (lane < 17) ? __builtin_amdgcn_cosf(rev) : -__builtin_amdgcn_sinf(rev); }
            const float* w1 = p.in[I_W1] + (size_t)jl * 33 * 64; const float* w2 = p.in[I_W2] + (size_t)jl * 64 * 64;
            float a = p.in[I_B1][jl * 64 + lane];
#pragma unroll
            for (int i = 0; i < 33; ++i) a += __shfl(z, i) * w1[i * 64 + lane];
            const float h1 = __sinf(p.in[I_FR1][jl * 64 + lane] * a);
            float a2 = p.in[I_B2][jl * 64 + lane];
#pragma unroll 16
            for (int i = 0; i < 64; ++i) a2 += __shfl(h1, i) * w2[i * 64 + lane];
            h2 = __sinf(p.in[I_FR2][jl * 64 + lane] * a2);
        }
        HID2[(size_t)it * 64 + lane] = (bf16_t)f2bf(h2);
      } }
}

__device__ __forceinline__ void phase_filtergen(const Params& p, LAS unsigned char* lds, int gw, int NGW, int wave, int lane) {
    unsigned char* ws = p.ws; const bf16_t* HID2 = (const bf16_t*)(ws + WS_HID2); bf16_t* KT = (bf16_t*)(ws + WS_KT);
    const int r32 = lane & 31, h = lane >> 5;
    LAS bf16_t* tile = (LAS bf16_t*)(lds + wave * 5120);
    for (int wi = gw; wi < 2048; wi += NGW) {
        const int lpart = wi & 3, cb = (wi >> 2) & 127, n = (wi >> 9) & 1, jl = wi >> 10; const int c0 = cb * 32;
        const float* w3 = p.in[I_W3] + (size_t)jl * 64 * 16384;
        bf16x8 A[2][4];
#pragma unroll
        for (int dir = 0; dir < 2; ++dir)
#pragma unroll
            for (int st = 0; st < 4; ++st) { const float* src = w3 + (size_t)(16 * st + 8 * h) * 16384 + (dir * 2 + n) * 4096 + c0 + r32;
                u32x4 w; w.x = pk2(src[0], src[16384]); w.y = pk2(src[2 * 16384], src[3 * 16384]); w.z = pk2(src[4 * 16384], src[5 * 16384]); w.w = pk2(src[6 * 16384], src[7 * 16384]);
                A[dir][st] = __builtin_bit_cast(bf16x8, w); }
        const int lb0 = lpart * 33, lb1 = (lb0 + 33 < 129) ? lb0 + 33 : 129;
        const bf16_t* hrow = HID2 + (size_t)jl * LPAD * 64 + 8 * h;
        bf16x8 Bf[4], Bb[4];
#define FG_LOAD(lb) do { const int lb_ = (lb) * 32 + r32; const int lf_ = lb_ + 1 < LPAD ? lb_ + 1 : LPAD - 1; \
        _Pragma("unroll") for (int st = 0; st < 4; ++st) { Bf[st] = *(const bf16x8*)(hrow + (size_t)lf_ * 64 + 16 * st); Bb[st] = *(const bf16x8*)(hrow + (size_t)lb_ * 64 + 16 * st); } } while (0)
        FG_LOAD(lb0);
        for (int lb = lb0; lb < lb1; ++lb) {
            f32x16 acc0, acc1, accc;
#pragma unroll
            for (int i = 0; i < 16; ++i) { acc0[i] = 0.f; acc1[i] = 0.f; accc[i] = 0.f; }
#pragma unroll
            for (int st = 0; st < 4; ++st) { acc0 = __builtin_amdgcn_mfma_f32_32x32x16_bf16(A[0][st], Bf[st], acc0, 0, 0, 0); acc1 = __builtin_amdgcn_mfma_f32_32x32x16_bf16(A[1][st], Bb[st], acc1, 0, 0, 0); }
            if (lb == 0) {
#pragma unroll
                for (int st = 0; st < 4; ++st) accc = __builtin_amdgcn_mfma_f32_32x32x16_bf16(A[0][st], Bb[st], accc, 0, 0, 0);
            }
            if (lb + 1 < lb1) FG_LOAD(lb + 1);
            const int lbk = lb * 32 + r32, lfw = lbk + 1;
            const float tb = (float)lbk * (1.0f / (float)(L - 1)), tf = (float)lfw * (1.0f / (float)(L - 1));
#pragma unroll
            for (int reg = 0; reg < 16; ++reg) { const int cl = (reg & 3) + 8 * (reg >> 2) + 4 * h;
                const float delta = 3.0701134f + (15.350567f - 3.0701134f) * ((float)(c0 + cl) * (1.0f / 4095.0f));
                float v1 = acc1[reg] * __expf(-tb * delta); if (lbk == 0) v1 += accc[reg];
                const float v0 = acc0[reg] * __expf(-tf * delta);
                tile[cl * 40 + (31 - r32)] = (bf16_t)f2bf(v0); tile[(32 + cl) * 40 + r32] = (bf16_t)f2bf(v1); }
            LDS_WAIT(); asm volatile("" ::: "memory");
#pragma unroll
            for (int k = 0; k < 2; ++k) { const int cl = (lane >> 2) + 16 * k, ch = lane & 3;
                bf16_t* R = KT + ((size_t)(jl * 2 + n) * 4096 + c0 + cl) * KLEN;
                *(u32x4*)(R + (KOFF - 32 - 32 * lb) + 8 * ch) = *(const LAS u32x4*)(tile + cl * 40 + 8 * ch);
                *(u32x4*)(R + (KOFF + 32 * lb) + 8 * ch) = *(const LAS u32x4*)(tile + (32 + cl) * 40 + 8 * ch); }
            LDS_WAIT(); asm volatile("" ::: "memory");
        }
#undef FG_LOAD
    }
}
constexpr int HG_QM = 0, HG_KM = 17408, HG_KST = 34816, HG_VT = 53248, HG_TOT = 71680, HG_OUT = 79872, HG_END1 = 97280;
__device__ __forceinline__ int hg_row(int dir, int b, int ci, int tau) {
    if (dir == 0) { if (ci == 0) return tau < 16 ? 8192 + 16 * b + tau : -1; return b * 4096 + 64 * (ci - 1) + tau; }
    if (ci == 64) return tau < 16 ? 8192 + 16 * b + 15 - tau : -1;
    return b * 4096 + 4095 - (64 * ci + tau);
}
struct HgRaw { u32x2 q[4], l[4]; u32x4 v[2]; };
__device__ __forceinline__ void hg1_load(const bf16_t* P, int item, int tid, HgRaw& r) {
    const int ci = item % 65, hd = (item / 65) & 15, b = (item / (65 * 16)) & 1, dir = item / (65 * 32);
    const int qcol = QB_OFF + hd * 128, vcol = IB_OFF + hd * 128, fcol = (dir ? FB_OFF : FF_OFF) + hd * 128;
    const int dg = tid & 31, tg = tid >> 5, tv = tid >> 3, dvq = tid & 7;
#pragma unroll
    for (int i = 0; i < 4; ++i) { const int row = hg_row(dir, b, ci, 4 * tg + i); const int rc = row < 0 ? 0 : row;
        r.q[i] = *(const u32x2*)(P + (size_t)rc * EIN + qcol + 4 * dg); r.l[i] = *(const u32x2*)(P + (size_t)rc * EIN + fcol + 4 * dg); }
    { const int row = hg_row(dir, b, ci, tv); const int rc = row < 0 ? 0 : row;
      r.v[0] = *(const u32x4*)(P + (size_t)rc * EIN + vcol + 16 * dvq); r.v[1] = *(const u32x4*)(P + (size_t)rc * EIN + vcol + 16 * dvq + 8); }
}
__device__ __forceinline__ void hgrn_stage1(const Params& p, LAS unsigned char* lds, int vcu, int G, int tid, int wave, int lane) {
    const bf16_t* P = (const bf16_t*)(p.ws + WS_P);
    bf16_t* QSG = (bf16_t*)(p.ws + WS_QSG); bf16_t* KSG = (bf16_t*)(p.ws + WS_KSG); bf16_t* VTG = (bf16_t*)(p.ws + WS_VTG); float* DECG = (float*)(p.ws + WS_DECG);
    const int dg = tid & 31, tg = tid >> 5, tv = tid >> 3, dvq = tid & 7, r32 = lane & 31, h = lane >> 5;
    LAS bf16_t* QM = (LAS bf16_t*)(lds + HG_QM); LAS bf16_t* KM = (LAS bf16_t*)(lds + HG_KM); LAS bf16_t* KST = (LAS bf16_t*)(lds + HG_KST); LAS bf16_t* VTL = (LAS bf16_t*)(lds + HG_VT);
    LAS float* TOT = (LAS float*)(lds + HG_TOT);
    HgRaw raw;
    if (vcu < 4160) hg1_load(P, vcu, tid, raw);
    for (int item = vcu; item < 4160; item += G) {
        const int ci = item % 65, hd = (item / 65) & 15, b = (item / (65 * 16)) & 1, dir = item / (65 * 32);
        SUBP_T0(20)
        float qs[4][4], lg[4][4], kk[4][4], cs[4][4];
#pragma unroll
        for (int i = 0; i < 4; ++i) if (hg_row(dir, b, ci, 4 * tg + i) < 0) { raw.q[i] = (u32x2){0u, 0u}; raw.l[i] = (u32x2){0u, 0u}; }
        if (hg_row(dir, b, ci, tv) < 0) { raw.v[0] = (u32x4){0u, 0u, 0u, 0u}; raw.v[1] = (u32x4){0u, 0u, 0u, 0u}; }
#pragma unroll
        for (int i = 0; i < 4; ++i) { qs[i][0] = bflo(raw.q[i].x); qs[i][1] = bfhi(raw.q[i].x); qs[i][2] = bflo(raw.q[i].y); qs[i][3] = bfhi(raw.q[i].y);
            lg[i][0] = bflo(raw.l[i].x); lg[i][1] = bfhi(raw.l[i].x); lg[i][2] = bflo(raw.l[i].y); lg[i][3] = bfhi(raw.l[i].y); }
#pragma unroll
        for (int i = 0; i < 4; ++i)
#pragma unroll
            for (int k = 0; k < 4; ++k) kk[i][k] = 1.0f - __expf(lg[i][k]);
#pragma unroll
        for (int k = 0; k < 4; ++k) { cs[0][k] = lg[0][k]; cs[1][k] = cs[0][k] + lg[1][k]; cs[2][k] = cs[1][k] + lg[2][k]; cs[3][k] = cs[2][k] + lg[3][k]; }
        *(LAS f32x4*)(TOT + tg * 128 + 4 * dg) = (f32x4){cs[3][0], cs[3][1], cs[3][2], cs[3][3]};
        { const unsigned vw[8] = {raw.v[0].x, raw.v[0].y, raw.v[0].z, raw.v[0].w, raw.v[1].x, raw.v[1].y, raw.v[1].z, raw.v[1].w};
#pragma unroll
          for (int k = 0; k < 8; ++k) { VTL[(16 * dvq + 2 * k) * 72 + tv] = (bf16_t)(vw[k] & 0xffffu); VTL[(16 * dvq + 2 * k + 1) * 72 + tv] = (bf16_t)(vw[k] >> 16); } }
        lds_barrier(); SUBP_T1(20) SUBP_T0(21)
        f32x4 pre = (f32x4){0.f, 0.f, 0.f, 0.f}, mid = pre, end = pre;
#pragma unroll
        for (int g = 0; g < 16; ++g) { const f32x4 t4 = *(const LAS f32x4*)(TOT + g * 128 + 4 * dg); if (g < tg) pre += t4; if (g < 8) mid += t4; end += t4; }
        if (item + G < 4160) hg1_load(P, item + G, tid, raw);
        bf16_t* qsg = QSG + (size_t)item * 8192; bf16_t* ksg = KSG + (size_t)item * 8192; bf16_t* vtg = VTG + (size_t)item * 8192;
        float qsv[4][4], qmv[4][4], kmv[4][4];
#pragma unroll
        for (int k = 0; k < 4; ++k) {
            const float emid = __expf(mid[k]), eem = __expf(end[k] - mid[k]);
            float ksv[4];
#pragma unroll
            for (int i = 0; i < 4; ++i) { const float Gc = pre[k] + cs[i][k]; const float e1 = __expf(Gc - mid[k]), e2 = __expf(mid[k] - Gc);
                const float qm = qs[i][k] * e1, km = kk[i][k] * e2; qmv[i][k] = qm; kmv[i][k] = km; qsv[i][k] = qm * emid; ksv[i] = km * eem; }
            *(LAS u32x2*)(KST + (4 * dg + k) * 72 + 4 * tg) = (u32x2){pk2(ksv[0], ksv[1]), pk2(ksv[2], ksv[3])};
            if (tg == 0) DECG[(size_t)item * 128 + 4 * dg + k] = emid * eem;
        }
#pragma unroll
        for (int i = 0; i < 4; ++i) { const int tau = 4 * tg + i;
            *(LAS u32x2*)(QM + tau * 136 + 4 * dg) = (u32x2){pk2(qmv[i][0], qmv[i][1]), pk2(qmv[i][2], qmv[i][3])};
            *(LAS u32x2*)(KM + tau * 136 + 4 * dg) = (u32x2){pk2(kmv[i][0], kmv[i][1]), pk2(kmv[i][2], kmv[i][3])};
            *(u32x2*)(qsg + tau * 128 + 4 * dg) = (u32x2){pk2(qsv[i][0], qsv[i][1]), pk2(qsv[i][2], qsv[i][3])}; }
        lds_barrier(); SUBP_T1(21) SUBP_T0(22)
        {
            const int dvt = wave & 3, tb = wave >> 2;
            f32x16 accO;
#pragma unroll
            for (int i = 0; i < 16; ++i) accO[i] = 0.f;
            for (int sb = 0; sb <= tb; ++sb) {
                f32x16 sT;
#pragma unroll
                for (int i = 0; i < 16; ++i) sT[i] = 0.f;
#pragma unroll
                for (int stp = 0; stp < 8; ++stp) { const bf16x8 a = *(const LAS bf16x8*)(KM + (32 * sb + r32) * 136 + 16 * stp + 8 * h); const bf16x8 bq = *(const LAS bf16x8*)(QM + (32 * tb + r32) * 136 + 16 * stp + 8 * h);
                    sT = __builtin_amdgcn_mfma_f32_32x32x16_bf16(a, bq, sT, 0, 0, 0); }
                if (sb == tb) {
#pragma unroll
                    for (int reg = 0; reg < 16; ++reg) { const int sl = (reg & 3) + 8 * (reg >> 2) + 4 * h; if (sl > r32) sT[reg] = 0.f; }
                }
#pragma unroll
                for (int st2 = 0; st2 < 2; ++st2) {
                    u32x4 pw; pw.x = pk2(sT[8 * st2 + 0], sT[8 * st2 + 1]); pw.y = pk2(sT[8 * st2 + 2], sT[8 * st2 + 3]); pw.z = pk2(sT[8 * st2 + 4], sT[8 * st2 + 5]); pw.w = pk2(sT[8 * st2 + 6], sT[8 * st2 + 7]);
                    const LAS bf16_t* vp = VTL + (32 * dvt + r32) * 72 + 32 * sb + 16 * st2 + 4 * h;
                    const u32x2 a0 = *(const LAS u32x2*)vp, a1 = *(const LAS u32x2*)(vp + 8);
                    const u32x4 aw = (u32x4){a0.x, a0.y, a1.x, a1.y};
                    accO = __builtin_amdgcn_mfma_f32_32x32x16_bf16(__builtin_bit_cast(bf16x8, aw), __builtin_bit_cast(bf16x8, pw), accO, 0, 0, 0);
                }
            }
            { LAS bf16_t* ot = (LAS bf16_t*)(lds + HG_OUT) + (32 * tb + r32) * 136 + 32 * dvt + 4 * h;
#pragma unroll
              for (int g4 = 0; g4 < 4; ++g4) *(LAS u32x2*)(ot + 8 * g4) = (u32x2){pk2(accO[4 * g4], accO[4 * g4 + 1]), pk2(accO[4 * g4 + 2], accO[4 * g4 + 3])}; }
#pragma unroll
            for (int j = 0; j < 2; ++j) { const int pc = tid + NTHR * j, rr = pc >> 3, ch = pc & 7;
                *(u32x4*)(ksg + rr * 64 + 8 * ch) = *(const LAS u32x4*)(KST + rr * 72 + 8 * ch); *(u32x4*)(vtg + rr * 64 + 8 * ch) = *(const LAS u32x4*)(VTL + rr * 72 + 8 * ch); }
        }
        lds_barrier(); SUBP_T1(22)
        { bf16_t* OB = (bf16_t*)(p.ws + WS_OBP) + (size_t)dir * MP * 2048;
#pragma unroll
          for (int j = 0; j < 2; ++j) { const int q = tid + NTHR * j, tau = q >> 4, c16 = q & 15; const int row = hg_row(dir, b, ci, tau);
              if (row >= 0) *(u32x4*)(OB + (size_t)row * 2048 + hd * 128 + 8 * c16) = *(const LAS u32x4*)(lds + HG_OUT + tau * 272 + 16 * c16); } }
    }
}
constexpr int HF_STB = 0, HF_SLOT0 = 34816, HF_QS = 0, HF_KST = 17408, HF_VT = 35840, HF_DEC = 54272, HF_SLOT = 54784, HF_OUT = HF_SLOT0 + 2 * HF_SLOT;
static_assert(HF_OUT + 64 * 272 <= MISC_OFF, "stage-2 LDS map");
__device__ __forceinline__ void hgrn_stage2f(const Params& p, LAS unsigned char* lds, int item, int tid, int wave, int lane) {
    const int hd = item & 15, b = (item >> 4) & 1, dir = item >> 5;
    const int r32 = lane & 31, h = lane >> 5, dvt = wave & 3, tb = wave >> 2; const size_t item0 = (size_t)(((dir * 2 + b) * 16 + hd) * 65);
    LAS bf16_t* STB = (LAS bf16_t*)(lds + HF_STB);
    for (int i = tid; i < 128 * 136 / 2; i += NTHR) ((LAS unsigned*)STB)[i] = 0u;
    f32x16 st0, st1;
#pragma unroll
    for (int i = 0; i < 16; ++i) { st0[i] = 0.f; st1[i] = 0.f; }
    u32x4 R[7], R2[7];
    const unsigned lqs = HF_QS + (tid >> 4) * 272 + 16 * (tid & 15), lk = (tid >> 3) * 144 + 16 * (tid & 7);
#define HF_LD(R, ci) do { if ((ci) < 65) { const size_t it_ = item0 + (ci); const bf16_t* q_ = (const bf16_t*)(p.ws + WS_QSG) + it_ * 8192 + 8 * tid; const bf16_t* k_ = (const bf16_t*)(p.ws + WS_KSG) + it_ * 8192 + 8 * tid; \
        const bf16_t* v_ = (const bf16_t*)(p.ws + WS_VTG) + it_ * 8192 + 8 * tid; \
        R[0] = *(const u32x4*)q_; R[1] = *(const u32x4*)(q_ + 4096); R[2] = *(const u32x4*)k_; R[3] = *(const u32x4*)(k_ + 4096); R[4] = *(const u32x4*)v_; R[5] = *(const u32x4*)(v_ + 4096); \
        if (tid < 32) R[6] = *(const u32x4*)((const float*)(p.ws + WS_DECG) + it_ * 128 + 4 * tid); } } while (0)
#define HF_ST(R, ci) do { if ((ci) < 65) { LAS unsigned char* sl_ = lds + HF_SLOT0 + ((ci) & 1) * HF_SLOT; \
        *(LAS u32x4*)(sl_ + lqs) = R[0]; *(LAS u32x4*)(sl_ + lqs + 32 * 272) = R[1]; *(LAS u32x4*)(sl_ + HF_KST + lk) = R[2]; *(LAS u32x4*)(sl_ + HF_KST + lk + 64 * 144) = R[3]; \
        *(LAS u32x4*)(sl_ + HF_VT + lk) = R[4]; *(LAS u32x4*)(sl_ + HF_VT + lk + 64 * 144) = R[5]; if (tid < 32) *(LAS u32x4*)(sl_ + HF_DEC + 16 * tid) = R[6]; } } while (0)
    HF_LD(R, 0); HF_ST(R, 0); HF_LD(R, 1); HF_LD(R2, 2);
    bf16_t* OB2 = (bf16_t*)(p.ws + WS_OBP) + (size_t)2 * MP * 2048 + (size_t)dir * MP * 2048;
    lds_barrier();
    auto step = [&](int ci, u32x4 (&RX)[7]) {
        const LAS unsigned char* slot = lds + HF_SLOT0 + (ci & 1) * HF_SLOT;
        HF_ST(RX, ci + 1);
        HF_LD(RX, ci + 3);
        {
            f32x16 accO;
#pragma unroll
            for (int i = 0; i < 16; ++i) accO[i] = 0.f;
            const LAS bf16_t* sbp = STB + (32 * dvt + r32) * 136 + 8 * h; const LAS bf16_t* qsl = (const LAS bf16_t*)(slot + HF_QS) + (32 * tb + r32) * 136 + 8 * h;
#pragma unroll
            for (int stp = 0; stp < 8; ++stp) accO = __builtin_amdgcn_mfma_f32_32x32x16_bf16(*(const LAS bf16x8*)(sbp + 16 * stp), *(const LAS bf16x8*)(qsl + 16 * stp), accO, 0, 0, 0);
            LAS bf16_t* ot = (LAS bf16_t*)(lds + HF_OUT) + (32 * tb + r32) * 136 + 32 * dvt + 4 * h;
#pragma unroll
            for (int g4 = 0; g4 < 4; ++g4) *(LAS u32x2*)(ot + 8 * g4) = (u32x2){pk2(accO[4 * g4], accO[4 * g4 + 1]), pk2(accO[4 * g4 + 2], accO[4 * g4 + 3])};
        }
        lds_barrier();
#pragma unroll
        for (int j = 0; j < 2; ++j) { const int q = tid + 512 * j, tau = q >> 4, c16 = q & 15; const int row = hg_row(dir, b, ci, tau);
            if (row >= 0) *(u32x4*)(OB2 + (size_t)row * 2048 + hd * 128 + 8 * c16) = *(const LAS u32x4*)(lds + HF_OUT + tau * 272 + 16 * c16); }
        {
            const LAS bf16_t* vtl = (const LAS bf16_t*)(slot + HF_VT) + (32 * dvt + r32) * 72 + 8 * h;
            const int db0 = 2 * tb; const LAS float* decp = (const LAS float*)(slot + HF_DEC) + 32 * db0 + 4 * h;
            const LAS bf16_t* ks0 = (const LAS bf16_t*)(slot + HF_KST) + (32 * db0 + r32) * 72 + 8 * h; const LAS bf16_t* ks1 = ks0 + 32 * 72;
#pragma unroll
            for (int g4 = 0; g4 < 4; ++g4) { const f32x4 d0 = *(const LAS f32x4*)(decp + 8 * g4), d1 = *(const LAS f32x4*)(decp + 32 + 8 * g4);
#pragma unroll
                for (int k = 0; k < 4; ++k) { st0[4 * g4 + k] *= d0[k]; st1[4 * g4 + k] *= d1[k]; } }
#pragma unroll
            for (int stp = 0; stp < 4; ++stp) { const bf16x8 bv = *(const LAS bf16x8*)(vtl + 16 * stp);
                st0 = __builtin_amdgcn_mfma_f32_32x32x16_bf16(*(const LAS bf16x8*)(ks0 + 16 * stp), bv, st0, 0, 0, 0); st1 = __builtin_amdgcn_mfma_f32_32x32x16_bf16(*(const LAS bf16x8*)(ks1 + 16 * stp), bv, st1, 0, 0, 0); }
            LAS bf16_t* srow = STB + (32 * dvt + r32) * 136 + 32 * db0 + 4 * h;
#pragma unroll
            for (int g4 = 0; g4 < 4; ++g4) { *(LAS u32x2*)(srow + 8 * g4) = (u32x2){pk2(st0[4 * g4], st0[4 * g4 + 1]), pk2(st0[4 * g4 + 2], st0[4 * g4 + 3])};
                *(LAS u32x2*)(srow + 32 + 8 * g4) = (u32x2){pk2(st1[4 * g4], st1[4 * g4 + 1]), pk2(st1[4 * g4 + 2], st1[4 * g4 + 3])}; }
        }
        lds_barrier();
    };
#pragma unroll 1
    for (int c2 = 0; c2 < 64; c2 += 2) { step(c2, R); step(c2 + 1, R2); }
    step(64, R);
#undef HF_LD
#undef HF_ST
}

typedef float f32x4v __attribute__((ext_vector_type(4)));
__device__ __forceinline__ void natten_item(const Params& p, LAS float* tbl, int item, int jl, int lane) {
    const bf16_t* P = (const bf16_t*)(p.ws + WS_P); const bf16_t* VT = (const bf16_t*)(p.ws + WS_VT); bf16_t* Y = (bf16_t*)(p.ws + WS_Y);
    const bool ismeta = item >= 8192;
    int b, hd, r, j;
    if (ismeta) { const int t = item - 8192; b = t >> 4; hd = t & 15; r = 0; j = 0; } else { j = item & 3; r = (item >> 2) & 63; hd = (item >> 8) & 15; b = item >> 12; }
    const int q16 = lane & 15, h4 = lane >> 4;
    const int qrow = ismeta ? 8192 + 16 * b + q16 : b * 4096 + 64 * r + 16 * j + q16;
    const int kw0 = (j == 0) ? 0 : (j == 1) ? 8 : (j == 2) ? 24 : 32;
    const int r0 = (r - 4 < 0) ? 0 : ((r - 4 > 56) ? 56 : r - 4);
    const float* rpb = p.in[I_RPB] + ((size_t)jl * 16 + hd) * 15 * 31; const float* mb = p.in[I_MBIAS] + ((size_t)jl * 16 + hd) * 16;
    { float tv[8];
#pragma unroll
      for (int k = 0; k < 8; ++k) { const int idx = lane + 64 * k; tv[k] = rpb[idx < 465 ? idx : 464]; }
#pragma unroll
      for (int k = 0; k < 8; ++k) tbl[lane + 64 * k] = tv[k]; }
    bf16x8 QF[4];
#pragma unroll
    for (int stp = 0; stp < 4; ++stp) QF[stp] = *(const bf16x8*)(P + (size_t)qrow * EIN + QA_OFF + hd * 128 + 32 * stp + 8 * h4);
    f32x4 S[17];
    auto rowbase = [&](int i) -> int { return b * 4096 + 64 * (r0 + i) + kw0; };
    auto keyrow = [&](int kt) -> int { if (kt == 0) return 8192 + 16 * b + q16; const int i = (kt - 1) >> 1, half = (kt - 1) & 1; return rowbase(i) + 8 * (q16 >> 2) + 4 * half + (q16 & 3); };
    {
        const bf16_t* kb = P + KA_OFF + hd * 128 + 8 * h4;
        bf16x8 KF[2][3][4];
#define NA_LDK(buf, bt) do { _Pragma("unroll") for (int t_ = 0; t_ < 3; ++t_) { const int kt_ = 3 * (bt) + t_; if (kt_ < 17) { const bf16_t* kp_ = kb + (size_t)keyrow(kt_) * EIN; \
            _Pragma("unroll") for (int stp = 0; stp < 4; ++stp) KF[buf][t_][stp] = *(const bf16x8*)(kp_ + 32 * stp); } } } while (0)
#define NA_MMK(buf, bt) do { _Pragma("unroll") for (int t_ = 0; t_ < 3; ++t_) { const int kt_ = 3 * (bt) + t_; if (kt_ < 17) { f32x4 s_ = (f32x4){0.f, 0.f, 0.f, 0.f}; \
            _Pragma("unroll") for (int stp = 0; stp < 4; ++stp) s_ = __builtin_amdgcn_mfma_f32_16x16x32_bf16(KF[buf][t_][stp], QF[stp], s_, 0, 0, 0); S[kt_] = s_; } } } while (0)
        NA_LDK(0, 0); __builtin_amdgcn_sched_barrier(0);
        NA_LDK(1, 1); __builtin_amdgcn_sched_barrier(0); NA_MMK(0, 0); __builtin_amdgcn_sched_barrier(0);
        NA_LDK(0, 2); __builtin_amdgcn_sched_barrier(0); NA_MMK(1, 1); __builtin_amdgcn_sched_barrier(0);
        NA_LDK(1, 3); __builtin_amdgcn_sched_barrier(0); NA_MMK(0, 2); __builtin_amdgcn_sched_barrier(0);
        NA_LDK(0, 4); __builtin_amdgcn_sched_barrier(0); NA_MMK(1, 3); __builtin_amdgcn_sched_barrier(0);
        NA_LDK(1, 5); __builtin_amdgcn_sched_barrier(0); NA_MMK(0, 4); __builtin_amdgcn_sched_barrier(0);
        NA_MMK(1, 5);
#undef NA_LDK
#undef NA_MMK
    }
    const int qc = 16 * j + q16; const int c0 = (qc - 8 < 0) ? 0 : ((qc - 8 > 48) ? 48 : qc - 8);
    float mx = -3.0e38f;
#pragma unroll
    for (int reg = 0; reg < 4; ++reg) { S[0][reg] += mb[4 * h4 + reg]; mx = fmaxf(mx, S[0][reg]); }
    float rb[16][4];
#pragma unroll
    for (int kt = 1; kt < 17; ++kt) { const int i = (kt - 1) >> 1, half = (kt - 1) & 1;
#pragma unroll
        for (int reg = 0; reg < 4; ++reg) { int ci = kw0 + 8 * h4 + 4 * half + reg - qc + 15; ci = ci < 0 ? 0 : (ci > 30 ? 30 : ci); rb[kt - 1][reg] = tbl[((r0 + i) - r + 7) * 31 + ci]; } }
    __builtin_amdgcn_sched_barrier(0);
#pragma unroll
    for (int kt = 1; kt < 17; ++kt) { const int half = (kt - 1) & 1;
#pragma unroll
        for (int reg = 0; reg < 4; ++reg) { const int kc = kw0 + 8 * h4 + 4 * half + reg; const bool ok = !ismeta && kc >= c0 && kc < c0 + 16;
            const float v = ok ? S[kt][reg] + rb[kt - 1][reg] : -3.0e38f; S[kt][reg] = v; mx = fmaxf(mx, v); } }
    mx = fmaxf(mx, __shfl_xor(mx, 16)); mx = fmaxf(mx, __shfl_xor(mx, 32));
    float sum = 0.f;
#pragma unroll
    for (int kt = 0; kt < 17; ++kt)
#pragma unroll
        for (int reg = 0; reg < 4; ++reg) { const float e = (S[kt][reg] > -1.0e38f) ? __expf(S[kt][reg] - mx) : 0.f; S[kt][reg] = e; sum += e; }
    sum += __shfl_xor(sum, 16); sum += __shfl_xor(sum, 32);
    const float inv = 1.0f / sum;
    f32x4 O[8];
#pragma unroll
    for (int dt = 0; dt < 8; ++dt) O[dt] = (f32x4){0.f, 0.f, 0.f, 0.f};
    u32x4 PW[9];
    PW[0].x = pk2(S[0][0], S[0][1]); PW[0].y = pk2(S[0][2], S[0][3]); PW[0].z = 0u; PW[0].w = 0u;
#pragma unroll
    for (int u = 1; u < 9; ++u) { const int k0t = 2 * u - 1, k1t = 2 * u;
        PW[u].x = pk2(S[k0t][0], S[k0t][1]); PW[u].y = pk2(S[k0t][2], S[k0t][3]); PW[u].z = pk2(S[k1t][0], S[k1t][1]); PW[u].w = pk2(S[k1t][2], S[k1t][3]); }
    {
        const bf16_t* vb = VT + (size_t)(hd * 128 + q16) * MP;
        u32x4 VF[4][8];
#define NA_LDV(buf, u) do { if ((u) == 0) { _Pragma("unroll") for (int dt = 0; dt < 8; ++dt) { const u32x2 m_ = *(const u32x2*)(vb + (size_t)(16 * dt) * MP + 8192 + 16 * b + 4 * h4); VF[buf][dt] = (u32x4){m_.x, m_.y, 0u, 0u}; } } \
        else { const int t0_ = rowbase((u) - 1) + 8 * h4; _Pragma("unroll") for (int dt = 0; dt < 8; ++dt) VF[buf][dt] = *(const u32x4*)(vb + (size_t)(16 * dt) * MP + t0_); } } while (0)
#define NA_MMV(buf, u) do { _Pragma("unroll") for (int dt = 0; dt < 8; ++dt) \
        O[dt] = __builtin_amdgcn_mfma_f32_16x16x32_bf16(__builtin_bit_cast(bf16x8, VF[buf][dt]), __builtin_bit_cast(bf16x8, PW[u]), O[dt], 0, 0, 0); } while (0)
        NA_LDV(0, 0); NA_LDV(1, 1); NA_LDV(2, 2); __builtin_amdgcn_sched_barrier(0);
        NA_LDV(3, 3); __builtin_amdgcn_sched_barrier(0); NA_MMV(0, 0); __builtin_amdgcn_sched_barrier(0);
        NA_LDV(0, 4); __builtin_amdgcn_sched_barrier(0); NA_MMV(1, 1); __builtin_amdgcn_sched_barrier(0);
        NA_LDV(1, 5); __builtin_amdgcn_sched_barrier(0); NA_MMV(2, 2); __builtin_amdgcn_sched_barrier(0);
        NA_LDV(2, 6); __builtin_amdgcn_sched_barrier(0); NA_MMV(3, 3); __builtin_amdgcn_sched_barrier(0);
        NA_LDV(3, 7); __builtin_amdgcn_sched_barrier(0); NA_MMV(0, 4); __builtin_amdgcn_sched_barrier(0);
        NA_LDV(0, 8); __builtin_amdgcn_sched_barrier(0); NA_MMV(1, 5); __builtin_amdgcn_sched_barrier(0);
        NA_MMV(2, 6); NA_MMV(3, 7); NA_MMV(0, 8);
#undef NA_LDV
#undef NA_MMV
    }
#pragma unroll
    for (int dt = 0; dt < 8; ++dt) { const int col = hd * 128 + 16 * dt + 4 * h4;
        const u32x2 g = *(const u32x2*)(P + (size_t)qrow * EIN + GATE_OFF + col);
        u32x2 w; w.x = pk2(O[dt][0] * inv * bflo(g.x), O[dt][1] * inv * bfhi(g.x)); w.y = pk2(O[dt][2] * inv * bflo(g.y), O[dt][3] * inv * bfhi(g.y));
        *(u32x2*)(Y + (size_t)qrow * D + col) = w; }
}
__device__ __forceinline__ void phase_combine(const Params& p, int jl, int gw, int NGW, int lane) {
    const bf16_t* OB0 = (const bf16_t*)(p.ws + WS_OBP); const bf16_t* OB1 = OB0 + (size_t)MP * 2048; const bf16_t* OB2 = OB0 + (size_t)2 * MP * 2048; const bf16_t* OB3 = OB0 + (size_t)3 * MP * 2048;
    const bf16_t* P = (const bf16_t*)(p.ws + WS_P); bf16_t* Y = (bf16_t*)(p.ws + WS_Y);
    const float* gain = p.in[I_HGNORM] + (size_t)jl * 2048;
    f32x4 gv[8];
#pragma unroll
    for (int k = 0; k < 8; ++k) gv[k] = *(const f32x4*)(gain + 32 * lane + 4 * k);
    u32x4 a8[4], b8[4], c8[4], d8[4], g8[4], an[4], bn[4], cn[4], dn[4], gn[4];
#define CB_LOAD(A, B, C, Dd, Gt, m) do { _Pragma("unroll") for (int k = 0; k < 4; ++k) { A[k] = *(const u32x4*)(OB0 + (size_t)(m) * 2048 + 32 * lane + 8 * k); B[k] = *(const u32x4*)(OB1 + (size_t)(m) * 2048 + 32 * lane + 8 * k); \
        C[k] = *(const u32x4*)(OB2 + (size_t)(m) * 2048 + 32 * lane + 8 * k); Dd[k] = *(const u32x4*)(OB3 + (size_t)(m) * 2048 + 32 * lane + 8 * k); \
        Gt[k] = *(const u32x4*)(P + (size_t)(m) * EIN + GATE_OFF + 2048 + 32 * lane + 8 * k); } } while (0)
    int m = gw;
    if (m < MV) CB_LOAD(a8, b8, c8, d8, g8, m);
    for (; m < MV; m += NGW) {
        if (m + NGW < MV) CB_LOAD(an, bn, cn, dn, gn, m + NGW);
        f32x4 o[8]; float ss = 0.f;
#pragma unroll
        for (int k = 0; k < 4; ++k) {
            o[2 * k] = (f32x4){(bflo(a8[k].x) + bflo(c8[k].x)) + (bflo(b8[k].x) + bflo(d8[k].x)), (bfhi(a8[k].x) + bfhi(c8[k].x)) + (bfhi(b8[k].x) + bfhi(d8[k].x)),
                               (bflo(a8[k].y) + bflo(c8[k].y)) + (bflo(b8[k].y) + bflo(d8[k].y)), (bfhi(a8[k].y) + bfhi(c8[k].y)) + (bfhi(b8[k].y) + bfhi(d8[k].y))};
            o[2 * k + 1] = (f32x4){(bflo(a8[k].z) + bflo(c8[k].z)) + (bflo(b8[k].z) + bflo(d8[k].z)), (bfhi(a8[k].z) + bfhi(c8[k].z)) + (bfhi(b8[k].z) + bfhi(d8[k].z)),
                                   (bflo(a8[k].w) + bflo(c8[k].w)) + (bflo(b8[k].w) + bflo(d8[k].w)), (bfhi(a8[k].w) + bfhi(c8[k].w)) + (bfhi(b8[k].w) + bfhi(d8[k].w))}; }
#pragma unroll
        for (int k = 0; k < 8; ++k) ss += (o[k].x * o[k].x + o[k].y * o[k].y) + (o[k].z * o[k].z + o[k].w * o[k].w);
        ss += __shfl_xor(ss, 1); ss += __shfl_xor(ss, 2);
        const float rstd = 1.0f / sqrtf(ss * (1.0f / 128.0f) + EPS);
#pragma unroll
        for (int k2 = 0; k2 < 4; ++k2) { const u32x4 g = g8[k2]; const f32x4 ga = gv[2 * k2], gb = gv[2 * k2 + 1]; const f32x4 a = o[2 * k2], bq = o[2 * k2 + 1];
            u32x4 w; w.x = pk2(a.x * rstd * ga.x * bflo(g.x), a.y * rstd * ga.y * bfhi(g.x)); w.y = pk2(a.z * rstd * ga.z * bflo(g.y), a.w * rstd * ga.w * bfhi(g.y));
            w.z = pk2(bq.x * rstd * gb.x * bflo(g.z), bq.y * rstd * gb.y * bfhi(g.z)); w.w = pk2(bq.z * rstd * gb.z * bflo(g.w), bq.w * rstd * gb.w * bfhi(g.w));
            *(u32x4*)(Y + (size_t)m * D + 2048 + 32 * lane + 8 * k2) = w; }
#pragma unroll
        for (int k = 0; k < 4; ++k) { a8[k] = an[k]; b8[k] = bn[k]; c8[k] = cn[k]; d8[k] = dn[k]; g8[k] = gn[k]; }
    }
#undef CB_LOAD
}
__device__ __forceinline__ void phase_postnorm(const Params& p, LAS unsigned char* lds, int layer, int vcu, int G, int tid, int wave, int lane) {
    const bf16_t* OUT = (const bf16_t*)(p.ws + WS_OUT); float* H = (float*)(p.ws + WS_H); bf16_t* HN = (bf16_t*)(p.ws + WS_HN);
    const bool last = (layer == 3); const int MR = last ? NB * T : MV;
    const f32x4* gp4 = (const f32x4*)(p.in[I_NPOST] + (size_t)layer * D) + 2 * tid; const f32x4* gq4 = (const f32x4*)(p.in[I_NPRE] + (size_t)(last ? 0 : layer + 1) * D) + 2 * tid;
    const f32x4 gpa = gp4[0], gpb = gp4[1], gqa = gq4[0], gqb = gq4[1];
    LAS float* RED = (LAS float*)lds;
    f32x4 oa[3], ob[3], ha[3], hb[3];
#define PN_LOAD(s, m) do { const u32x4 o8_ = *(const u32x4*)(OUT + (size_t)(m) * D + 8 * tid); const f32x4* h4_ = (const f32x4*)(H + (size_t)(m) * D) + 2 * tid; \
        oa[s] = (f32x4){bflo(o8_.x), bfhi(o8_.x), bflo(o8_.y), bfhi(o8_.y)}; ob[s] = (f32x4){bflo(o8_.z), bfhi(o8_.z), bflo(o8_.w), bfhi(o8_.w)}; ha[s] = h4_[0]; hb[s] = h4_[1]; } while (0)
#define PN_ROW(s, m, par) do { \
        float ss = (oa[s].x * oa[s].x + oa[s].y * oa[s].y) + (oa[s].z * oa[s].z + oa[s].w * oa[s].w) + (ob[s].x * ob[s].x + ob[s].y * ob[s].y) + (ob[s].z * ob[s].z + ob[s].w * ob[s].w); \
        ss = wave_sum(ss); if (lane == 0) RED[(par) * 8 + wave] = ss; lds_barrier(); \
        float tot = 0.f; _Pragma("unroll") for (int w = 0; w < 8; ++w) tot += RED[(par) * 8 + w]; \
        const float rstd = 1.0f / sqrtf(tot * (1.0f / D) + EPS); \
        const f32x4 na = ha[s] + oa[s] * rstd * gpa, nb = hb[s] + ob[s] * rstd * gpb; \
        if (last) { f32x4* d4_ = (f32x4*)(p.out + (size_t)(m) * D) + 2 * tid; d4_[0] = na; d4_[1] = nb; } \
        else { f32x4* d4_ = (f32x4*)(H + (size_t)(m) * D) + 2 * tid; d4_[0] = na; d4_[1] = nb; \
            float s2 = (na.x * na.x + na.y * na.y) + (na.z * na.z + na.w * na.w) + (nb.x * nb.x + nb.y * nb.y) + (nb.z * nb.z + nb.w * nb.w); \
            s2 = wave_sum(s2); if (lane == 0) RED[16 + (par) * 8 + wave] = s2; lds_barrier(); \
            float t2 = 0.f; _Pragma("unroll") for (int w = 0; w < 8; ++w) t2 += RED[16 + (par) * 8 + w]; \
            const float r2 = 1.0f / sqrtf(t2 * (1.0f / D) + EPS); \
            *(u32x4*)(HN + (size_t)(m) * D + 8 * tid) = (u32x4){pk2(na.x * r2 * gqa.x, na.y * r2 * gqa.y), pk2(na.z * r2 * gqa.z, na.w * r2 * gqa.w), pk2(nb.x * r2 * gqb.x, nb.y * r2 * gqb.y), pk2(nb.z * r2 * gqb.z, nb.w * r2 * gqb.w)}; } \
    } while (0)
    int m0 = vcu;
    if (m0 < MR) PN_LOAD(0, m0); if (m0 + G < MR) PN_LOAD(1, m0 + G);
    int par = 0;
    for (; m0 < MR; m0 += 3 * G) {
        if (m0 + 2 * G < MR) PN_LOAD(2, m0 + 2 * G);
        PN_ROW(0, m0, par); par ^= 1;
        if (m0 + G < MR) { if (m0 + 3 * G < MR) PN_LOAD(0, m0 + 3 * G); PN_ROW(1, m0 + G, par); par ^= 1; }
        if (m0 + 2 * G < MR) { if (m0 + 4 * G < MR) PN_LOAD(1, m0 + 4 * G); PN_ROW(2, m0 + 2 * G, par); par ^= 1; }
    }
#undef PN_LOAD
#undef PN_ROW
    lds_barrier();
}
constexpr int LC_KCS = 16704;
constexpr int LC_KC = 0, LC_U1 = 4 * LC_KCS  , LC_US = 20480, LC_U2 = LC_U1 + LC_US, LC_X1 = LC_U2 + LC_US  , LC_XS = 16512, LC_X2 = LC_X1 + LC_XS, LC_TAIL = LC_X2 + LC_XS  , LC_END = LC_TAIL + 256;
static_assert(LC_END <= MISC_OFF, "long-conv LDS map");
__device__ __forceinline__ int lc_ugran(int b, int G) { return b * 10240 + (G & 3) * 2560 + (G >> 2) * 16; }
__device__ __forceinline__ int lc_tokrow(int b, int l) { return l < 16 ? 8192 + 16 * b + l : b * 4096 + l - 16; }
struct LcRaw { u32x4 mid; unsigned left, right; };
__device__ __forceinline__ void lc_load_raw(const bf16_t* urow, int b, int gl, LcRaw& r) {
    const int l0 = 8 * gl; r.mid = *(const u32x4*)(urow + lc_tokrow(b, l0));
    r.left = urow[lc_tokrow(b, l0 > 0 ? l0 - 1 : 0)]; r.right = urow[lc_tokrow(b, l0 + 8 < L ? l0 + 8 : L - 1)];
}
__device__ __forceinline__ void lc_load_raw_x(const bf16_t* urow, int b, int gl, int lane, LcRaw& r) {
    const int l0 = 8 * gl; r.mid = *(const u32x4*)(urow + lc_tokrow(b, l0));
    unsigned edge = 0u;
    if (lane == 0 || lane == 63) edge = urow[lc_tokrow(b, lane == 0 ? l0 - 1 : (l0 + 8 < L ? l0 + 8 : L - 1))];
    r.left = edge; r.right = edge;
}
__device__ __forceinline__ void lc_fix_edges(LcRaw& r, int lane) {
    const unsigned up = (unsigned)__shfl_up((int)(r.mid.w >> 16), 1), dn = (unsigned)__shfl_down((int)(r.mid.x & 0xffffu), 1);
    if (lane != 0) r.left = up; if (lane != 63) r.right = dn;
}
__device__ __forceinline__ u32x4 lc_conv3(const LcRaw& r, int gl, float w0, float w1, float w2) {
    float x[10]; x[0] = (gl > 0) ? bf1((bf16_t)r.left) : 0.f; x[9] = (8 * gl + 8 < L) ? bf1((bf16_t)r.right) : 0.f;
    x[1] = bflo(r.mid.x); x[2] = bfhi(r.mid.x); x[3] = bflo(r.mid.y); x[4] = bfhi(r.mid.y); x[5] = bflo(r.mid.z); x[6] = bfhi(r.mid.z); x[7] = bflo(r.mid.w); x[8] = bfhi(r.mid.w);
    float o[8];
#pragma unroll
    for (int k = 0; k < 8; ++k) o[k] = w0 * x[k] + w1 * x[k + 1] + w2 * x[k + 2];
    return (u32x4){pk2(o[0], o[1]), pk2(o[2], o[3]), pk2(o[4], o[5]), pk2(o[6], o[7])};
}
struct LcFilt { u32x4 a[3]; u32x2 n[3]; };
__device__ __forceinline__ void lc_load_filter(const bf16_t* krow, int tid, LcFilt& f) {
#pragma unroll
    for (int j = 0; j < 3; ++j) { const int m = tid + NTHR * j; const int mc = m < KLEN / 8 ? m : KLEN / 8 - 1, mn = mc + 1 < KLEN / 8 ? mc + 1 : KLEN / 8 - 1;
        f.a[j] = *(const u32x4*)(krow + 8 * mc); f.n[j] = *(const u32x2*)(krow + 8 * mn); }
}
__device__ __forceinline__ void lc_store_filter(const LcFilt& f, LAS unsigned char* lds, int tid) {
#pragma unroll
    for (int j = 0; j < 3; ++j) { const int m = tid + NTHR * j;
        if (m < KLEN / 8) { const bool lastc = (m + 1 >= KLEN / 8); const unsigned w[6] = {f.a[j].x, f.a[j].y, f.a[j].z, f.a[j].w, lastc ? 0u : f.n[j].x, lastc ? 0u : f.n[j].y};
            *(LAS u32x4*)(lds + LC_KC + 0 * LC_KCS + 16 * m) = (u32x4){__builtin_amdgcn_alignbit(w[1], w[0], 16), __builtin_amdgcn_alignbit(w[2], w[1], 16), __builtin_amdgcn_alignbit(w[3], w[2], 16), __builtin_amdgcn_alignbit(w[4], w[3], 16)};
            *(LAS u32x4*)(lds + LC_KC + 1 * LC_KCS + 16 * m) = (u32x4){w[1], w[2], w[3], w[4]};
            *(LAS u32x4*)(lds + LC_KC + 2 * LC_KCS + 16 * m) = (u32x4){__builtin_amdgcn_alignbit(w[2], w[1], 16), __builtin_amdgcn_alignbit(w[3], w[2], 16), __builtin_amdgcn_alignbit(w[4], w[3], 16), __builtin_amdgcn_alignbit(w[5], w[4], 16)};
            *(LAS u32x4*)(lds + LC_KC + 3 * LC_KCS + 16 * m) = (u32x4){w[2], w[3], w[4], w[5]}; } }
}
template <int VAR = 0> __device__ __forceinline__ void lc_conv(LAS unsigned char* lds, int uin_off, int wave, int lane, f32x16& accm) {
    const int g = wave; const int i32 = lane & 31, h = lane >> 5, n16 = lane & 15, b = (lane >> 4) & 1;
    const int e0 = 32 * g - 257;
    const int p0 = KOFF - 16 * e0 - i32 + 8 * h; const int sh = ((p0 - 1) & 3) + 1; const int q0 = p0 - sh;
    const LAS unsigned char* kpA = lds + LC_KC + (sh - 1) * LC_KCS + 2 * q0;
    const int I = 16 * g + n16;
    const int G0 = 4 * I - 2 * e0 + h + 60, G1 = G0 - 2;
    const LAS unsigned char* up0 = lds + uin_off + lc_ugran(b, G0); const LAS unsigned char* up1 = lds + uin_off + lc_ugran(b, G1);
    f32x16 acc0, acc1;
#pragma unroll
    for (int r = 0; r < 16; ++r) { acc0[r] = 0.f; acc1[r] = 0.f; }
    u32x2 fa[4], fb[4]; u32x4 fu[4];
    if (VAR != 0) { for (int j = 0; j < 4; ++j) { fa[j] = (u32x2){0u, 0u}; fb[j] = (u32x2){0u, 0u}; fu[j] = (u32x4){0u, 0u, 0u, 0u}; } }
    unsigned ka = (unsigned)(size_t)kpA - 96u, u0 = (unsigned)(size_t)up0 - 16u, u1 = (unsigned)(size_t)up1 - 16u;
#define LC_LD(j, jo, ko, uo) do { if (VAR == 0) asm volatile("ds_read_b64 %0, %3 offset:" #ko "\n\tds_read_b64 %1, %3 offset:" #ko "+8\n\tds_read_b128 %2, %4 offset:" #uo \
        : "=v"(fa[j]), "=v"(fb[j]), "=v"(fu[j]) : "v"(ka), "v"(((jo) & 1) ? u1 : u0) : "memory"); \
        else if (VAR == 1) asm volatile("ds_read_b64 %0, %2 offset:" #ko "\n\tds_read_b64 %1, %2 offset:" #ko "+8" : "=v"(fa[j]), "=v"(fb[j]) : "v"(ka) : "memory"); } while (0)
#define LC_WAIT(n, j) do { if (VAR == 0) asm volatile("s_waitcnt lgkmcnt(" #n ")" : "+v"(fa[j]), "+v"(fb[j]), "+v"(fu[j])); else if (VAR == 1) asm volatile("s_waitcnt lgkmcnt(" #n "*2/3)" : "+v"(fa[j]), "+v"(fb[j]), "+v"(fu[j])); else asm volatile("" : "+v"(fa[j]), "+v"(fb[j]), "+v"(fu[j])); } while (0)
#define LC_MM(j, acc) acc = __builtin_amdgcn_mfma_f32_32x32x16_bf16(__builtin_bit_cast(bf16x8, (u32x4){fa[j].x, fa[j].y, fb[j].x, fb[j].y}), __builtin_bit_cast(bf16x8, fu[j]), acc, 0, 0, 0)
    LC_LD(0, 0, 96, 16); LC_LD(1, 1, 64, 16); LC_LD(2, 2, 32, 0); LC_LD(3, 3, 0, 0);
    for (int k = 0; k < 71; ++k) {
        ka -= 128u; u0 -= 32u; u1 -= 32u;
        LC_WAIT(9, 0); LC_MM(0, acc0); LC_LD(0, 0, 96, 16);
        LC_WAIT(9, 1); LC_MM(1, acc1); LC_LD(1, 1, 64, 16);
        LC_WAIT(9, 2); LC_MM(2, acc0); LC_LD(2, 2, 32, 0);
        LC_WAIT(9, 3); LC_MM(3, acc1); LC_LD(3, 3, 0, 0);
    }
    LC_WAIT(9, 0); LC_MM(0, acc0); LC_WAIT(6, 1); LC_MM(1, acc1); LC_WAIT(3, 2); LC_MM(2, acc0); LC_WAIT(0, 3); LC_MM(3, acc1);
#undef LC_LD
#undef LC_WAIT
#undef LC_MM
    accm = acc0 + acc1;
    {
        const int h4 = lane >> 4; f32x4 t = (f32x4){0.f, 0.f, 0.f, 0.f};
        const int s_lo = 17 * wave, s_hi = (s_lo + 17 < 129) ? s_lo + 17 : 129;
        const int pt = 32 - n16 + 8 * h4; const int st_ = ((pt - 1) & 3) + 1; const LAS unsigned char* kt = lds + LC_KC + (st_ - 1) * LC_KCS + 2 * (pt - st_);
        const LAS unsigned char* ut = lds + uin_off + (n16 & 1) * 10240 + h4 * 2560 + 16 * 15;
        for (int s = s_lo; s < s_hi; ++s) {
            const u32x2 a0 = *(const LAS u32x2*)(kt + 64 * s), a1 = *(const LAS u32x2*)(kt + 64 * s + 8);
            u32x4 bw = *(const LAS u32x4*)(ut + 16 * s); if (n16 >= 2) bw = (u32x4){0u, 0u, 0u, 0u};
            t = __builtin_amdgcn_mfma_f32_16x16x32_bf16(__builtin_bit_cast(bf16x8, (u32x4){a0.x, a0.y, a1.x, a1.y}), __builtin_bit_cast(bf16x8, bw), t, 0, 0, 0);
        }
        if (n16 < 2) { LAS float* tl = (LAS float*)(lds + LC_TAIL) + n16 * 16 + 4 * h4;
#pragma unroll
            for (int r = 0; r < 4; ++r) (void)__hip_atomic_fetch_add(tl + r, t[r], __ATOMIC_RELAXED, __HIP_MEMORY_SCOPE_WORKGROUP); }
    }
}
__device__ __forceinline__ void lc_item(int tid, int j, int& b, int& gl) { if (j < 2) { b = j; gl = 2 + tid; } else { b = (tid >> 1) & 1; gl = tid & 1; } }
__device__ __forceinline__ void phase_longconv(const Params& p, LAS unsigned char* lds, int jl, int vcu, int G, int tid, int wave, int lane) {
    const bf16_t* UT = (const bf16_t*)(p.ws + WS_P); bf16_t* YT = (bf16_t*)(p.ws + WS_YT); const bf16_t* KT = (const bf16_t*)(p.ws + WS_KT);
    const float* wsh = p.in[I_HYSHORT] + (size_t)jl * 3 * 4096 * 3; const float* hb = p.in[I_HYBIAS] + (size_t)jl * 2 * 4096;
    for (int i = tid; i < 2 * LC_US / 16; i += NTHR) *(LAS u32x4*)(lds + LC_U1 + 16 * i) = (u32x4){0u, 0u, 0u, 0u};
    const int h = lane >> 5, n16 = lane & 15, bl = (lane >> 4) & 1;
    LcRaw rv[3], r1[3], r2[3]; LcFilt flt; float wv[9], nb0 = 0.f, nb1 = 0.f, nb0n = 0.f, nb1n = 0.f;
    auto load_channel = [&](int c) {
#pragma unroll
        for (int k = 0; k < 3; ++k) { wv[k] = wsh[c * 3 + k]; wv[3 + k] = wsh[(4096 + c) * 3 + k]; wv[6 + k] = wsh[(8192 + c) * 3 + k]; }
        nb0n = hb[c]; nb1n = hb[4096 + c];
#pragma unroll
        for (int j = 0; j < 2; ++j) { int b, gl; lc_item(tid, j, b, gl);
            lc_load_raw_x(UT + (size_t)c * MP, b, gl, lane, rv[j]); lc_load_raw_x(UT + (size_t)(4096 + c) * MP, b, gl, lane, r1[j]); lc_load_raw_x(UT + (size_t)(8192 + c) * MP, b, gl, lane, r2[j]); }
        if (tid < 4) { int b, gl; lc_item(tid, 2, b, gl);
            lc_load_raw(UT + (size_t)c * MP, b, gl, rv[2]); lc_load_raw(UT + (size_t)(4096 + c) * MP, b, gl, r1[2]); lc_load_raw(UT + (size_t)(8192 + c) * MP, b, gl, r2[2]); }
        lc_load_filter(KT + ((size_t)(jl * 2 + 0) * 4096 + c) * KLEN, tid, flt);
    };
    if (vcu < 4096) { load_channel(vcu); nb0 = nb0n; nb1 = nb1n; }
    lds_barrier();
    for (int c = vcu; c < 4096; c += G) {
        const bf16_t* grow = UT + (size_t)(12288 + c) * MP;
        const float bias0 = nb0, bias1 = nb1;
        SUBP_T0(10)
#pragma unroll
        for (int j = 0; j < 2; ++j) { lc_fix_edges(rv[j], lane); lc_fix_edges(r1[j], lane); lc_fix_edges(r2[j], lane); }
#pragma unroll
        for (int j = 0; j < 3; ++j) { if (j < 2 || tid < 4) { int b, gl; lc_item(tid, j, b, gl);
            *(LAS u32x4*)(lds + LC_U1 + lc_ugran(b, gl + 60)) = lc_conv3(rv[j], gl, wv[0], wv[1], wv[2]);
            *(LAS u32x4*)(lds + LC_X1 + b * 8224 + 16 * gl) = lc_conv3(r1[j], gl, wv[3], wv[4], wv[5]);
            *(LAS u32x4*)(lds + LC_X2 + b * 8224 + 16 * gl) = lc_conv3(r2[j], gl, wv[6], wv[7], wv[8]); } }
        lc_store_filter(flt, lds, tid);
        if (tid < 32) ((LAS float*)(lds + LC_TAIL))[tid] = 0.f;
        lc_load_filter(KT + ((size_t)(jl * 2 + 1) * 4096 + c) * KLEN, tid, flt);
        lds_barrier(); SUBP_T1(10)
        SUBP_T0(11)
        f32x16 acc;
#if MK_LCX
        { lc_conv<MK_LCX - 1>(lds, LC_U1, wave, lane, acc); asm volatile("" :: "v"(acc)); lds_barrier(); if (tid < 32) ((LAS float*)(lds + LC_TAIL))[tid] = 0.f; lds_barrier(); }
#endif
        lc_conv(lds, LC_U1, wave, lane, acc);
        lds_barrier(); SUBP_T1(11) SUBP_T0(12)
        {
            const int I = 16 * wave + n16;
#pragma unroll
            for (int rg = 0; rg < 4; ++rg) { const int t = 32 * I + 8 * rg + 4 * h; const int G8 = (t + 480) >> 3; const int uoff = lc_ugran(bl, G8) + 2 * (t & 7);
                const u32x2 uu = *(const LAS u32x2*)(lds + LC_U1 + uoff); const u32x2 xx = *(const LAS u32x2*)(lds + LC_X1 + bl * 8224 + 2 * t);
                const float z0 = bflo(xx.x) * (acc[4 * rg + 0] + bias0 * bflo(uu.x)), z1 = bfhi(xx.x) * (acc[4 * rg + 1] + bias0 * bfhi(uu.x));
                const float z2 = bflo(xx.y) * (acc[4 * rg + 2] + bias0 * bflo(uu.y)), z3 = bfhi(xx.y) * (acc[4 * rg + 3] + bias0 * bfhi(uu.y));
                *(LAS u32x2*)(lds + LC_U2 + uoff) = (u32x2){pk2(z0, z1), pk2(z2, z3)}; }
            if (tid < 32) { const int b = tid >> 4, i = tid & 15, t = 4096 + i; const int uoff = lc_ugran(b, (t + 480) >> 3) + 2 * (t & 7);
                const float u = bf1(*(const LAS bf16_t*)(lds + LC_U1 + uoff)), x = bf1(*(const LAS bf16_t*)(lds + LC_X1 + b * 8224 + 2 * t));
                const float y = ((LAS float*)(lds + LC_TAIL))[b * 16 + i];
                *(LAS bf16_t*)(lds + LC_U2 + uoff) = (bf16_t)f2bf(x * (y + bias0 * u)); }
        }
        lc_store_filter(flt, lds, tid);
        lds_barrier(); SUBP_T1(12) SUBP_T0(13)
        if (tid < 32) ((LAS float*)(lds + LC_TAIL))[tid] = 0.f;
        u32x2 gg[4]; bf16_t gtail = 0;
#pragma unroll
        for (int rg = 0; rg < 4; ++rg) gg[rg] = *(const u32x2*)(grow + lc_tokrow(bl, 32 * (16 * wave + n16) + 8 * rg + 4 * h));
        gtail = grow[lc_tokrow((tid >> 4) & 1, 4096 + (tid & 15))];
        if (c + G < 4096) load_channel(c + G);
        lds_barrier(); SUBP_T1(13) SUBP_T0(14)
        lc_conv(lds, LC_U2, wave, lane, acc);
        lds_barrier(); SUBP_T1(14) SUBP_T0(15)
        {
            const int I = 16 * wave + n16;
#pragma unroll
            for (int rg = 0; rg < 4; ++rg) { const int t = 32 * I + 8 * rg + 4 * h; const int G8 = (t + 480) >> 3; const int uoff = lc_ugran(bl, G8) + 2 * (t & 7);
                const u32x2 zz = *(const LAS u32x2*)(lds + LC_U2 + uoff); const u32x2 xx = *(const LAS u32x2*)(lds + LC_X2 + bl * 8224 + 2 * t);
                const int row = lc_tokrow(bl, t); const u32x2 g2 = gg[rg];
                const float o0 = bflo(xx.x) * (acc[4 * rg + 0] + bias1 * bflo(zz.x)) * bflo(g2.x), o1 = bfhi(xx.x) * (acc[4 * rg + 1] + bias1 * bfhi(zz.x)) * bfhi(g2.x);
                const float o2 = bflo(xx.y) * (acc[4 * rg + 2] + bias1 * bflo(zz.y)) * bflo(g2.y), o3 = bfhi(xx.y) * (acc[4 * rg + 3] + bias1 * bfhi(zz.y)) * bfhi(g2.y);
                *(u32x2*)(YT + (size_t)c * MP + row) = (u32x2){pk2(o0, o1), pk2(o2, o3)}; }
            if (tid < 32) { const int b = tid >> 4, i = tid & 15, t = 4096 + i; const int uoff = lc_ugran(b, (t + 480) >> 3) + 2 * (t & 7);
                const float z = bf1(*(const LAS bf16_t*)(lds + LC_U2 + uoff)), x = bf1(*(const LAS bf16_t*)(lds + LC_X2 + b * 8224 + 2 * t));
                const float y = ((LAS float*)(lds + LC_TAIL))[b * 16 + i]; const int row = lc_tokrow(b, t);
                YT[(size_t)c * MP + row] = (bf16_t)f2bf(x * (y + bias1 * z) * bf1(gtail)); }
        }
        asm volatile("" : "+v"(nb0n), "+v"(nb1n));
        nb0 = nb0n; nb1 = nb1n;
        lds_barrier(); SUBP_T1(15)
    }
}
__device__ __forceinline__ void phase_transpose(const Params& p, LAS unsigned char* lds, int gw, int NGW, int wave, int lane) {
    const bf16_t* YT = (const bf16_t*)(p.ws + WS_YT); bf16_t* Y = (bf16_t*)(p.ws + WS_Y);
    LAS bf16_t* tile = (LAS bf16_t*)(lds + wave * 8704);
    constexpr int NTT = MP / 64;
    for (int it = gw; it < (D / 64) * NTT; it += NGW) {
        const int ct = it / NTT, tt = it % NTT; const int c0 = 64 * ct, t0 = 64 * tt;
#pragma unroll
        for (int k = 0; k < 8; ++k) { const int cl = 8 * k + (lane >> 3), ch = lane & 7; const u32x4 v = *(const u32x4*)(YT + (size_t)(c0 + cl) * MP + t0 + 8 * ch);
            LAS unsigned* d = (LAS unsigned*)(tile + cl * 68 + 8 * ch); d[0] = v.x; d[1] = v.y; d[2] = v.z; d[3] = v.w; }
        LDS_WAIT(); asm volatile("" ::: "memory");
#pragma unroll
        for (int k = 0; k < 8; ++k) { const int tl = 8 * k + (lane >> 3), ch = lane & 7; const LAS bf16_t* s = tile + (8 * ch) * 68 + tl;
            u32x4 o; o.x = (unsigned)s[0] | ((unsigned)s[68] << 16); o.y = (unsigned)s[2 * 68] | ((unsigned)s[3 * 68] << 16); o.z = (unsigned)s[4 * 68] | ((unsigned)s[5 * 68] << 16); o.w = (unsigned)s[6 * 68] | ((unsigned)s[7 * 68] << 16);
            *(u32x4*)(Y + (size_t)(t0 + tl) * D + c0 + 8 * ch) = o; }
        LDS_WAIT(); asm volatile("" ::: "memory");
    }
}
constexpr int TG_ROWB = 528;
constexpr int TG_A = 0, TG_B = 32 * TG_ROWB, TG_BUF = 96 * TG_ROWB;
__device__ __forceinline__ void thin_gemm(const Params& p, LAS unsigned char* lds, int mode, int jp, const bf16_t* Ameta, const bf16_t* W, int N, int vcu, int G, int tid, int wave, int lane) {
    const int r32 = lane & 31, h = lane >> 5, nt = wave & 1, kq = wave >> 1; LAS float* RED = (LAS float*)lds;
    for (int nb = vcu; nb < N / 64; nb += G) {
        const int n0 = 64 * nb;
        u32x4 st[6];
#define TG_LOAD(kc) do { _Pragma("unroll") for (int j = 0; j < 6; ++j) { const int q_ = tid + NTHR * j; const int row_ = (q_ >> 5) & 63, col_ = q_ & 31; \
            const bf16_t* src_ = (j < 2) ? Ameta + (size_t)(q_ >> 5) * D : W + (size_t)(n0 + row_ - (j < 2 ? 0 : 0)) * D; \
            st[j] = *(const u32x4*)((j < 2 ? Ameta + (size_t)(q_ >> 5) * D : W + (size_t)(n0 + ((q_ - 1024) >> 5)) * D) + 256 * (kc) + 8 * col_); (void)src_; (void)row_; } } while (0)
#define TG_STORE(buf) do { _Pragma("unroll") for (int j = 0; j < 6; ++j) { const int q_ = tid + NTHR * j; const int col_ = q_ & 31; \
            const int off_ = (j < 2) ? TG_A + (q_ >> 5) * TG_ROWB : TG_B + ((q_ - 1024) >> 5) * TG_ROWB; *(LAS u32x4*)(lds + (buf) * TG_BUF + off_ + 16 * col_) = st[j]; } } while (0)
        f32x16 acc;
#pragma unroll
        for (int i = 0; i < 16; ++i) acc[i] = 0.f;
        TG_LOAD(0); TG_STORE(0); lds_barrier();
        for (int kc = 0; kc < 16; ++kc) {
            const int buf = kc & 1;
            if (kc + 1 < 16) TG_LOAD(kc + 1);
            const LAS unsigned char* ab = lds + buf * TG_BUF + TG_A + r32 * TG_ROWB + 128 * kq + 16 * h; const LAS unsigned char* bb = lds + buf * TG_BUF + TG_B + (32 * nt + r32) * TG_ROWB + 128 * kq + 16 * h;
#pragma unroll
            for (int s4 = 0; s4 < 4; ++s4) acc = __builtin_amdgcn_mfma_f32_32x32x16_bf16(*(const LAS bf16x8*)(ab + 32 * s4), *(const LAS bf16x8*)(bb + 32 * s4), acc, 0, 0, 0);
            if (kc + 1 < 16) TG_STORE(buf ^ 1);
            lds_barrier();
        }
#undef TG_LOAD
#undef TG_STORE
#pragma unroll
        for (int reg = 0; reg < 16; ++reg) RED[(wave * 32 + (reg & 3) + 8 * (reg >> 2) + 4 * h) * 33 + r32] = acc[reg];
        lds_barrier();
#pragma unroll
        for (int half = 0; half < 2; ++half) {
            const int nh0 = n0 + 32 * half;
            const int seg = (mode == 0) ? (nh0 >> 11) : 0; const bool transposed = (mode == 2) || (mode == 0 && seg == 2);
            float v[2]; int tok[2], nn[2];
#pragma unroll
            for (int k = 0; k < 2; ++k) { tok[k] = transposed ? 2 * (tid & 15) + k : (tid >> 4); nn[k] = transposed ? (tid >> 4) : 2 * (tid & 15) + k; float s = 0.f;
#pragma unroll
                for (int q4 = 0; q4 < 4; ++q4) s += RED[((2 * q4 + half) * 32 + tok[k]) * 33 + nn[k]];
                v[k] = s; }
            if (mode == 0) {
                const float* lb = (const float*)(p.ws + WS_LB) + (size_t)jp * 4096;
#pragma unroll
                for (int k = 0; k < 2; ++k) { const int n = nh0 + nn[k];
                    if (seg == 0) v[k] *= 0.08838834764831845f; else if (seg == 3) v[k] = pg8::silu_f(v[k]) * 0.08838834764831845f;
                    else if (seg == 5 || seg == 6) { const float x = fminf(fmaxf(v[k], -80.f), 80.f); const float sg = __builtin_amdgcn_rcpf(1.0f + __expf(-x)); const float l0 = lb[(seg - 5) * 2048 + (n & 2047)]; v[k] = __logf(l0 + (1.0f - l0) * sg); }
                    else if (seg >= 7) v[k] = pg8::silu_f(v[k]); }
                if (seg == 2) *(unsigned*)((bf16_t*)(p.ws + WS_VT) + (size_t)(nh0 - 4096 + nn[0]) * MP + 8192 + tok[0]) = pk2(v[0], v[1]);
                else *(unsigned*)((bf16_t*)(p.ws + WS_P) + (size_t)(8192 + tok[0]) * EIN + nh0 + nn[0]) = pk2(v[0], v[1]);
            } else if (mode == 1) {
                *(unsigned*)((bf16_t*)(p.ws + WS_OUT) + (size_t)(8192 + tok[0]) * D + nh0 + nn[0]) = pk2(v[0], v[1]);
            } else {
                if (nh0 >= 12288) { v[0] = pg8::silu_f(v[0]); v[1] = pg8::silu_f(v[1]); }
                *(unsigned*)((bf16_t*)(p.ws + WS_P) + (size_t)(nh0 + nn[0]) * MP + 8192 + tok[0]) = pk2(v[0], v[1]);
            }
        }
        lds_barrier();
    }
}
#define GEMM_ALIGN true
#define GEMM_SP2 true
__global__ void __launch_bounds__(NTHR, 2) mk_fwd(Params p) {
    extern __shared__ __attribute__((aligned(16))) unsigned char lds_raw[];
    LAS unsigned char* lds = (LAS unsigned char*)lds_raw;
    volatile LAS unsigned* MISC = (volatile LAS unsigned*)(lds + MISC_OFF);
    const int tid = threadIdx.x, lane = tid & 63, wave = __builtin_amdgcn_readfirstlane(tid >> 6);
    const int G = gridDim.x; const int bx = blockIdx.x; const int vcu = (G % 8 == 0) ? (bx % 8) * (G / 8) + bx / 8 : bx;
    const int gw = vcu * NWAVES + wave, NGW = G * NWAVES;
    unsigned char* ws = p.ws;
    for (int u = tid; u < (LDS_BYTES - MISC_OFF) / 4; u += NTHR) MISC[u] = 0u;
    __syncthreads();
    XcdBarrier bar; bar.bar = (unsigned*)(ws + WS_CTL) + CW_BAR; bar.x = 0; bar.st = nullptr;
#if !MK_PER_PHASE
    bar = xcd_barrier_post((unsigned*)(ws + WS_CTL) + CW_BAR, MISC);
#endif
    const int lo = p.ph_lo, hi = p.ph_hi;
#define FRESH() int tid_ = threadIdx.x; asm volatile("" : "+v"(tid_)); const int lane_ = tid_ & 63, wave_ = __builtin_amdgcn_readfirstlane(tid_ >> 6); \
    int vcu_ = vcu; asm volatile("" : "+s"(vcu_)); const int gw_ = vcu_ * NWAVES + wave_; Params q = p; { unsigned char* w_ = q.ws; asm volatile("" : "+s"(w_)); q.ws = w_; } unsigned char* ws_ = q.ws; (void)lane_; (void)gw_; (void)ws_;
#define IN(k) (lo <= (k) && (k) < hi)
#if MK_PER_PHASE
#define SEAM(k) do { } while (0)
#elif MK_TIME_MASK || MK_SUBPROBE
    unsigned long long t_prev = wall_clock64(), t_acc = 0;
#define SEAM(k) do { if (IN(k) && IN((k) + 1)) xcd_barrier(bar); { const unsigned long long now_ = wall_clock64(); if ((MK_TIME_MASK >> (k)) & 1u) t_acc += now_ - t_prev; t_prev = now_; } } while (0)
#else
#define SEAM(k) do { if (IN(k) && IN((k) + 1)) xcd_barrier(bar); } while (0)
#endif
    if (IN(0)) { FRESH() phase_prologue(q, lds, gw_, NGW, wave_, lane_); } SEAM(0);
    if (IN(1)) { FRESH() phase_filtergen(q, lds, gw_, NGW, wave_, lane_); } SEAM(1);
    for (int jp = 0; jp < 2; ++jp) {
        const int pb = 2 + 11 * jp;
        if (IN(pb + 0)) { FRESH() const bf16_t* HN = (const bf16_t*)(ws_ + WS_HN);
            const bf16_t* W = (const bf16_t*)(ws_ + WS_WEIN) + (size_t)jp * EIN * D;
            pg8::DualOrder S; S.init(HN, W, NB * T, EIN - 2048, W + (size_t)4096 * D, HN, 2048, NB * T, D, G, bx, 16, 8);
            pg8::EpiEvenIn E{(bf16_t*)(ws_ + WS_P), EIN, (bf16_t*)(ws_ + WS_VT), MP, (const float*)(ws_ + WS_LB) + (size_t)jp * 4096};
            pg8::gemm_phase<pg8::EpiEvenIn, pg8::DualOrder, GEMM_ALIGN, GEMM_SP2>(lds, D, S, E);
            SUBP_T0(3) thin_gemm(q, lds, 0, jp, HN + (size_t)NB * T * D, W, EIN, vcu_, G, tid_, wave_, lane_); SUBP_T1(3)
        } SEAM(pb + 0);
        if (IN(pb + 1)) { FRESH()
            SUBP_T0(1) hgrn_stage1(q, lds, vcu_, G, tid_, wave_, lane_); SUBP_T1(1)
            SUBP_T0(2) for (int it = gw_; it < NA_SPLIT; it += NGW) natten_item(q, (LAS float*)(lds + wave_ * 2048), it, jp, lane_); SUBP_T1(2)
        } SEAM(pb + 1);
        if (IN(pb + 2)) { FRESH()
            if (G >= 128) {
                if (bx < 64) { SUBP_T0(30) hgrn_stage2f(q, lds, bx, tid_, wave_, lane_); SUBP_T1(30)
                    const int u = (bx & 7) * 8 + (bx >> 3);
                    for (int it = NA_TAIL + u * NWAVES + wave_; it < 8192 + 32; it += 64 * NWAVES) natten_item(q, (LAS float*)(lds + wave_ * 2048), it, jp, lane_); }
                else { const int nw = G - 64, b2 = bx - 64; const int u = ((nw & 7) == 0) ? (b2 & 7) * (nw >> 3) + (b2 >> 3) : b2;
                    for (int it = NA_SPLIT + u * NWAVES + wave_; it < NA_TAIL; it += nw * NWAVES) natten_item(q, (LAS float*)(lds + wave_ * 2048), it, jp, lane_); }
            } else {
                for (int item = bx; item < 64; item += G) hgrn_stage2f(q, lds, item, tid_, wave_, lane_);
                for (int it = NA_SPLIT + gw_; it < 8192 + 32; it += NGW) natten_item(q, (LAS float*)(lds + wave_ * 2048), it, jp, lane_);
            }
        } SEAM(pb + 2);
        if (IN(pb + 3)) { FRESH() phase_combine(q, jp, gw_, NGW, lane_); } SEAM(pb + 3);
        if (IN(pb + 4)) { FRESH()
            pg8::DualOrder S; S.init(ws_ + WS_Y, (const bf16_t*)(ws_ + WS_WEOUT) + (size_t)jp * D * D, NB * T, D, nullptr, nullptr, 0, 0, D, G, bx, 1 << 30, 0);
            pg8::EpiBf16Plain E{(bf16_t*)(ws_ + WS_OUT), D};
            pg8::gemm_phase<pg8::EpiBf16Plain, pg8::DualOrder, GEMM_ALIGN, GEMM_SP2>(lds, D, S, E);
            thin_gemm(q, lds, 1, jp, (const bf16_t*)(ws_ + WS_Y) + (size_t)NB * T * D, (const bf16_t*)(ws_ + WS_WEOUT) + (size_t)jp * D * D, D, vcu_, G, tid_, wave_, lane_);
        } SEAM(pb + 4);
        if (IN(pb + 5)) { FRESH() phase_postnorm(q, lds, 2 * jp, vcu_, G, tid_, wave_, lane_); } SEAM(pb + 5);
        if (IN(pb + 6)) { FRESH() const bf16_t* HN = (const bf16_t*)(ws_ + WS_HN);
            pg8::DualOrder S; S.init((const bf16_t*)(ws_ + WS_WOIN) + (size_t)jp * OIN * D, HN, OIN, NB * T, nullptr, nullptr, 0, 0, D, G, bx, 1 << 30, 0);
            pg8::EpiOddIn E{(bf16_t*)(ws_ + WS_P), MP, 48};
            pg8::gemm_phase<pg8::EpiOddIn, pg8::DualOrder, GEMM_ALIGN, GEMM_SP2>(lds, D, S, E);
            SUBP_T0(5) thin_gemm(q, lds, 2, jp, HN + (size_t)NB * T * D, (const bf16_t*)(ws_ + WS_WOIN) + (size_t)jp * OIN * D, OIN, vcu_, G, tid_, wave_, lane_); SUBP_T1(5)
        } SEAM(pb + 6);
        if (IN(pb + 7)) { FRESH() phase_longconv(q, lds, jp, vcu_, G, tid_, wave_, lane_); } SEAM(pb + 7);
        if (IN(pb + 8)) { FRESH() phase_transpose(q, lds, gw_, NGW, wave_, lane_); } SEAM(pb + 8);
        if (IN(pb + 9)) { FRESH()
            pg8::DualOrder S; S.init(ws_ + WS_Y, (const bf16_t*)(ws_ + WS_WOOUT) + (size_t)jp * D * D, NB * T, D, nullptr, nullptr, 0, 0, D, G, bx, 1 << 30, 0);
            pg8::EpiBf16Plain E{(bf16_t*)(ws_ + WS_OUT), D};
            pg8::gemm_phase<pg8::EpiBf16Plain, pg8::DualOrder, GEMM_ALIGN, GEMM_SP2>(lds, D, S, E);
            thin_gemm(q, lds, 1, jp, (const bf16_t*)(ws_ + WS_Y) + (size_t)NB * T * D, (const bf16_t*)(ws_ + WS_WOOUT) + (size_t)jp * D * D, D, vcu_, G, tid_, wave_, lane_);
        } SEAM(pb + 9);
        if (IN(pb + 10)) { FRESH() phase_postnorm(q, lds, 2 * jp + 1, vcu_, G, tid_, wave_, lane_); } SEAM(pb + 10);
    }
#if (MK_TIME_MASK || MK_SUBPROBE) && !MK_PER_PHASE
    if (blockIdx.x == 0) { __syncthreads(); const unsigned long long sub_ = ((unsigned long long)MISC[5] << 32) | MISC[4]; const unsigned long long t_end = wall_clock64(); while (wall_clock64() - t_end < (unsigned long long)MK_TIME_MULT * (t_acc + sub_)) __builtin_amdgcn_s_sleep(8); }
#endif
#undef IN
#undef SEAM
}

extern "C" void kernel_launch(void* const* d_in, const int* in_sizes, int n_in, void* d_out, int out_size, void* d_ws, size_t ws_size, hipStream_t stream) {
    static int grid = 0;
    if (grid == 0) {
        if (n_in != 21 || ws_size < WS_END) { fprintf(stderr, "kernel_launch: expected 21 inputs and >= %zu bytes of workspace; got %d, %zu\n", (size_t)WS_END, n_in, ws_size); grid = -1; return; }
        int dev = 0, cus = 0, per_cu = 0;
        if (hipGetDevice(&dev) != hipSuccess || hipDeviceGetAttribute(&cus, hipDeviceAttributeMultiprocessorCount, dev) != hipSuccess) { grid = -1; return; }
        if (hipFuncSetAttribute((const void*)mk_fwd, hipFuncAttributeMaxDynamicSharedMemorySize, LDS_BYTES) != hipSuccess) { fprintf(stderr, "kernel_launch: hipFuncSetAttribute failed\n"); grid = -1; return; }
        if (hipOccupancyMaxActiveBlocksPerMultiprocessor(&per_cu, (const void*)mk_fwd, NTHR, LDS_BYTES) != hipSuccess || per_cu < 1)
            fprintf(stderr, "kernel_launch: note: occupancy query reports %d workgroups per CU\n", per_cu);
        (void)hipGetLastError();
        grid = cus;
    }
    if (grid < 0) return;
    if (hipMemsetAsync((char*)d_ws + WS_CTL, 0, CTL_ZERO_BYTES, stream) != hipSuccess) return;
    Params a{};
    for (int i = 0; i < 21; ++i) a.in[i] = (const float*)d_in[i];
    a.out = (float*)d_out; a.ws = (unsigned char*)d_ws;
#if MK_PER_PHASE
    for (int ph = 0; ph < NPHASE; ++ph) { a.ph_lo = ph; a.ph_hi = ph + 1; hipLaunchKernelGGL(mk_fwd, dim3(grid), dim3(NTHR), LDS_BYTES, stream, a); }
#else
    a.ph_lo = 0; a.ph_hi = NPHASE; hipLaunchKernelGGL(mk_fwd, dim3(grid), dim3(NTHR), LDS_BYTES, stream, a);
#endif
    const hipError_t le = hipPeekAtLastError();
    if (le != hipSuccess) fprintf(stderr, "kernel_launch: launch failed: %s\n", hipGetErrorName(le));
}
```

```cpp
#include <hip/hip_runtime.h>
#include <cstdio>
#include <cstdint>
#ifndef MK_PER_PHASE
#define MK_PER_PHASE 0
#endif
#ifndef MK_TIME_MASK
#define MK_TIME_MASK 0u
#endif
#ifndef MK_TIME_MULT
#define MK_TIME_MULT 4
#endif
#ifndef MK_SUBPROBE
#define MK_SUBPROBE 0
#endif
#ifndef MK_LCX
#define MK_LCX 0
#endif
namespace pg8 {
#define PG8_LAS __attribute__((address_space(3)))
typedef unsigned short bf16_t;
typedef short bf16x8 __attribute__((ext_vector_type(8)));
typedef float f32x4 __attribute__((ext_vector_type(4)));
typedef unsigned u32x4 __attribute__((ext_vector_type(4)));
constexpr int BM = 256, BK = 64, HALF = 128, HTB = HALF * BK * 2  , STAGE_BYTES = 8 * HTB, NXCD = 8, WGM = 8;

__host__ __device__ __forceinline__ int lds_byte(int r, int c) { const int st = (r >> 4) * 2 + (c >> 5), rr = r & 15, cc = c & 31, ob = rr * 64 + cc * 2; return st * 1024 + (ob ^ (((ob >> 9) & 1) << 5)); }
__host__ __device__ __forceinline__ void stage_rc(int b, int& R, int& C) { const int st = b / 1024, sb = b % 1024, swz = sb ^ (((sb >> 9) & 1) << 5); R = (st >> 1) * 16 + swz / 64; C = (st & 1) * 32 + (swz % 64) / 2; }
__host__ __device__ __forceinline__ int perm32(int rho) { const int n = rho >> 4, i = rho & 15; return 8 * (i >> 2) + 4 * n + (i & 3); }

struct Unit { int pm, pn, kind; };

struct DualOrder {
    const char *A0, *B0, *A1, *B1; int nM0, nN0, n0, nM1, nN1, n1, G, c, skip_lo, skip_n; size_t tstep;
    __device__ void init(const void* a0, const void* b0, int M0, int N0, const void* a1, const void* b1, int M1, int N1, int K, int G_, int c_, int sl, int sn) {
        A0 = (const char*)a0; B0 = (const char*)b0; A1 = (const char*)a1; B1 = (const char*)b1; nM0 = M0 / BM; nN0 = N0 / BM; n0 = nM0 * nN0; nM1 = M1 / BM; nN1 = N1 / BM; n1 = nM1 * nN1;
        G = G_; c = c_; skip_lo = sl; skip_n = sn; tstep = (size_t)BM * K * 2; }
    __device__ bool next(int i, Unit& u) const {
        const long L = (long)i * G + c; const int nwg = n0 + n1; if (L >= nwg) return false;
        int wgid = (int)L; { const int q = nwg / NXCD, r = nwg % NXCD, xcd = wgid % NXCD, off = wgid / NXCD; wgid = (xcd < r ? xcd * (q + 1) : r * (q + 1) + (xcd - r) * q) + off; }
        int nM, nN, kind;
        if (wgid < n0) { nM = nM0; nN = nN0; kind = 0; } else { wgid -= n0; nM = nM1; nN = nN1; kind = 1; }
        const int nig = WGM * nN, gid = wgid / nig, fm = gid * WGM, gsz = (nM - fm) < WGM ? (nM - fm) : WGM;
        u.pm = fm + ((wgid % nig) % gsz); int pn = (wgid % nig) / gsz; if (kind == 0 && pn >= skip_lo) pn += skip_n; u.pn = pn; u.kind = kind; return true;
    }
    __device__ __forceinline__ const char* abase(const Unit& u) const { return (u.kind ? A1 : A0) + (size_t)u.pm * tstep; }
    __device__ __forceinline__ const char* bbase(const Unit& u) const { return (u.kind ? B1 : B0) + (size_t)u.pn * tstep; }
    __device__ __forceinline__ void a_ready(const Unit&) const {}
    __device__ __forceinline__ void done(const Unit&) const {}
};

typedef __bf16 bf16x2_t __attribute__((ext_vector_type(2)));
typedef float f32x2_t __attribute__((ext_vector_type(2)));
__device__ __forceinline__ unsigned cvt_pk_bf16(float lo, float hi) { const f32x2_t v = {lo, hi}; const bf16x2_t b = __builtin_convertvector(v, bf16x2_t); return __builtin_bit_cast(unsigned, b); }

struct EpiF32 {
    static constexpr bool PERM = false, AFTER_DRAIN = false;
    float* C; int ldc;
    __device__ __forceinline__ void operator()(const f32x4 (&acc)[2][2][4][2], const Unit& u, int wr, int wc, int fr, int fq) const {
        const int row0 = u.pm * BM + wr * 64 + fr, col0 = u.pn * BM + wc * 32 + 4 * fq;
#pragma unroll
        for (int ai = 0; ai < 2; ++ai)
#pragma unroll
            for (int m = 0; m < 4; ++m) { float* rowp = C + (size_t)(row0 + ai * HALF + m * 16) * ldc + col0;
#pragma unroll
                for (int bj = 0; bj < 2; ++bj)
#pragma unroll
                    for (int n = 0; n < 2; ++n) *(f32x4*)(rowp + bj * HALF + n * 16) = acc[ai][bj][m][n]; }
    }
};
struct EpiBf16Plain {
    static constexpr bool PERM = true, AFTER_DRAIN = false;
    bf16_t* O; int ldc;
    __device__ __forceinline__ void operator()(const f32x4 (&acc)[2][2][4][2], const Unit& u, int wr, int wc, int fr, int fq) const {
        const int row0 = u.pm * BM + wr * 64 + fr; const int col0 = u.pn * BM + wc * 32 + 8 * fq;
#pragma unroll
        for (int ai = 0; ai < 2; ++ai)
#pragma unroll
            for (int m = 0; m < 4; ++m) { bf16_t* rowp = O + (size_t)(row0 + ai * HALF + m * 16) * ldc + col0;
#pragma unroll
                for (int bj = 0; bj < 2; ++bj) { const f32x4 v0 = acc[ai][bj][m][0], v1 = acc[ai][bj][m][1];
                    u32x4 w; w.x = cvt_pk_bf16(v0[0], v0[1]); w.y = cvt_pk_bf16(v0[2], v0[3]); w.z = cvt_pk_bf16(v1[0], v1[1]); w.w = cvt_pk_bf16(v1[2], v1[3]);
                    *(u32x4*)(rowp + bj * HALF) = w; } }
    }
};
__device__ __forceinline__ float silu_f(float x) { return x * __builtin_amdgcn_rcpf(1.0f + __expf(-x)); }
struct EpiEvenIn {
    static constexpr bool PERM = true, AFTER_DRAIN = false;
    bf16_t* P; int ldp; bf16_t* VT; int ldv; const float* lb;
    __device__ __forceinline__ void operator()(const f32x4 (&acc)[2][2][4][2], const Unit& u, int wr, int wc, int fr, int fq) const {
        const int row0 = u.pm * BM + wr * 64 + fr; const int col0 = u.pn * BM + wc * 32 + 8 * fq;
        bf16_t* base = u.kind ? VT : P; const int ldc = u.kind ? ldv : ldp;
        const int seg = u.kind ? 1 : (u.pn >> 3);
        const int mode = (seg == 0) ? 1 : (seg == 3) ? 2 : (seg == 5 || seg == 6) ? 3 : (seg >= 7) ? 4 : 0;
        f32x4 lbv[2][2];
#pragma unroll
        for (int bj = 0; bj < 2; ++bj)
#pragma unroll
            for (int n = 0; n < 2; ++n) lbv[bj][n] = (mode == 3) ? *(const f32x4*)(lb + (seg - 5) * 2048 + ((col0 + bj * HALF + 4 * n) & 2047)) : (f32x4){0.f, 0.f, 0.f, 0.f};
#pragma unroll
        for (int ai = 0; ai < 2; ++ai)
#pragma unroll
            for (int m = 0; m < 4; ++m) { bf16_t* rowp = base + (size_t)(row0 + ai * HALF + m * 16) * ldc + col0;
#pragma unroll
                for (int bj = 0; bj < 2; ++bj) { f32x4 v[2] = {acc[ai][bj][m][0], acc[ai][bj][m][1]};
                    if (mode == 1) { v[0] = v[0] * 0.08838834764831845f; v[1] = v[1] * 0.08838834764831845f; }
                    else if (mode == 2) {
#pragma unroll
                        for (int n = 0; n < 2; ++n)
#pragma unroll
                            for (int k = 0; k < 4; ++k) v[n][k] = silu_f(v[n][k]) * 0.08838834764831845f; }
                    else if (mode == 3) {
#pragma unroll
                        for (int n = 0; n < 2; ++n)
#pragma unroll
                            for (int k = 0; k < 4; ++k) { const float x = fminf(fmaxf(v[n][k], -80.f), 80.f); const float sg = __builtin_amdgcn_rcpf(1.0f + __expf(-x)); const float l0 = lbv[bj][n][k];
                                v[n][k] = __logf(l0 + (1.0f - l0) * sg); } }
                    else if (mode == 4) {
#pragma unroll
                        for (int n = 0; n < 2; ++n)
#pragma unroll
                            for (int k = 0; k < 4; ++k) v[n][k] = silu_f(v[n][k]); }
                    u32x4 w; w.x = cvt_pk_bf16(v[0][0], v[0][1]); w.y = cvt_pk_bf16(v[0][2], v[0][3]); w.z = cvt_pk_bf16(v[1][0], v[1][1]); w.w = cvt_pk_bf16(v[1][2], v[1][3]);
                    *(u32x4*)(rowp + bj * HALF) = w; } }
    }
};
struct EpiOddIn {
    static constexpr bool PERM = true, AFTER_DRAIN = false;
    bf16_t* O; int ldc; int gate_pm0;
    __device__ __forceinline__ void operator()(const f32x4 (&acc)[2][2][4][2], const Unit& u, int wr, int wc, int fr, int fq) const {
        const int row0 = u.pm * BM + wr * 64 + fr; const int col0 = u.pn * BM + wc * 32 + 8 * fq; const bool gate = u.pm >= gate_pm0;
#pragma unroll
        for (int ai = 0; ai < 2; ++ai)
#pragma unroll
            for (int m = 0; m < 4; ++m) { bf16_t* rowp = O + (size_t)(row0 + ai * HALF + m * 16) * ldc + col0;
#pragma unroll
                for (int bj = 0; bj < 2; ++bj) { f32x4 v[2] = {acc[ai][bj][m][0], acc[ai][bj][m][1]};
                    if (gate) {
#pragma unroll
                        for (int n = 0; n < 2; ++n)
#pragma unroll
                            for (int k = 0; k < 4; ++k) v[n][k] = silu_f(v[n][k]); }
                    u32x4 w; w.x = cvt_pk_bf16(v[0][0], v[0][1]); w.y = cvt_pk_bf16(v[0][2], v[0][3]); w.z = cvt_pk_bf16(v[1][0], v[1][1]); w.w = cvt_pk_bf16(v[1][2], v[1][3]);
                    *(u32x4*)(rowp + bj * HALF) = w; } }
    }
};
template <class Epi, class Sched, bool ALIGN_EPI = false, bool SP2 = false>
__device__ __forceinline__ void gemm_phase(PG8_LAS unsigned char* lds, const int K, const Sched& S, const Epi& E) {
    int tid = threadIdx.x; asm volatile("" : "+v"(tid));
    const int wid = __builtin_amdgcn_readfirstlane(tid >> 6), lane = tid & 63, wr = wid >> 2, wc = wid & 3, fr = lane & 15, fq = lane >> 4;
    const int nt = K / BK;
    unsigned voffA[2], voffB[2];
#pragma unroll
    for (int i = 0; i < 2; ++i) { int R, C; stage_rc(tid * 16 + i * 8192, R, C); const int Rb = Epi::PERM ? ((R & ~31) + perm32(R & 31)) : R;
        voffA[i] = (unsigned)(R * K + C) * 2u; voffB[i] = (unsigned)(Rb * K + C) * 2u; }
    const size_t kstep = (size_t)(BK * 2);
    const size_t hstep = (size_t)HALF * K * 2;
    const size_t tstep = 2 * hstep;
    const unsigned ldsw = (unsigned)wid * 1024u;
    const int aoff = lds_byte(wr * 64 + fr, fq * 8), boff = lds_byte(wc * 32 + fr, fq * 8);
#define PG8_SA(b, h) (((b) * 2 + (h)) * HTB)
#define PG8_SB(b, h) ((4 + (b) * 2 + (h)) * HTB)
#define PG8_STAGE(bufoff, gbase, voff) do { _Pragma("unroll") for (int _i = 0; _i < 2; ++_i) \
        __builtin_amdgcn_global_load_lds((const unsigned*)((const char*)(gbase) + (voff)[_i]), (PG8_LAS unsigned*)(lds + (bufoff) + ldsw + _i * 8192), 16, 0, 0); } while (0)
#define PG8_LDA(dst, b, h) do { _Pragma("unroll") for (int m = 0; m < 4; ++m) _Pragma("unroll") for (int k = 0; k < 2; ++k) dst[m][k] = *(const PG8_LAS bf16x8*)(lds + PG8_SA(b, h) + aoff + m * 2048 + k * 1024); } while (0)
#define PG8_LDB(dst, b, h) do { _Pragma("unroll") for (int n = 0; n < 2; ++n) _Pragma("unroll") for (int k = 0; k < 2; ++k) dst[n][k] = *(const PG8_LAS bf16x8*)(lds + PG8_SB(b, h) + boff + n * 2048 + k * 1024); } while (0)
#define PG8_MMA(ai, bj, At, Bt) do { __builtin_amdgcn_s_setprio(1); _Pragma("unroll") for (int m = 0; m < 4; ++m) _Pragma("unroll") for (int n = 0; n < 2; ++n) _Pragma("unroll") for (int k = 0; k < 2; ++k) \
        acc[ai][bj][m][n] = __builtin_amdgcn_mfma_f32_16x16x32_bf16(Bt[n][k], At[m][k], acc[ai][bj][m][n], 0, 0, 0); __builtin_amdgcn_s_setprio(0); } while (0)
#define PG8_WAIT_V(n) asm volatile("s_waitcnt vmcnt(" #n ")" ::: "memory")
#define PG8_WAIT_L(n) asm volatile("s_waitcnt lgkmcnt(" #n ")" ::: "memory")
#define PG8_BAR __builtin_amdgcn_s_barrier()
#define PG8_SCHED __builtin_amdgcn_sched_barrier(0)
    Unit cur, nxt; int ui = 0;
    if (!S.next(0, cur)) return;
    f32x4 acc[2][2][4][2];
#pragma unroll
    for (int a = 0; a < 2; ++a)
#pragma unroll
        for (int b = 0; b < 2; ++b)
#pragma unroll
            for (int m = 0; m < 4; ++m)
#pragma unroll
                for (int n = 0; n < 2; ++n) acc[a][b][m][n] = (f32x4){0.f, 0.f, 0.f, 0.f};
    bf16x8 At[4][2], B0[2][2], B1[2][2];
    const char* cA = S.abase(cur); const char* cB = S.bbase(cur);
    S.a_ready(cur);
    if constexpr (SP2) {
        PG8_STAGE(PG8_SB(0, 0), cB, voffB); PG8_STAGE(PG8_SB(0, 1), cB + hstep, voffB); PG8_STAGE(PG8_SA(0, 0), cA, voffA); PG8_STAGE(PG8_SA(0, 1), cA + hstep, voffA);
        if (wr == 1) PG8_BAR;
        PG8_WAIT_V(2); PG8_BAR;
        PG8_STAGE(PG8_SB(1, 0), cB + kstep, voffB); PG8_STAGE(PG8_SA(1, 0), cA + kstep, voffA); PG8_STAGE(PG8_SB(1, 1), cB + hstep + kstep, voffB);
        PG8_WAIT_V(6); PG8_BAR;
    } else {
        PG8_STAGE(PG8_SB(0, 0), cB, voffB); PG8_STAGE(PG8_SA(0, 0), cA, voffA); PG8_STAGE(PG8_SB(0, 1), cB + hstep, voffB); PG8_STAGE(PG8_SA(0, 1), cA + hstep, voffA);
        if (wr == 1) PG8_BAR;
        PG8_WAIT_V(4); PG8_BAR;
        PG8_STAGE(PG8_SB(1, 0), cB + kstep, voffB); PG8_STAGE(PG8_SA(1, 0), cA + kstep, voffA); PG8_STAGE(PG8_SB(1, 1), cB + hstep + kstep, voffB);
        PG8_WAIT_V(6); PG8_BAR;
    }
    for (;;) {
        const bool has_next = S.next(ui + 1, nxt);
        const char* nA = has_next ? S.abase(nxt) : cA; const char* nB = has_next ? S.bbase(nxt) : cB;
        for (int t = 0; t < nt; t += 2) {
            const bool last = (t == nt - 2);
            const char* a1 = cA + (size_t)(t + 1) * kstep;
            const char* a2 = last ? nA : cA + (size_t)(t + 2) * kstep; const char* b2 = last ? nB : cB + (size_t)(t + 2) * kstep;
            const char* a3 = a2 + kstep; const char* b3 = b2 + kstep;
            if (last && has_next) S.a_ready(nxt);
            if constexpr (SP2) {
            PG8_LDB(B0, 0, 0); PG8_LDB(B1, 0, 1); PG8_SCHED; PG8_LDA(At, 0, 0); PG8_STAGE(PG8_SA(1, 1), a1 + hstep, voffA);
            PG8_WAIT_V(8); PG8_WAIT_L(0); PG8_BAR; PG8_MMA(0, 0, At, B0); PG8_MMA(0, 1, At, B1); PG8_BAR; PG8_SCHED;
            PG8_LDA(At, 0, 1); PG8_STAGE(PG8_SB(0, 0), b2, voffB); PG8_STAGE(PG8_SB(0, 1), b2 + hstep, voffB); PG8_STAGE(PG8_SA(0, 0), a2, voffA);
            PG8_WAIT_V(8); PG8_WAIT_L(0); PG8_BAR; PG8_MMA(1, 0, At, B0); PG8_MMA(1, 1, At, B1); PG8_BAR; PG8_SCHED;
            PG8_LDB(B0, 1, 0); PG8_LDB(B1, 1, 1); PG8_SCHED; PG8_LDA(At, 1, 0); PG8_STAGE(PG8_SA(0, 1), a2 + hstep, voffA);
            PG8_WAIT_V(8); PG8_WAIT_L(0); PG8_BAR; PG8_MMA(0, 0, At, B0); PG8_MMA(0, 1, At, B1); PG8_BAR; PG8_SCHED;
            PG8_LDA(At, 1, 1); PG8_STAGE(PG8_SB(1, 0), b3, voffB); PG8_STAGE(PG8_SB(1, 1), b3 + hstep, voffB); PG8_STAGE(PG8_SA(1, 0), a3, voffA);
            PG8_WAIT_V(8); PG8_WAIT_L(0); PG8_BAR; PG8_MMA(1, 0, At, B0); PG8_MMA(1, 1, At, B1); PG8_BAR; PG8_SCHED;
            } else {
            PG8_LDB(B0, 0, 0); PG8_SCHED; PG8_LDA(At, 0, 0); PG8_STAGE(PG8_SA(1, 1), a1 + hstep, voffA);
            PG8_WAIT_L(8); PG8_BAR; PG8_WAIT_L(0); PG8_MMA(0, 0, At, B0); PG8_BAR; PG8_SCHED;
            PG8_LDB(B1, 0, 1); PG8_STAGE(PG8_SB(0, 0), b2, voffB);
            PG8_BAR; PG8_WAIT_L(0); PG8_MMA(0, 1, At, B1); PG8_BAR;
            PG8_LDA(At, 0, 1); PG8_STAGE(PG8_SA(0, 0), a2, voffA);
            PG8_BAR; PG8_WAIT_L(0); PG8_MMA(1, 0, At, B0); PG8_BAR; PG8_SCHED;
            PG8_STAGE(PG8_SB(0, 1), b2 + hstep, voffB);
            PG8_WAIT_V(6); PG8_BAR; PG8_MMA(1, 1, At, B1); PG8_BAR;
            PG8_LDB(B0, 1, 0); PG8_SCHED; PG8_LDA(At, 1, 0); PG8_STAGE(PG8_SA(0, 1), a2 + hstep, voffA);
            PG8_WAIT_L(8); PG8_BAR; PG8_WAIT_L(0); PG8_MMA(0, 0, At, B0); PG8_BAR; PG8_SCHED;
            PG8_LDB(B1, 1, 1); PG8_STAGE(PG8_SB(1, 0), b3, voffB);
            PG8_BAR; PG8_WAIT_L(0); PG8_MMA(0, 1, At, B1); PG8_BAR;
            PG8_LDA(At, 1, 1); PG8_STAGE(PG8_SA(1, 0), a3, voffA);
            PG8_BAR; PG8_WAIT_L(0); PG8_MMA(1, 0, At, B0); PG8_BAR; PG8_SCHED;
            PG8_STAGE(PG8_SB(1, 1), b3 + hstep, voffB);
            PG8_WAIT_V(6); PG8_BAR; PG8_MMA(1, 1, At, B1); PG8_BAR;
            }
        }
        if constexpr (ALIGN_EPI) { if (wr == 0) PG8_BAR; }
        if constexpr (!Epi::AFTER_DRAIN) { E(acc, cur, wr, wc, fr, fq); S.done(cur); }
        if (!has_next) break;
#pragma unroll
        for (int a = 0; a < 2; ++a)
#pragma unroll
            for (int b = 0; b < 2; ++b)
#pragma unroll
                for (int m = 0; m < 4; ++m)
#pragma unroll
                    for (int n = 0; n < 2; ++n) acc[a][b][m][n] = (f32x4){0.f, 0.f, 0.f, 0.f};
        cur = nxt; cA = nA; cB = nB; ++ui;
        if constexpr (ALIGN_EPI) { if (wr == 1) PG8_BAR; }
    }
    PG8_WAIT_V(0);
    if constexpr (!ALIGN_EPI) { if (wr == 0) PG8_BAR; }
    PG8_BAR;

#undef PG8_SA
#undef PG8_SB
#undef PG8_STAGE
#undef PG8_LDA
#undef PG8_LDB
#undef PG8_MMA
#undef PG8_WAIT_V
#undef PG8_WAIT_L
#undef PG8_BAR
#undef PG8_SCHED
}
}
constexpr int NB = 2, T = 4096, NMETA = 16, L = T + NMETA, D = 4096;
constexpr int MV = NB * L;
constexpr int MP = 8448;
constexpr int EIN = 18432, OIN = 16384, HD = 128;
constexpr int QA_OFF = 0, KA_OFF = 2048, QB_OFF = 6144, IB_OFF = 8192, FF_OFF = 10240, FB_OFF = 12288, GATE_OFF = 14336;
constexpr int KOFF = 4128, KLEN = 8256;
constexpr int LPAD = 4128;
constexpr float EPS = 1e-6f;
constexpr int NWAVES = 8, NTHR = 512;
constexpr int NPHASE = 24;
constexpr int NA_SPLIT = 0, NA_TAIL = 7680;

constexpr size_t MiB = 1u << 20;
constexpr size_t WS_CTL = 0, CTL_ZERO_BYTES = 1 * MiB;
constexpr size_t WS_WEIN = 1 * MiB;
constexpr size_t WS_WEOUT = WS_WEIN + 2 * (size_t)EIN * D * 2;
constexpr size_t WS_WOIN = WS_WEOUT + 2 * (size_t)D * D * 2;
constexpr size_t WS_WOOUT = WS_WOIN + 2 * (size_t)OIN * D * 2;
constexpr size_t WS_H = WS_WOOUT + 2 * (size_t)D * D * 2;
constexpr size_t WS_HN = WS_H + (size_t)MP * D * 4;
constexpr size_t WS_P = WS_HN + (size_t)MP * D * 2;
constexpr size_t WS_VT = WS_P + (size_t)MP * EIN * 2;
constexpr size_t WS_Y = WS_VT + (size_t)2048 * MP * 2;
constexpr size_t WS_YT = WS_Y + (size_t)MP * D * 2;
constexpr size_t WS_OBP = WS_YT + (size_t)MP * D * 2;
constexpr size_t WS_OUT = WS_OBP + (size_t)2 * MP * 2048 * 4;
constexpr size_t WS_KT = WS_OUT + (size_t)MP * D * 4;
constexpr size_t WS_HID2 = WS_KT + (size_t)2 * 2 * 4096 * KLEN * 2;
constexpr size_t WS_LB = WS_HID2 + (size_t)2 * LPAD * 64 * 2;
constexpr size_t WS_QSG = WS_LB + (size_t)2 * 2 * 2048 * 4;
constexpr size_t WS_KSG = WS_QSG + (size_t)4160 * 8192 * 2;
constexpr size_t WS_VTG = WS_KSG + (size_t)4160 * 8192 * 2;
constexpr size_t WS_DECG = WS_VTG + (size_t)4160 * 8192 * 2;
constexpr size_t WS_END = WS_DECG + (size_t)4160 * 128 * 4;
static_assert(WS_WEIN % 256 == 0 && WS_H % 256 == 0 && WS_P % 256 == 0 && WS_KT % 256 == 0 && WS_HID2 % 256 == 0 && WS_LB % 256 == 0, "alignment");
constexpr int CW_BAR = 4096;

constexpr int LDS_BYTES = 163840;
constexpr int MISC_OFF = 162816;

#define LAS __attribute__((address_space(3)))
typedef unsigned short bf16_t;
typedef short bf16x8 __attribute__((ext_vector_type(8)));
typedef short bf16x4 __attribute__((ext_vector_type(4)));
typedef float f32x4 __attribute__((ext_vector_type(4)));
typedef float f32x16 __attribute__((ext_vector_type(16)));
typedef unsigned u32x4 __attribute__((ext_vector_type(4)));
typedef unsigned u32x2 __attribute__((ext_vector_type(2)));
#define LDS_WAIT() asm volatile("s_waitcnt lgkmcnt(0)" ::: "memory")
#define VM_WAIT() asm volatile("s_waitcnt vmcnt(0)" ::: "memory")
__device__ __forceinline__ unsigned f2bf(float f) { return pg8::cvt_pk_bf16(f, 0.f) & 0xffffu; }
__device__ __forceinline__ unsigned pk2(float lo, float hi) { return pg8::cvt_pk_bf16(lo, hi); }
__device__ __forceinline__ float bflo(unsigned w) { return __builtin_bit_cast(float, w << 16); }
__device__ __forceinline__ float bfhi(unsigned w) { return __builtin_bit_cast(float, w & 0xffff0000u); }
__device__ __forceinline__ float bf1(bf16_t w) { return __builtin_bit_cast(float, ((unsigned)w) << 16); }
__device__ __forceinline__ void lds_barrier() { asm volatile("s_waitcnt lgkmcnt(0)" ::: "memory"); __builtin_amdgcn_s_barrier(); asm volatile("" ::: "memory"); }
__device__ __forceinline__ float wave_sum(float v) {
#pragma unroll
    for (int o = 1; o < 64; o <<= 1) v += __shfl_xor(v, o);
    return v;
}

#define XB_TMO      128
#define XB_XCNT(j)  (256  + 64 * (j))
#define XB_XSUB(j)  (1280 + 64 * (j))
#define XB_XGEN(j)  (2304 + 64 * (j))
#define XB_TOP      3328
#define XB_TOPGEN   3392
#define XCD_BAR_WORDS 3456
#define XB_SPIN_CAP (1u << 20)
__device__ __forceinline__ unsigned xb_ld(unsigned* p)              { return __hip_atomic_load(p, __ATOMIC_RELAXED, __HIP_MEMORY_SCOPE_AGENT); }
__device__ __forceinline__ unsigned xb_add(unsigned* p, unsigned v) { return __hip_atomic_fetch_add(p, v, __ATOMIC_RELAXED, __HIP_MEMORY_SCOPE_AGENT); }
__device__ __forceinline__ unsigned xb_xcc_id() { return (unsigned)__builtin_amdgcn_s_getreg((3 << 11) | 20) & 0xFu; }
#define XB_SPIN(cond, bar) do { unsigned _sp = 0; while (cond) { __builtin_amdgcn_s_sleep(1); \
    if ((++_sp & 255u) == 0u) { if (xb_ld(&(bar)[XB_TMO])) break; if (_sp > XB_SPIN_CAP) { atomicAdd(&(bar)[XB_TMO], 1u); break; } } } } while (0)
struct XcdBarrier { unsigned* bar; unsigned x; volatile LAS unsigned* st; };
__device__ __forceinline__ XcdBarrier xcd_barrier_post(unsigned* bar, volatile LAS unsigned* st) {
    XcdBarrier b; b.bar = bar; b.x = xb_xcc_id(); b.st = st;
    if (threadIdx.x == 0) (void)xb_add(&bar[XB_XCNT(b.x)], 1u);
    return b;
}
__device__ __forceinline__ void xcd_barrier_complete(unsigned* bar, unsigned x, unsigned& nloc, unsigned& nx) {
    const unsigned G = gridDim.x * gridDim.y * gridDim.z;
    unsigned sum, cnt, mine, sp = 0u;
    for (;;) {
        sum = 0u; cnt = 0u; mine = 0u;
#pragma unroll
        for (unsigned j = 0; j < 16; ++j) { const unsigned c = xb_ld(&bar[XB_XCNT(j)]); sum += c; cnt += (c > 0u) ? 1u : 0u; mine = (j == x) ? c : mine; }
        if (sum == G) break;
        __builtin_amdgcn_s_sleep(1);
        if ((++sp & 255u) == 0u) { if (xb_ld(&bar[XB_TMO])) break; if (sp > XB_SPIN_CAP) { atomicAdd(&bar[XB_TMO], 1u); break; } }
    }
    nloc = mine > 0u ? mine : 1u; nx = cnt > 0u ? cnt : 1u;
}
__device__ __forceinline__ void xcd_barrier(const XcdBarrier& b) {
    asm volatile("s_waitcnt vmcnt(0)" ::: "memory");
    __syncthreads();
    if (threadIdx.x == 0) {
        unsigned* bar = b.bar;
        __builtin_amdgcn_s_waitcnt(0);
        unsigned nloc = b.st[0], nx = b.st[1];
        if (nloc == 0u) { xcd_barrier_complete(bar, b.x, nloc, nx); b.st[0] = nloc; b.st[1] = nx; }
        const unsigned old = xb_add(&bar[XB_XSUB(b.x)], 1u);
        const unsigned gen = old / nloc;
        if (old + 1u == (gen + 1u) * nloc) {
            __builtin_amdgcn_fence(__ATOMIC_RELEASE, "agent");
            asm volatile("s_waitcnt vmcnt(0)" ::: "memory");
            const unsigned og = xb_add(&bar[XB_TOP], 1u);
            const unsigned tg = og / nx;
            if (og + 1u == (tg + 1u) * nx) xb_add(&bar[XB_TOPGEN], 1u);
            else XB_SPIN(xb_ld(&bar[XB_TOPGEN]) == tg, bar);
            __builtin_amdgcn_fence(__ATOMIC_ACQUIRE, "agent");
            xb_add(&bar[XB_XGEN(b.x)], 1u);
            asm volatile("s_waitcnt vmcnt(0)" ::: "memory");
        } else {
            XB_SPIN(xb_ld(&bar[XB_XGEN(b.x)]) == gen, bar);
            __builtin_amdgcn_fence(__ATOMIC_ACQUIRE, "agent");
            asm volatile("s_waitcnt vmcnt(0)" ::: "memory");
        }
    }
    __syncthreads();
}

struct Params { const float* in[21]; float* out; unsigned char* ws; int ph_lo, ph_hi; };
enum { I_X = 0, I_META, I_NPRE, I_NPOST, I_EWIN, I_EWOUT, I_RPB, I_MBIAS, I_HGLOW, I_HGNORM, I_OWIN, I_OWOUT, I_HYSHORT, I_W1, I_B1, I_FR1, I_W2, I_B2, I_FR2, I_W3, I_HYBIAS };

#if MK_SUBPROBE
#define SUBP_T0(id) unsigned long long sp_t0_##id = 0; if (MK_SUBPROBE == (id)) sp_t0_##id = wall_clock64();
#define SUBP_T1(id) if (MK_SUBPROBE == (id) && threadIdx.x == 0) { volatile LAS unsigned* M_ = (volatile LAS unsigned*)(lds + MISC_OFF); const unsigned long long d_ = wall_clock64() - sp_t0_##id + (((unsigned long long)M_[5] << 32) | M_[4]); M_[4] = (unsigned)d_; M_[5] = (unsigned)(d_ >> 32); }
#else
#define SUBP_T0(id)
#define SUBP_T1(id)
#endif
struct P0Item { const float* W; bf16_t* WT; int N, k0, n0; };
__device__ __forceinline__ P0Item p0_item(const Params& p, int it) {
    constexpr int I_EIN = (D / 64) * (EIN / 256), I_SQ = (D / 64) * (D / 256), I_OIN = (D / 64) * (OIN / 256), I_LAYER = I_EIN + 2 * I_SQ + I_OIN;
    const int j = it / I_LAYER; int r = it % I_LAYER; P0Item x;
    if (r < I_EIN) { x.W = p.in[I_EWIN] + (size_t)j * D * EIN; x.WT = (bf16_t*)(p.ws + WS_WEIN) + (size_t)j * EIN * D; x.N = EIN; }
    else if ((r -= I_EIN) < I_SQ) { x.W = p.in[I_EWOUT] + (size_t)j * D * D; x.WT = (bf16_t*)(p.ws + WS_WEOUT) + (size_t)j * D * D; x.N = D; }
    else if ((r -= I_SQ) < I_OIN) { x.W = p.in[I_OWIN] + (size_t)j * D * OIN; x.WT = (bf16_t*)(p.ws + WS_WOIN) + (size_t)j * OIN * D; x.N = OIN; }
    else { r -= I_OIN; x.W = p.in[I_OWOUT] + (size_t)j * D * D; x.WT = (bf16_t*)(p.ws + WS_WOOUT) + (size_t)j * D * D; x.N = D; }
    const int nblk = x.N / 256; x.k0 = 64 * (r / nblk); x.n0 = 256 * (r % nblk); return x;
}
__device__ __forceinline__ void p0_load(const P0Item& x, int tid, f32x4 (&v)[8]) {
#pragma unroll
    for (int j = 0; j < 8; ++j) { const int q = tid + NTHR * j; v[j] = *(const f32x4*)(x.W + (size_t)(x.k0 + (q >> 6)) * x.N + x.n0 + 4 * (q & 63)); }
}
__device__ __forceinline__ void rms_row_to_bf16(const f32x4 (&v)[16], const float* g, bf16_t* orow, int lane) {
    float s = 0.f;
#pragma unroll
    for (int j = 0; j < 16; ++j) s += (v[j].x * v[j].x + v[j].y * v[j].y) + (v[j].z * v[j].z + v[j].w * v[j].w);
    const float rstd = 1.0f / sqrtf(wave_sum(s) * (1.0f / D) + EPS);
    const f32x4* g4 = (const f32x4*)g + lane; u32x2* o8 = (u32x2*)orow + lane;
#pragma unroll
    for (int j = 0; j < 16; ++j) { const f32x4 gg = g4[64 * j]; u32x2 w; w.x = pk2(v[j].x * rstd * gg.x, v[j].y * rstd * gg.y); w.y = pk2(v[j].z * rstd * gg.z, v[j].w * rstd * gg.w); o8[64 * j] = w; }
}
__device__ __forceinline__ void phase_prologue(const Params& p, LAS unsigned char* lds, int gw, int NGW, int wave, int lane) {
    unsigned char* ws = p.ws;
    {
        LAS float* tile = (LAS float*)lds;
        constexpr int NITEMS = 2 * ((D / 64) * (EIN / 256) + 2 * (D / 64) * (D / 256) + (D / 64) * (OIN / 256));
        const int vcu = gw / NWAVES, G = NGW / NWAVES, tid = wave * 64 + lane;
        f32x4 v[8]; P0Item cur;
        if (vcu < NITEMS) { cur = p0_item(p, vcu); p0_load(cur, tid, v); }
        for (int it = vcu; it < NITEMS; it += G) {
#pragma unroll
            for (int j = 0; j < 8; ++j) { const int q = tid + NTHR * j; *(LAS f32x4*)(tile + (q >> 6) * 260 + 4 * (q & 63)) = v[j]; }
            lds_barrier();
            const P0Item me = cur;
            if (it + G < NITEMS) { cur = p0_item(p, it + G); p0_load(cur, tid, v); }
#pragma unroll
            for (int half = 0; half < 2; ++half) { const int n = 128 * half + (tid >> 2), kq = tid & 3; const LAS float* s = tile + (16 * kq) * 260 + n;
                u32x4 o0, o1;
                o0.x = pk2(s[0 * 260], s[1 * 260]); o0.y = pk2(s[2 * 260], s[3 * 260]); o0.z = pk2(s[4 * 260], s[5 * 260]); o0.w = pk2(s[6 * 260], s[7 * 260]);
                o1.x = pk2(s[8 * 260], s[9 * 260]); o1.y = pk2(s[10 * 260], s[11 * 260]); o1.z = pk2(s[12 * 260], s[13 * 260]); o1.w = pk2(s[14 * 260], s[15 * 260]);
                bf16_t* d = me.WT + (size_t)(me.n0 + n) * D + me.k0 + 16 * kq;
                *(u32x4*)d = o0; *(u32x4*)(d + 8) = o1; }
            lds_barrier();
        }
    }
    float* H = (float*)(ws + WS_H); bf16_t* HN = (bf16_t*)(ws + WS_HN);
    for (int m = gw; m < MP; m += NGW) {
        f32x4 v[16];
        if (m < MV) {
            const float* src = (m < NB * T) ? p.in[I_X] + (size_t)m * D : p.in[I_META] + (size_t)((m - NB * T) & 15) * D;
#pragma unroll
            for (int j = 0; j < 16; ++j) v[j] = ((const f32x4*)src)[lane + 64 * j];
#pragma unroll
            for (int j = 0; j < 16; ++j) ((f32x4*)(H + (size_t)m * D))[lane + 64 * j] = v[j];
            rms_row_to_bf16(v, p.in[I_NPRE], HN + (size_t)m * D, lane);
        } else {
#pragma unroll
            for (int j = 0; j < 16; ++j) ((u32x2*)(HN + (size_t)m * D))[lane + 64 * j] = (u32x2){0u, 0u};
        }
    }
    { float* LB = (float*)(ws + WS_LB); const float* hl = p.in[I_HGLOW];
      for (int i = gw * 64 + lane; i < 2 * 2048; i += NGW * 64) { LB[i] = 0.f; LB[4096 + i] = 1.0f / (1.0f + __expf(hl[i] - hl[4096 + i])); } }
    { bf16_t* HID2 = (bf16_t*)(ws + WS_HID2);
      for (int it = gw; it < 2 * LPAD; it += NGW) {
        const int jl = it / LPAD, l = it % LPAD; float h2 = 0.f;
        if (l < L) {
            float z = 0.f;
            if (lane == 0) z = (float)l * (1.0f / (float)(L - 1));
            else if (lane < 33) { const int k = (lane - 1) & 15; const float band = 1e-4f + (float)k * ((15.0f - 1e-4f) / 15.0f); float rev = band * ((float)l / (float)L); rev -= floorf(rev);
                z = (lane < 17) ? __builtin_amdgcn_cosf(rev) : -__builtin_amdgcn_sinf(rev); }
            const float* w1 = p.in[I_W1] + (size_t)jl * 33 * 64; const float* w2 = p.in[I_W2] + (size_t)jl * 64 * 64;
            float a = p.in[I_B1][jl * 64 + lane];
#pragma unroll
            for (int i = 0; i < 33; ++i) a += __shfl(z, i) * w1[i * 64 + lane];
            const float h1 = __sinf(p.in[I_FR1][jl * 64 + lane] * a);
            float a2 = p.in[I_B2][jl * 64 + lane];
#pragma unroll 16
            for (int i = 0; i < 64; ++i) a2 += __shfl(h1, i) * w2[i * 64 + lane];
            h2 = __sinf(p.in[I_FR2][jl * 64 + lane] * a2);
        }
        HID2[(size_t)it * 64 + lane] = (bf16_t)f2bf(h2);
      } }
}

__device__ __forceinline__ void phase_filtergen(const Params& p, LAS unsigned char* lds, int gw, int NGW, int wave, int lane) {
    unsigned char* ws = p.ws; const bf16_t* HID2 = (const bf16_t*)(ws + WS_HID2); bf16_t* KT = (bf16_t*)(ws + WS_KT);
    const int r32 = lane & 31, h = lane >> 5;
    LAS bf16_t* tile = (LAS bf16_t*)(lds + wave * 5120);
    for (int wi = gw; wi < 2048; wi += NGW) {
        const int lpart = wi & 3, cb = (wi >> 2) & 127, n = (wi >> 9) & 1, jl = wi >> 10; const int c0 = cb * 32;
        const float* w3 = p.in[I_W3] + (size_t)jl * 64 * 16384;
        bf16x8 A[2][4];
#pragma unroll
        for (int dir = 0; dir < 2; ++dir)
#pragma unroll
            for (int st = 0; st < 4; ++st) { const float* src = w3 + (size_t)(16 * st + 8 * h) * 16384 + (dir * 2 + n) * 4096 + c0 + r32;
                u32x4 w; w.x = pk2(src[0], src[16384]); w.y = pk2(src[2 * 16384], src[3 * 16384]); w.z = pk2(src[4 * 16384], src[5 * 16384]); w.w = pk2(src[6 * 16384], src[7 * 16384]);
                A[dir][st] = __builtin_bit_cast(bf16x8, w); }
        const int lb0 = lpart * 33, lb1 = (lb0 + 33 < 129) ? lb0 + 33 : 129;
        const bf16_t* hrow = HID2 + (size_t)jl * LPAD * 64 + 8 * h;
        bf16x8 Bf[4], Bb[4];
#define FG_LOAD(lb) do { const int lb_ = (lb) * 32 + r32; const int lf_ = lb_ + 1 < LPAD ? lb_ + 1 : LPAD - 1; \
        _Pragma("unroll") for (int st = 0; st < 4; ++st) { Bf[st] = *(const bf16x8*)(hrow + (size_t)lf_ * 64 + 16 * st); Bb[st] = *(const bf16x8*)(hrow + (size_t)lb_ * 64 + 16 * st); } } while (0)
        FG_LOAD(lb0);
        for (int lb = lb0; lb < lb1; ++lb) {
            f32x16 acc0, acc1, accc;
#pragma unroll
            for (int i = 0; i < 16; ++i) { acc0[i] = 0.f; acc1[i] = 0.f; accc[i] = 0.f; }
#pragma unroll
            for (int st = 0; st < 4; ++st) { acc0 = __builtin_amdgcn_mfma_f32_32x32x16_bf16(A[0][st], Bf[st], acc0, 0, 0, 0); acc1 = __builtin_amdgcn_mfma_f32_32x32x16_bf16(A[1][st], Bb[st], acc1, 0, 0, 0); }
            if (lb == 0) {
#pragma unroll
                for (int st = 0; st < 4; ++st) accc = __builtin_amdgcn_mfma_f32_32x32x16_bf16(A[0][st], Bb[st], accc, 0, 0, 0);
            }
            if (lb + 1 < lb1) FG_LOAD(lb + 1);
            const int lbk = lb * 32 + r32, lfw = lbk + 1;
            const float tb = (float)lbk * (1.0f / (float)(L - 1)), tf = (float)lfw * (1.0f / (float)(L - 1));
#pragma unroll
            for (int reg = 0; reg < 16; ++reg) { const int cl = (reg & 3) + 8 * (reg >> 2) + 4 * h;
                const float delta = 3.0701134f + (15.350567f - 3.0701134f) * ((float)(c0 + cl) * (1.0f / 4095.0f));
                float v1 = acc1[reg] * __expf(-tb * delta); if (lbk == 0) v1 += accc[reg];
                const float v0 = acc0[reg] * __expf(-tf * delta);
                tile[cl * 40 + (31 - r32)] = (bf16_t)f2bf(v0); tile[(32 + cl) * 40 + r32] = (bf16_t)f2bf(v1); }
            LDS_WAIT(); asm volatile("" ::: "memory");
#pragma unroll
            for (int k = 0; k < 2; ++k) { const int cl = (lane >> 2) + 16 * k, ch = lane & 3;
                bf16_t* R = KT + ((size_t)(jl * 2 + n) * 4096 + c0 + cl) * KLEN;
                *(u32x4*)(R + (KOFF - 32 - 32 * lb) + 8 * ch) = *(const LAS u32x4*)(tile + cl * 40 + 8 * ch);
                *(u32x4*)(R + (KOFF + 32 * lb) + 8 * ch) = *(const LAS u32x4*)(tile + (32 + cl) * 40 + 8 * ch); }
            LDS_WAIT(); asm volatile("" ::: "memory");
        }
#undef FG_LOAD
    }
}
constexpr int HG_QM = 0, HG_KM = 17408, HG_KST = 34816, HG_VT = 53248, HG_TOT = 71680, HG_OUT = 79872, HG_END1 = 97280;
__device__ __forceinline__ int hg_row(int dir, int b, int ci, int tau) {
    if (dir == 0) { if (ci == 0) return tau < 16 ? 8192 + 16 * b + tau : -1; return b * 4096 + 64 * (ci - 1) + tau; }
    if (ci == 64) return tau < 16 ? 8192 + 16 * b + 15 - tau : -1;
    return b * 4096 + 4095 - (64 * ci + tau);
}
struct HgRaw { u32x2 q[4], l[4]; u32x4 v[2]; };
__device__ __forceinline__ void hg1_load(const bf16_t* P, int item, int tid, HgRaw& r) {
    const int ci = item % 65, hd = (item / 65) & 15, b = (item / (65 * 16)) & 1, dir = item / (65 * 32);
    const int qcol = QB_OFF + hd * 128, vcol = IB_OFF + hd * 128, fcol = (dir ? FB_OFF : FF_OFF) + hd * 128;
    const int dg = tid & 31, tg = tid >> 5, tv = tid >> 3, dvq = tid & 7;
#pragma unroll
    for (int i = 0; i < 4; ++i) { const int row = hg_row(dir, b, ci, 4 * tg + i); const int rc = row < 0 ? 0 : row;
        r.q[i] = *(const u32x2*)(P + (size_t)rc * EIN + qcol + 4 * dg); r.l[i] = *(const u32x2*)(P + (size_t)rc * EIN + fcol + 4 * dg); }
    { const int row = hg_row(dir, b, ci, tv); const int rc = row < 0 ? 0 : row;
      r.v[0] = *(const u32x4*)(P + (size_t)rc * EIN + vcol + 16 * dvq); r.v[1] = *(const u32x4*)(P + (size_t)rc * EIN + vcol + 16 * dvq + 8); }
}
__device__ __forceinline__ void hgrn_stage1(const Params& p, LAS unsigned char* lds, int vcu, int G, int tid, int wave, int lane) {
    const bf16_t* P = (const bf16_t*)(p.ws + WS_P);
    bf16_t* QSG = (bf16_t*)(p.ws + WS_QSG); bf16_t* KSG = (bf16_t*)(p.ws + WS_KSG); bf16_t* VTG = (bf16_t*)(p.ws + WS_VTG); float* DECG = (float*)(p.ws + WS_DECG);
    const int dg = tid & 31, tg = tid >> 5, tv = tid >> 3, dvq = tid & 7, r32 = lane & 31, h = lane >> 5;
    LAS bf16_t* QM = (LAS bf16_t*)(lds + HG_QM); LAS bf16_t* KM = (LAS bf16_t*)(lds + HG_KM); LAS bf16_t* KST = (LAS bf16_t*)(lds + HG_KST); LAS bf16_t* VTL = (LAS bf16_t*)(lds + HG_VT);
    LAS float* TOT = (LAS float*)(lds + HG_TOT);
    HgRaw raw;
    if (vcu < 4160) hg1_load(P, vcu, tid, raw);
    for (int item = vcu; item < 4160; item += G) {
        const int ci = item % 65, hd = (item / 65) & 15, b = (item / (65 * 16)) & 1, dir = item / (65 * 32);
        SUBP_T0(20)
        float qs[4][4], lg[4][4], kk[4][4], cs[4][4];
#pragma unroll
        for (int i = 0; i < 4; ++i) if (hg_row(dir, b, ci, 4 * tg + i) < 0) { raw.q[i] = (u32x2){0u, 0u}; raw.l[i] = (u32x2){0u, 0u}; }
        if (hg_row(dir, b, ci, tv) < 0) { raw.v[0] = (u32x4){0u, 0u, 0u, 0u}; raw.v[1] = (u32x4){0u, 0u, 0u, 0u}; }
#pragma unroll
        for (int i = 0; i < 4; ++i) { qs[i][0] = bflo(raw.q[i].x); qs[i][1] = bfhi(raw.q[i].x); qs[i][2] = bflo(raw.q[i].y); qs[i][3] = bfhi(raw.q[i].y);
            lg[i][0] = bflo(raw.l[i].x); lg[i][1] = bfhi(raw.l[i].x); lg[i][2] = bflo(raw.l[i].y); lg[i][3] = bfhi(raw.l[i].y); }
#pragma unroll
        for (int i = 0; i < 4; ++i)
#pragma unroll
            for (int k = 0; k < 4; ++k) kk[i][k] = 1.0f - __expf(lg[i][k]);
#pragma unroll
        for (int k = 0; k < 4; ++k) { cs[0][k] = lg[0][k]; cs[1][k] = cs[0][k] + lg[1][k]; cs[2][k] = cs[1][k] + lg[2][k]; cs[3][k] = cs[2][k] + lg[3][k]; }
        *(LAS f32x4*)(TOT + tg * 128 + 4 * dg) = (f32x4){cs[3][0], cs[3][1], cs[3][2], cs[3][3]};
        { const unsigned vw[8] = {raw.v[0].x, raw.v[0].y, raw.v[0].z, raw.v[0].w, raw.v[1].x, raw.v[1].y, raw.v[1].z, raw.v[1].w};
#pragma unroll
          for (int k = 0; k < 8; ++k) { VTL[(16 * dvq + 2 * k) * 72 + tv] = (bf16_t)(vw[k] & 0xffffu); VTL[(16 * dvq + 2 * k + 1) * 72 + tv] = (bf16_t)(vw[k] >> 16); } }
        lds_barrier(); SUBP_T1(20) SUBP_T0(21)
        f32x4 pre = (f32x4){0.f, 0.f, 0.f, 0.f}, mid = pre, end = pre;
#pragma unroll
        for (int g = 0; g < 16; ++g) { const f32x4 t4 = *(const LAS f32x4*)(TOT + g * 128 + 4 * dg); if (g < tg) pre += t4; if (g < 8) mid += t4; end += t4; }
        if (item + G < 4160) hg1_load(P, item + G, tid, raw);
        bf16_t* qsg = QSG + (size_t)item * 8192; bf16_t* ksg = KSG + (size_t)item * 8192; bf16_t* vtg = VTG + (size_t)item * 8192;
        float qsv[4][4], qmv[4][4], kmv[4][4];
#pragma unroll
        for (int k = 0; k < 4; ++k) {
            const float emid = __expf(mid[k]), eem = __expf(end[k] - mid[k]);
            float ksv[4];
#pragma unroll
            for (int i = 0; i < 4; ++i) { const float Gc = pre[k] + cs[i][k]; const float e1 = __expf(Gc - mid[k]), e2 = __expf(mid[k] - Gc);
                const float qm = qs[i][k] * e1, km = kk[i][k] * e2; qmv[i][k] = qm; kmv[i][k] = km; qsv[i][k] = qm * emid; ksv[i] = km * eem; }
            *(LAS u32x2*)(KST + (4 * dg + k) * 72 + 4 * tg) = (u32x2){pk2(ksv[0], ksv[1]), pk2(ksv[2], ksv[3])};
            if (tg == 0) DECG[(size_t)item * 128 + 4 * dg + k] = emid * eem;
        }
#pragma unroll
        for (int i = 0; i < 4; ++i) { const int tau = 4 * tg + i;
            *(LAS u32x2*)(QM + tau * 136 + 4 * dg) = (u32x2){pk2(qmv[i][0], qmv[i][1]), pk2(qmv[i][2], qmv[i][3])};
            *(LAS u32x2*)(KM + tau * 136 + 4 * dg) = (u32x2){pk2(kmv[i][0], kmv[i][1]), pk2(kmv[i][2], kmv[i][3])};
            *(u32x2*)(qsg + tau * 128 + 4 * dg) = (u32x2){pk2(qsv[i][0], qsv[i][1]), pk2(qsv[i][2], qsv[i][3])}; }
        lds_barrier(); SUBP_T1(21) SUBP_T0(22)
        {
            const int dvt = wave & 3, tb = wave >> 2;
            f32x16 accO;
#pragma unroll
            for (int i = 0; i < 16; ++i) accO[i] = 0.f;
            for (int sb = 0; sb <= tb; ++sb) {
                f32x16 sT;
#pragma unroll
                for (int i = 0; i < 16; ++i) sT[i] = 0.f;
#pragma unroll
                for (int stp = 0; stp < 8; ++stp) { const bf16x8 a = *(const LAS bf16x8*)(KM + (32 * sb + r32) * 136 + 16 * stp + 8 * h); const bf16x8 bq = *(const LAS bf16x8*)(QM + (32 * tb + r32) * 136 + 16 * stp + 8 * h);
                    sT = __builtin_amdgcn_mfma_f32_32x32x16_bf16(a, bq, sT, 0, 0, 0); }
                if (sb == tb) {
#pragma unroll
                    for (int reg = 0; reg < 16; ++reg) { const int sl = (reg & 3) + 8 * (reg >> 2) + 4 * h; if (sl > r32) sT[reg] = 0.f; }
                }
#pragma unroll
                for (int st2 = 0; st2 < 2; ++st2) {
                    u32x4 pw; pw.x = pk2(sT[8 * st2 + 0], sT[8 * st2 + 1]); pw.y = pk2(sT[8 * st2 + 2], sT[8 * st2 + 3]); pw.z = pk2(sT[8 * st2 + 4], sT[8 * st2 + 5]); pw.w = pk2(sT[8 * st2 + 6], sT[8 * st2 + 7]);
                    const LAS bf16_t* vp = VTL + (32 * dvt + r32) * 72 + 32 * sb + 16 * st2 + 4 * h;
                    const u32x2 a0 = *(const LAS u32x2*)vp, a1 = *(const LAS u32x2*)(vp + 8);
                    const u32x4 aw = (u32x4){a0.x, a0.y, a1.x, a1.y};
                    accO = __builtin_amdgcn_mfma_f32_32x32x16_bf16(__builtin_bit_cast(bf16x8, aw), __builtin_bit_cast(bf16x8, pw), accO, 0, 0, 0);
                }
            }
            { LAS bf16_t* ot = (LAS bf16_t*)(lds + HG_OUT) + (32 * tb + r32) * 136 + 32 * dvt + 4 * h;
#pragma unroll
              for (int g4 = 0; g4 < 4; ++g4) *(LAS u32x2*)(ot + 8 * g4) = (u32x2){pk2(accO[4 * g4], accO[4 * g4 + 1]), pk2(accO[4 * g4 + 2], accO[4 * g4 + 3])}; }
#pragma unroll
            for (int j = 0; j < 2; ++j) { const int pc = tid + NTHR * j, rr = pc >> 3, ch = pc & 7;
                *(u32x4*)(ksg + rr * 64 + 8 * ch) = *(const LAS u32x4*)(KST + rr * 72 + 8 * ch); *(u32x4*)(vtg + rr * 64 + 8 * ch) = *(const LAS u32x4*)(VTL + rr * 72 + 8 * ch); }
        }
        lds_barrier(); SUBP_T1(22)
        { bf16_t* OB = (bf16_t*)(p.ws + WS_OBP) + (size_t)dir * MP * 2048;
#pragma unroll
          for (int j = 0; j < 2; ++j) { const int q = tid + NTHR * j, tau = q >> 4, c16 = q & 15; const int row = hg_row(dir, b, ci, tau);
              if (row >= 0) *(u32x4*)(OB + (size_t)row * 2048 + hd * 128 + 8 * c16) = *(const LAS u32x4*)(lds + HG_OUT + tau * 272 + 16 * c16); } }
    }
}
constexpr int HF_STB = 0, HF_SLOT0 = 34816, HF_QS = 0, HF_KST = 17408, HF_VT = 35840, HF_DEC = 54272, HF_SLOT = 54784, HF_OUT = HF_SLOT0 + 2 * HF_SLOT;
static_assert(HF_OUT + 64 * 272 <= MISC_OFF, "stage-2 LDS map");
__device__ __forceinline__ void hgrn_stage2f(const Params& p, LAS unsigned char* lds, int item, int tid, int wave, int lane) {
    const int hd = item & 15, b = (item >> 4) & 1, dir = item >> 5;
    const int r32 = lane & 31, h = lane >> 5, dvt = wave & 3, tb = wave >> 2; const size_t item0 = (size_t)(((dir * 2 + b) * 16 + hd) * 65);
    LAS bf16_t* STB = (LAS bf16_t*)(lds + HF_STB);
    for (int i = tid; i < 128 * 136 / 2; i += NTHR) ((LAS unsigned*)STB)[i] = 0u;
    f32x16 st0, st1;
#pragma unroll
    for (int i = 0; i < 16; ++i) { st0[i] = 0.f; st1[i] = 0.f; }
    u32x4 R[7], R2[7];
    const unsigned lqs = HF_QS + (tid >> 4) * 272 + 16 * (tid & 15), lk = (tid >> 3) * 144 + 16 * (tid & 7);
#define HF_LD(R, ci) do { if ((ci) < 65) { const size_t it_ = item0 + (ci); const bf16_t* q_ = (const bf16_t*)(p.ws + WS_QSG) + it_ * 8192 + 8 * tid; const bf16_t* k_ = (const bf16_t*)(p.ws + WS_KSG) + it_ * 8192 + 8 * tid; \
        const bf16_t* v_ = (const bf16_t*)(p.ws + WS_VTG) + it_ * 8192 + 8 * tid; \
        R[0] = *(const u32x4*)q_; R[1] = *(const u32x4*)(q_ + 4096); R[2] = *(const u32x4*)k_; R[3] = *(const u32x4*)(k_ + 4096); R[4] = *(const u32x4*)v_; R[5] = *(const u32x4*)(v_ + 4096); \
        if (tid < 32) R[6] = *(const u32x4*)((const float*)(p.ws + WS_DECG) + it_ * 128 + 4 * tid); } } while (0)
#define HF_ST(R, ci) do { if ((ci) < 65) { LAS unsigned char* sl_ = lds + HF_SLOT0 + ((ci) & 1) * HF_SLOT; \
        *(LAS u32x4*)(sl_ + lqs) = R[0]; *(LAS u32x4*)(sl_ + lqs + 32 * 272) = R[1]; *(LAS u32x4*)(sl_ + HF_KST + lk) = R[2]; *(LAS u32x4*)(sl_ + HF_KST + lk + 64 * 144) = R[3]; \
        *(LAS u32x4*)(sl_ + HF_VT + lk) = R[4]; *(LAS u32x4*)(sl_ + HF_VT + lk + 64 * 144) = R[5]; if (tid < 32) *(LAS u32x4*)(sl_ + HF_DEC + 16 * tid) = R[6]; } } while (0)
    HF_LD(R, 0); HF_ST(R, 0); HF_LD(R, 1); HF_LD(R2, 2);
    bf16_t* OB2 = (bf16_t*)(p.ws + WS_OBP) + (size_t)2 * MP * 2048 + (size_t)dir * MP * 2048;
    lds_barrier();
    auto step = [&](int ci, u32x4 (&RX)[7]) {
        const LAS unsigned char* slot = lds + HF_SLOT0 + (ci & 1) * HF_SLOT;
        HF_ST(RX, ci + 1);
        HF_LD(RX, ci + 3);
        {
            f32x16 accO;
#pragma unroll
            for (int i = 0; i < 16; ++i) accO[i] = 0.f;
            const LAS bf16_t* sbp = STB + (32 * dvt + r32) * 136 + 8 * h; const LAS bf16_t* qsl = (const LAS bf16_t*)(slot + HF_QS) + (32 * tb + r32) * 136 + 8 * h;
#pragma unroll
            for (int stp = 0; stp < 8; ++stp) accO = __builtin_amdgcn_mfma_f32_32x32x16_bf16(*(const LAS bf16x8*)(sbp + 16 * stp), *(const LAS bf16x8*)(qsl + 16 * stp), accO, 0, 0, 0);
            LAS bf16_t* ot = (LAS bf16_t*)(lds + HF_OUT) + (32 * tb + r32) * 136 + 32 * dvt + 4 * h;
#pragma unroll
            for (int g4 = 0; g4 < 4; ++g4) *(LAS u32x2*)(ot + 8 * g4) = (u32x2){pk2(accO[4 * g4], accO[4 * g4 + 1]), pk2(accO[4 * g4 + 2], accO[4 * g4 + 3])};
        }
        lds_barrier();
#pragma unroll
        for (int j = 0; j < 2; ++j) { const int q = tid + 512 * j, tau = q >> 4, c16 = q & 15; const int row = hg_row(dir, b, ci, tau);
            if (row >= 0) *(u32x4*)(OB2 + (size_t)row * 2048 + hd * 128 + 8 * c16) = *(const LAS u32x4*)(lds + HF_OUT + tau * 272 + 16 * c16); }
        {
            const LAS bf16_t* vtl = (const LAS bf16_t*)(slot + HF_VT) + (32 * dvt + r32) * 72 + 8 * h;
            const int db0 = 2 * tb; const LAS float* decp = (const LAS float*)(slot + HF_DEC) + 32 * db0 + 4 * h;
            const LAS bf16_t* ks0 = (const LAS bf16_t*)(slot + HF_KST) + (32 * db0 + r32) * 72 + 8 * h; const LAS bf16_t* ks1 = ks0 + 32 * 72;
#pragma unroll
            for (int g4 = 0; g4 < 4; ++g4) { const f32x4 d0 = *(const LAS f32x4*)(decp + 8 * g4), d1 = *(const LAS f32x4*)(decp + 32 + 8 * g4);
#pragma unroll
                for (int k = 0; k < 4; ++k) { st0[4 * g4 + k] *= d0[k]; st1[4 * g4 + k] *= d1[k]; } }
#pragma unroll
            for (int stp = 0; stp < 4; ++stp) { const bf16x8 bv = *(const LAS bf16x8*)(vtl + 16 * stp);
                st0 = __builtin_amdgcn_mfma_f32_32x32x16_bf16(*(const LAS bf16x8*)(ks0 + 16 * stp), bv, st0, 0, 0, 0); st1 = __builtin_amdgcn_mfma_f32_32x32x16_bf16(*(const LAS bf16x8*)(ks1 + 16 * stp), bv, st1, 0, 0, 0); }
            LAS bf16_t* srow = STB + (32 * dvt + r32) * 136 + 32 * db0 + 4 * h;
#pragma unroll
            for (int g4 = 0; g4 < 4; ++g4) { *(LAS u32x2*)(srow + 8 * g4) = (u32x2){pk2(st0[4 * g4], st0[4 * g4 + 1]), pk2(st0[4 * g4 + 2], st0[4 * g4 + 3])};
                *(LAS u32x2*)(srow + 32 + 8 * g4) = (u32x2){pk2(st1[4 * g4], st1[4 * g4 + 1]), pk2(st1[4 * g4 + 2], st1[4 * g4 + 3])}; }
        }
        lds_barrier();
    };
#pragma unroll 1
    for (int c2 = 0; c2 < 64; c2 += 2) { step(c2, R); step(c2 + 1, R2); }
    step(64, R);
#undef HF_LD
#undef HF_ST
}

typedef float f32x4v __attribute__((ext_vector_type(4)));
__device__ __forceinline__ void natten_item(const Params& p, LAS float* tbl, int item, int jl, int lane) {
    const bf16_t* P = (const bf16_t*)(p.ws + WS_P); const bf16_t* VT = (const bf16_t*)(p.ws + WS_VT); bf16_t* Y = (bf16_t*)(p.ws + WS_Y);
    const bool ismeta = item >= 8192;
    int b, hd, r, j;
    if (ismeta) { const int t = item - 8192; b = t >> 4; hd = t & 15; r = 0; j = 0; } else { j = item & 3; r = (item >> 2) & 63; hd = (item >> 8) & 15; b = item >> 12; }
    const int q16 = lane & 15, h4 = lane >> 4;
    const int qrow = ismeta ? 8192 + 16 * b + q16 : b * 4096 + 64 * r + 16 * j + q16;
    const int kw0 = (j == 0) ? 0 : (j == 1) ? 8 : (j == 2) ? 24 : 32;
    const int r0 = (r - 4 < 0) ? 0 : ((r - 4 > 56) ? 56 : r - 4);
    const float* rpb = p.in[I_RPB] + ((size_t)jl * 16 + hd) * 15 * 31; const float* mb = p.in[I_MBIAS] + ((size_t)jl * 16 + hd) * 16;
    { float tv[8];
#pragma unroll
      for (int k = 0; k < 8; ++k) { const int idx = lane + 64 * k; tv[k] = rpb[idx < 465 ? idx : 464]; }
#pragma unroll
      for (int k = 0; k < 8; ++k) tbl[lane + 64 * k] = tv[k]; }
    bf16x8 QF[4];
#pragma unroll
    for (int stp = 0; stp < 4; ++stp) QF[stp] = *(const bf16x8*)(P + (size_t)qrow * EIN + QA_OFF + hd * 128 + 32 * stp + 8 * h4);
    f32x4 S[17];
    auto rowbase = [&](int i) -> int { return b * 4096 + 64 * (r0 + i) + kw0; };
    auto keyrow = [&](int kt) -> int { if (kt == 0) return 8192 + 16 * b + q16; const int i = (kt - 1) >> 1, half = (kt - 1) & 1; return rowbase(i) + 8 * (q16 >> 2) + 4 * half + (q16 & 3); };
    {
        const bf16_t* kb = P + KA_OFF + hd * 128 + 8 * h4;
        bf16x8 KF[2][3][4];
#define NA_LDK(buf, bt) do { _Pragma("unroll") for (int t_ = 0; t_ < 3; ++t_) { const int kt_ = 3 * (bt) + t_; if (kt_ < 17) { const bf16_t* kp_ = kb + (size_t)keyrow(kt_) * EIN; \
            _Pragma("unroll") for (int stp = 0; stp < 4; ++stp) KF[buf][t_][stp] = *(const bf16x8*)(kp_ + 32 * stp); } } } while (0)
#define NA_MMK(buf, bt) do { _Pragma("unroll") for (int t_ = 0; t_ < 3; ++t_) { const int kt_ = 3 * (bt) + t_; if (kt_ < 17) { f32x4 s_ = (f32x4){0.f, 0.f, 0.f, 0.f}; \
            _Pragma("unroll") for (int stp = 0; stp < 4; ++stp) s_ = __builtin_amdgcn_mfma_f32_16x16x32_bf16(KF[buf][t_][stp], QF[stp], s_, 0, 0, 0); S[kt_] = s_; } } } while (0)
        NA_LDK(0, 0); __builtin_amdgcn_sched_barrier(0);
        NA_LDK(1, 1); __builtin_amdgcn_sched_barrier(0); NA_MMK(0, 0); __builtin_amdgcn_sched_barrier(0);
        NA_LDK(0, 2); __builtin_amdgcn_sched_barrier(0); NA_MMK(1, 1); __builtin_amdgcn_sched_barrier(0);
        NA_LDK(1, 3); __builtin_amdgcn_sched_barrier(0); NA_MMK(0, 2); __builtin_amdgcn_sched_barrier(0);
        NA_LDK(0, 4); __builtin_amdgcn_sched_barrier(0); NA_MMK(1, 3); __builtin_amdgcn_sched_barrier(0);
        NA_LDK(1, 5); __builtin_amdgcn_sched_barrier(0); NA_MMK(0, 4); __builtin_amdgcn_sched_barrier(0);
        NA_MMK(1, 5);
#undef NA_LDK
#undef NA_MMK
    }
    const int qc = 16 * j + q16; const int c0 = (qc - 8 < 0) ? 0 : ((qc - 8 > 48) ? 48 : qc - 8);
    float mx = -3.0e38f;
#pragma unroll
    for (int reg = 0; reg < 4; ++reg) { S[0][reg] += mb[4 * h4 + reg]; mx = fmaxf(mx, S[0][reg]); }
    float rb[16][4];
#pragma unroll
    for (int kt = 1; kt < 17; ++kt) { const int i = (kt - 1) >> 1, half = (kt - 1) & 1;
#pragma unroll
        for (int reg = 0; reg < 4; ++reg) { int ci = kw0 + 8 * h4 + 4 * half + reg - qc + 15; ci = ci < 0 ? 0 : (ci > 30 ? 30 : ci); rb[kt - 1][reg] = tbl[((r0 + i) - r + 7) * 31 + ci]; } }
    __builtin_amdgcn_sched_barrier(0);
#pragma unroll
    for (int kt = 1; kt < 17; ++kt) { const int half = (kt - 1) & 1;
#pragma unroll
        for (int reg = 0; reg < 4; ++reg) { const int kc = kw0 + 8 * h4 + 4 * half + reg; const bool ok = !ismeta && kc >= c0 && kc < c0 + 16;
            const float v = ok ? S[kt][reg] + rb[kt - 1][reg] : -3.0e38f; S[kt][reg] = v; mx = fmaxf(mx, v); } }
    mx = fmaxf(mx, __shfl_xor(mx, 16)); mx = fmaxf(mx, __shfl_xor(mx, 32));
    float sum = 0.f;
#pragma unroll
    for (int kt = 0; kt < 17; ++kt)
#pragma unroll
        for (int reg = 0; reg < 4; ++reg) { const float e = (S[kt][reg] > -1.0e38f) ? __expf(S[kt][reg] - mx) : 0.f; S[kt][reg] = e; sum += e; }
    sum += __shfl_xor(sum, 16); sum += __shfl_xor(sum, 32);
    const float inv = 1.0f / sum;
    f32x4 O[8];
#pragma unroll
    for (int dt = 0; dt < 8; ++dt) O[dt] = (f32x4){0.f, 0.f, 0.f, 0.f};
    u32x4 PW[9];
    PW[0].x = pk2(S[0][0], S[0][1]); PW[0].y = pk2(S[0][2], S[0][3]); PW[0].z = 0u; PW[0].w = 0u;
#pragma unroll
    for (int u = 1; u < 9; ++u) { const int k0t = 2 * u - 1, k1t = 2 * u;
        PW[u].x = pk2(S[k0t][0], S[k0t][1]); PW[u].y = pk2(S[k0t][2], S[k0t][3]); PW[u].z = pk2(S[k1t][0], S[k1t][1]); PW[u].w = pk2(S[k1t][2], S[k1t][3]); }
    {
        const bf16_t* vb = VT + (size_t)(hd * 128 + q16) * MP;
        u32x4 VF[4][8];
#define NA_LDV(buf, u) do { if ((u) == 0) { _Pragma("unroll") for (int dt = 0; dt < 8; ++dt) { const u32x2 m_ = *(const u32x2*)(vb + (size_t)(16 * dt) * MP + 8192 + 16 * b + 4 * h4); VF[buf][dt] = (u32x4){m_.x, m_.y, 0u, 0u}; } } \
        else { const int t0_ = rowbase((u) - 1) + 8 * h4; _Pragma("unroll") for (int dt = 0; dt < 8; ++dt) VF[buf][dt] = *(const u32x4*)(vb + (size_t)(16 * dt) * MP + t0_); } } while (0)
#define NA_MMV(buf, u) do { _Pragma("unroll") for (int dt = 0; dt < 8; ++dt) \
        O[dt] = __builtin_amdgcn_mfma_f32_16x16x32_bf16(__builtin_bit_cast(bf16x8, VF[buf][dt]), __builtin_bit_cast(bf16x8, PW[u]), O[dt], 0, 0, 0); } while (0)
        NA_LDV(0, 0); NA_LDV(1, 1); NA_LDV(2, 2); __builtin_amdgcn_sched_barrier(0);
        NA_LDV(3, 3); __builtin_amdgcn_sched_barrier(0); NA_MMV(0, 0); __builtin_amdgcn_sched_barrier(0);
        NA_LDV(0, 4); __builtin_amdgcn_sched_barrier(0); NA_MMV(1, 1); __builtin_amdgcn_sched_barrier(0);
        NA_LDV(1, 5); __builtin_amdgcn_sched_barrier(0); NA_MMV(2, 2); __builtin_amdgcn_sched_barrier(0);
        NA_LDV(2, 6); __builtin_amdgcn_sched_barrier(0); NA_MMV(3, 3); __builtin_amdgcn_sched_barrier(0);
        NA_LDV(3, 7); __builtin_amdgcn_sched_barrier(0); NA_MMV(0, 4); __builtin_amdgcn_sched_barrier(0);
        NA_LDV(0, 8); __builtin_amdgcn_sched_barrier(0); NA_MMV(1, 5); __builtin_amdgcn_sched_barrier(0);
        NA_MMV(2, 6); NA_MMV(3, 7); NA_MMV(0, 8);
#undef NA_LDV
#undef NA_MMV
    }
#pragma unroll
    for (int dt = 0; dt < 8; ++dt) { const int col = hd * 128 + 16 * dt + 4 * h4;
        const u32x2 g = *(const u32x2*)(P + (size_t)qrow * EIN + GATE_OFF + col);
        u32x2 w; w.x = pk2(O[dt][0] * inv * bflo(g.x), O[dt][1] * inv * bfhi(g.x)); w.y = pk2(O[dt][2] * inv * bflo(g.y), O[dt][3] * inv * bfhi(g.y));
        *(u32x2*)(Y + (size_t)qrow * D + col) = w; }
}
__device__ __forceinline__ void phase_combine(const Params& p, int jl, int gw, int NGW, int lane) {
    const bf16_t* OB0 = (const bf16_t*)(p.ws + WS_OBP); const bf16_t* OB1 = OB0 + (size_t)MP * 2048; const bf16_t* OB2 = OB0 + (size_t)2 * MP * 2048; const bf16_t* OB3 = OB0 + (size_t)3 * MP * 2048;
    const bf16_t* P = (const bf16_t*)(p.ws + WS_P); bf16_t* Y = (bf16_t*)(p.ws + WS_Y);
    const float* gain = p.in[I_HGNORM] + (size_t)jl * 2048;
    f32x4 gv[8];
#pragma unroll
    for (int k = 0; k < 8; ++k) gv[k] = *(const f32x4*)(gain + 32 * lane + 4 * k);
    u32x4 a8[4], b8[4], c8[4], d8[4], g8[4], an[4], bn[4], cn[4], dn[4], gn[4];
#define CB_LOAD(A, B, C, Dd, Gt, m) do { _Pragma("unroll") for (int k = 0; k < 4; ++k) { A[k] = *(const u32x4*)(OB0 + (size_t)(m) * 2048 + 32 * lane + 8 * k); B[k] = *(const u32x4*)(OB1 + (size_t)(m) * 2048 + 32 * lane + 8 * k); \
        C[k] = *(const u32x4*)(OB2 + (size_t)(m) * 2048 + 32 * lane + 8 * k); Dd[k] = *(const u32x4*)(OB3 + (size_t)(m) * 2048 + 32 * lane + 8 * k); \
        Gt[k] = *(const u32x4*)(P + (size_t)(m) * EIN + GATE_OFF + 2048 + 32 * lane + 8 * k); } } while (0)
    int m = gw;
    if (m < MV) CB_LOAD(a8, b8, c8, d8, g8, m);
    for (; m < MV; m += NGW) {
        if (m + NGW < MV) CB_LOAD(an, bn, cn, dn, gn, m + NGW);
        f32x4 o[8]; float ss = 0.f;
#pragma unroll
        for (int k = 0; k < 4; ++k) {
            o[2 * k] = (f32x4){(bflo(a8[k].x) + bflo(c8[k].x)) + (bflo(b8[k].x) + bflo(d8[k].x)), (bfhi(a8[k].x) + bfhi(c8[k].x)) + (bfhi(b8[k].x) + bfhi(d8[k].x)),
                               (bflo(a8[k].y) + bflo(c8[k].y)) + (bflo(b8[k].y) + bflo(d8[k].y)), (bfhi(a8[k].y) + bfhi(c8[k].y)) + (bfhi(b8[k].y) + bfhi(d8[k].y))};
            o[2 * k + 1] = (f32x4){(bflo(a8[k].z) + bflo(c8[k].z)) + (bflo(b8[k].z) + bflo(d8[k].z)), (bfhi(a8[k].z) + bfhi(c8[k].z)) + (bfhi(b8[k].z) + bfhi(d8[k].z)),
                                   (bflo(a8[k].w) + bflo(c8[k].w)) + (bflo(b8[k].w) + bflo(d8[k].w)), (bfhi(a8[k].w) + bfhi(c8[k].w)) + (bfhi(b8[k].w) + bfhi(d8[k].w))}; }
#pragma unroll
        for (int k = 0; k < 8; ++k) ss += (o[k].x * o[k].x + o[k].y * o[k].y) + (o[k].z * o[k].z + o[k].w * o[k].w);
        ss += __shfl_xor(ss, 1); ss += __shfl_xor(ss, 2);
        const float rstd = 1.0f / sqrtf(ss * (1.0f / 128.0f) + EPS);
#pragma unroll
        for (int k2 = 0; k2 < 4; ++k2) { const u32x4 g = g8[k2]; const f32x4 ga = gv[2 * k2], gb = gv[2 * k2 + 1]; const f32x4 a = o[2 * k2], bq = o[2 * k2 + 1];
            u32x4 w; w.x = pk2(a.x * rstd * ga.x * bflo(g.x), a.y * rstd * ga.y * bfhi(g.x)); w.y = pk2(a.z * rstd * ga.z * bflo(g.y), a.w * rstd * ga.w * bfhi(g.y));
            w.z = pk2(bq.x * rstd * gb.x * bflo(g.z), bq.y * rstd * gb.y * bfhi(g.z)); w.w = pk2(bq.z * rstd * gb.z * bflo(g.w), bq.w * rstd * gb.w * bfhi(g.w));
            *(u32x4*)(Y + (size_t)m * D + 2048 + 32 * lane + 8 * k2) = w; }
#pragma unroll
        for (int k = 0; k < 4; ++k) { a8[k] = an[k]; b8[k] = bn[k]; c8[k] = cn[k]; d8[k] = dn[k]; g8[k] = gn[k]; }
    }
#undef CB_LOAD
}
__device__ __forceinline__ void phase_postnorm(const Params& p, LAS unsigned char* lds, int layer, int vcu, int G, int tid, int wave, int lane) {
    const bf16_t* OUT = (const bf16_t*)(p.ws + WS_OUT); float* H = (float*)(p.ws + WS_H); bf16_t* HN = (bf16_t*)(p.ws + WS_HN);
    const bool last = (layer == 3); const int MR = last ? NB * T : MV;
    const f32x4* gp4 = (const f32x4*)(p.in[I_NPOST] + (size_t)layer * D) + 2 * tid; const f32x4* gq4 = (const f32x4*)(p.in[I_NPRE] + (size_t)(last ? 0 : layer + 1) * D) + 2 * tid;
    const f32x4 gpa = gp4[0], gpb = gp4[1], gqa = gq4[0], gqb = gq4[1];
    LAS float* RED = (LAS float*)lds;
    f32x4 oa[3], ob[3], ha[3], hb[3];
#define PN_LOAD(s, m) do { const u32x4 o8_ = *(const u32x4*)(OUT + (size_t)(m) * D + 8 * tid); const f32x4* h4_ = (const f32x4*)(H + (size_t)(m) * D) + 2 * tid; \
        oa[s] = (f32x4){bflo(o8_.x), bfhi(o8_.x), bflo(o8_.y), bfhi(o8_.y)}; ob[s] = (f32x4){bflo(o8_.z), bfhi(o8_.z), bflo(o8_.w), bfhi(o8_.w)}; ha[s] = h4_[0]; hb[s] = h4_[1]; } while (0)
#define PN_ROW(s, m, par) do { \
        float ss = (oa[s].x * oa[s].x + oa[s].y * oa[s].y) + (oa[s].z * oa[s].z + oa[s].w * oa[s].w) + (ob[s].x * ob[s].x + ob[s].y * ob[s].y) + (ob[s].z * ob[s].z + ob[s].w * ob[s].w); \
        ss = wave_sum(ss); if (lane == 0) RED[(par) * 8 + wave] = ss; lds_barrier(); \
        float tot = 0.f; _Pragma("unroll") for (int w = 0; w < 8; ++w) tot += RED[(par) * 8 + w]; \
        const float rstd = 1.0f / sqrtf(tot * (1.0f / D) + EPS); \
        const f32x4 na = ha[s] + oa[s] * rstd * gpa, nb = hb[s] + ob[s] * rstd * gpb; \
        if (last) { f32x4* d4_ = (f32x4*)(p.out + (size_t)(m) * D) + 2 * tid; d4_[0] = na; d4_[1] = nb; } \
        else { f32x4* d4_ = (f32x4*)(H + (size_t)(m) * D) + 2 * tid; d4_[0] = na; d4_[1] = nb; \
            float s2 = (na.x * na.x + na.y * na.y) + (na.z * na.z + na.w * na.w) + (nb.x * nb.x + nb.y * nb.y) + (nb.z * nb.z + nb.w * nb.w); \
            s2 = wave_sum(s2); if (lane == 0) RED[16 + (par) * 8 + wave] = s2; lds_barrier(); \
            float t2 = 0.f; _Pragma("unroll") for (int w = 0; w < 8; ++w) t2 += RED[16 + (par) * 8 + w]; \
            const float r2 = 1.0f / sqrtf(t2 * (1.0f / D) + EPS); \
            *(u32x4*)(HN + (size_t)(m) * D + 8 * tid) = (u32x4){pk2(na.x * r2 * gqa.x, na.y * r2 * gqa.y), pk2(na.z * r2 * gqa.z, na.w * r2 * gqa.w), pk2(nb.x * r2 * gqb.x, nb.y * r2 * gqb.y), pk2(nb.z * r2 * gqb.z, nb.w * r2 * gqb.w)}; } \
    } while (0)
    int m0 = vcu;
    if (m0 < MR) PN_LOAD(0, m0); if (m0 + G < MR) PN_LOAD(1, m0 + G);
    int par = 0;
    for (; m0 < MR; m0 += 3 * G) {
        if (m0 + 2 * G < MR) PN_LOAD(2, m0 + 2 * G);
        PN_ROW(0, m0, par); par ^= 1;
        if (m0 + G < MR) { if (m0 + 3 * G < MR) PN_LOAD(0, m0 + 3 * G); PN_ROW(1, m0 + G, par); par ^= 1; }
        if (m0 + 2 * G < MR) { if (m0 + 4 * G < MR) PN_LOAD(1, m0 + 4 * G); PN_ROW(2, m0 + 2 * G, par); par ^= 1; }
    }
#undef PN_LOAD
#undef PN_ROW
    lds_barrier();
}
constexpr int NW_META = 147456, NW_TBL = 151552;
static_assert(NW_TBL + 2048 <= MISC_OFF, "attention LDS map");
__device__ __forceinline__ int nw_fc(int c) { return (c & 3) | (((c >> 3) & 3) << 2); }

#define NW_FRESH(z) int z = 0; asm volatile("" : "+v"(z));
#define NW_ISSUE_K(sx) do { const int b_ = (sx) >> 9, hd_ = ((sx) >> 5) & 15, rp_ = (sx) & 31; const int R0_ = (2 * rp_ - 4 < 0) ? 0 : ((2 * rp_ - 4 > 56) ? 56 : 2 * rp_ - 4); \
    const bf16_t* kb_ = P + KA_OFF + hd_ * 128 + 8 * (tid & 15); \
    _Pragma("unroll") for (int k = 0; k < 18; ++k) { int row_ = R0_ + (k >> 1); row_ = row_ > 63 ? 63 : row_; \
        R[k] = *(const u32x4*)(kb_ + (size_t)(b_ * 4096 + 64 * row_ + 32 * (k & 1) + (tid >> 4)) * EIN); } \
    RM = *(const u32x4*)(kb_ + (size_t)(8192 + 16 * b_ + ((tid >> 4) & 15)) * EIN); \
    tv = p.in[I_RPB][((size_t)jl * 16 + hd_) * 465 + (tid < 465 ? tid : 464)]; } while (0)

__device__ __forceinline__ void natten_wg(const Params& p, LAS unsigned char* lds, int s0, int sstride, int send, int jl, int tid, int wave, int lane) {
    const bf16_t* P = (const bf16_t*)(p.ws + WS_P); const bf16_t* VT = (const bf16_t*)(p.ws + WS_VT); bf16_t* Y = (bf16_t*)(p.ws + WS_Y);
    if (s0 >= send) return;
    const int q16 = lane & 15, h4 = lane >> 4; const int rr = wave >> 2, j = wave & 3;
    const int kw0 = (j == 0) ? 0 : (j == 1) ? 8 : (j == 2) ? 24 : 32;
    u32x4 R[18]; u32x4 RM; float tv;
    NW_ISSUE_K(s0);
    for (int s = s0; s < send; s += sstride) {
        const int b = s >> 9, hd = (s >> 5) & 15, rp = s & 31;
        const int R0 = (2 * rp - 4 < 0) ? 0 : ((2 * rp - 4 > 56) ? 56 : 2 * rp - 4);
        const int r = 2 * rp + rr; const int r0 = (r - 4 < 0) ? 0 : ((r - 4 > 56) ? 56 : r - 4); const int so = r0 - R0;
        const int qrow = b * 4096 + 64 * r + 16 * j + q16;
        const float* mb = p.in[I_MBIAS] + ((size_t)jl * 16 + hd) * 16;
        bf16x8 QF[4];
#pragma unroll
        for (int stp = 0; stp < 4; ++stp) QF[stp] = *(const bf16x8*)(P + (size_t)qrow * EIN + QA_OFF + hd * 128 + 32 * stp + 8 * h4);
        { const int g = tid & 15, c0_ = tid >> 4;
          NW_FRESH(z_) LAS unsigned char* w0 = lds + z_ + c0_ * 256 + 16 * (g ^ nw_fc(c0_)); LAS unsigned char* w1 = w0 + 65536; LAS unsigned char* w2 = w0 + 131072;
#pragma unroll
          for (int k = 0; k < 18; ++k) *(LAS u32x4*)((k < 8 ? w0 : k < 16 ? w1 : w2) + 8192 * (k & 7)) = R[k];
          if (tid < 256) *(LAS u32x4*)(w2 + (NW_META - 131072) + 16 * ((g ^ c0_) - (g ^ nw_fc(c0_)))) = RM;
          if (tid < 465) *(LAS float*)(lds + z_ + NW_TBL + 4 * tid) = tv; }
        lds_barrier();
        f32x4 S[17];
        { NW_FRESH(zs_)
            { f32x4 s_ = (f32x4){0.f, 0.f, 0.f, 0.f};
#pragma unroll
              for (int stp = 0; stp < 4; ++stp) { const u32x4 kf = *(const LAS u32x4*)(lds + zs_ + NW_META + q16 * 256 + 16 * ((4 * stp + h4) ^ q16));
                  s_ = __builtin_amdgcn_mfma_f32_16x16x32_bf16(__builtin_bit_cast(bf16x8, kf), QF[stp], s_, 0, 0, 0); }
              S[0] = s_; }
            const int cb = kw0 + 8 * (q16 >> 2) + (q16 & 3); const int fcv = nw_fc(cb);
            const LAS unsigned char* kbase = lds + zs_ + (so * 64 + cb) * 256;
            const LAS unsigned char* kx[4];
#pragma unroll
            for (int stp = 0; stp < 4; ++stp) kx[stp] = kbase + 16 * ((4 * stp + h4) ^ fcv);
#pragma unroll
            for (int kt = 1; kt < 17; ++kt) { const int i = (kt - 1) >> 1, half = (kt - 1) & 1; f32x4 s_ = (f32x4){0.f, 0.f, 0.f, 0.f};
                if (kt == 9) {
#pragma unroll
                    for (int stp = 0; stp < 4; ++stp) { kx[stp] += 65536; asm volatile("" : "+v"(kx[stp])); } }
#pragma unroll
                for (int stp = 0; stp < 4; ++stp) { const u32x4 kf = *(const LAS u32x4*)(kx[stp] + (i * 64 + 4 * half) * 256 - (kt >= 9 ? 65536 : 0));
                    s_ = __builtin_amdgcn_mfma_f32_16x16x32_bf16(__builtin_bit_cast(bf16x8, kf), QF[stp], s_, 0, 0, 0); }
                S[kt] = s_; if ((kt & 1) == 0) __builtin_amdgcn_sched_barrier(0); }
        }
        { const bf16_t* vb_ = VT + (size_t)(hd * 128 + (tid >> 3)) * MP + b * 4096 + 8 * (tid & 7);
#pragma unroll
          for (int k = 0; k < 18; ++k) { int row_ = R0 + (k >> 1); row_ = row_ > 63 ? 63 : row_; R[k] = *(const u32x4*)(vb_ + (size_t)(64 * (k & 1)) * MP + 64 * row_); }
          RM = *(const u32x4*)(VT + (size_t)(hd * 128 + ((tid >> 1) & 127)) * MP + 8192 + 16 * b + 8 * (tid & 1)); }
        const int qc = 16 * j + q16; const int c0 = (qc - 8 < 0) ? 0 : ((qc - 8 > 48) ? 48 : qc - 8);
        float mx = -3.0e38f;
        NW_FRESH(zt_) const LAS float* tblz = (const LAS float*)(lds + zt_ + NW_TBL);
#pragma unroll
        for (int reg = 0; reg < 4; ++reg) { S[0][reg] += mb[4 * h4 + reg]; mx = fmaxf(mx, S[0][reg]); }
#pragma unroll
        for (int kt = 1; kt < 17; ++kt) { const int i = (kt - 1) >> 1, half = (kt - 1) & 1;
#pragma unroll
            for (int reg = 0; reg < 4; ++reg) { const int kc = kw0 + 8 * h4 + 4 * half + reg; int ci = kc - qc + 15; ci = ci < 0 ? 0 : (ci > 30 ? 30 : ci);
                const float rbv = tblz[((r0 + i) - r + 7) * 31 + ci]; const bool ok = kc >= c0 && kc < c0 + 16;
                const float v = ok ? S[kt][reg] + rbv : -3.0e38f; S[kt][reg] = v; mx = fmaxf(mx, v); }
            if ((kt & 3) == 0) __builtin_amdgcn_sched_barrier(0); }
        mx = fmaxf(mx, __shfl_xor(mx, 16)); mx = fmaxf(mx, __shfl_xor(mx, 32));
        float sum = 0.f;
#pragma unroll
        for (int kt = 0; kt < 17; ++kt)
#pragma unroll
            for (int reg = 0; reg < 4; ++reg) { const float e = (S[kt][reg] > -1.0e38f) ? __expf(S[kt][reg] - mx) : 0.f; S[kt][reg] = e; sum += e; }
        sum += __shfl_xor(sum, 16); sum += __shfl_xor(sum, 32);
        const float inv = 1.0f / sum;
        u32x4 PW[9];
        PW[0].x = pk2(S[0][0], S[0][1]); PW[0].y = pk2(S[0][2], S[0][3]); PW[0].z = 0u; PW[0].w = 0u;
#pragma unroll
        for (int u = 1; u < 9; ++u) { const int k0t = 2 * u - 1, k1t = 2 * u;
            PW[u].x = pk2(S[k0t][0], S[k0t][1]); PW[u].y = pk2(S[k0t][2], S[k0t][3]); PW[u].z = pk2(S[k1t][0], S[k1t][1]); PW[u].w = pk2(S[k1t][2], S[k1t][3]); }
        lds_barrier();
        { const int gk = tid & 7, dv0 = tid >> 3;
          NW_FRESH(z_) LAS unsigned char* w0 = lds + z_ + dv0 * 128 + 16 * (gk ^ ((dv0 >> 1) & 7)); LAS unsigned char* w1 = w0 + 65536; LAS unsigned char* w2 = w0 + 131072;
#pragma unroll
          for (int k = 0; k < 18; ++k) *(LAS u32x4*)((k < 8 ? w0 : k < 16 ? w1 : w2) + 8192 * (k & 7)) = R[k];
          if (tid < 256) *(LAS u32x4*)(lds + z_ + NW_META + 16 * tid) = RM; }
        lds_barrier();
        if (s + sstride < send) NW_ISSUE_K(s + sstride);
        f32x4 O[8];
#pragma unroll
        for (int dt = 0; dt < 8; ++dt) O[dt] = (f32x4){0.f, 0.f, 0.f, 0.f};
        { NW_FRESH(zv_)
#pragma unroll
            for (int dt = 0; dt < 8; ++dt) { const u32x2 m_ = *(const LAS u32x2*)(lds + zv_ + NW_META + (16 * dt + q16) * 32 + 8 * h4);
                O[dt] = __builtin_amdgcn_mfma_f32_16x16x32_bf16(__builtin_bit_cast(bf16x8, (u32x4){m_.x, m_.y, 0u, 0u}), __builtin_bit_cast(bf16x8, PW[0]), O[dt], 0, 0, 0); }
            const LAS unsigned char* vbase = lds + zv_ + so * 16384 + q16 * 128 + 16 * (((kw0 >> 3) + h4) ^ ((q16 >> 1) & 7));
#pragma unroll
            for (int u = 1; u < 9; ++u) {
                if (u == 5) { vbase += 65536; asm volatile("" : "+v"(vbase)); }
#pragma unroll
                for (int dt = 0; dt < 8; ++dt) { const u32x4 vf = *(const LAS u32x4*)(vbase + (u - 1) * 16384 + dt * 2048 - (u >= 5 ? 65536 : 0));
                    O[dt] = __builtin_amdgcn_mfma_f32_16x16x32_bf16(__builtin_bit_cast(bf16x8, vf), __builtin_bit_cast(bf16x8, PW[u]), O[dt], 0, 0, 0); }
                __builtin_amdgcn_sched_barrier(0); }
        }
#pragma unroll
        for (int dt = 0; dt < 8; ++dt) { const int col = hd * 128 + 16 * dt + 4 * h4;
            const u32x2 g = *(const u32x2*)(P + (size_t)qrow * EIN + GATE_OFF + col);
            u32x2 w; w.x = pk2(O[dt][0] * inv * bflo(g.x), O[dt][1] * inv * bfhi(g.x)); w.y = pk2(O[dt][2] * inv * bflo(g.y), O[dt][3] * inv * bfhi(g.y));
            *(u32x2*)(Y + (size_t)qrow * D + col) = w; }
        lds_barrier();
    }
}
#undef NW_ISSUE_K
#undef NW_FRESH
constexpr int LC_KCS = 16704;
constexpr int LC_KC = 0, LC_U1 = 4 * LC_KCS  , LC_US = 20480, LC_U2 = LC_U1 + LC_US, LC_X1 = LC_U2 + LC_US  , LC_XS = 16512, LC_X2 = LC_X1 + LC_XS, LC_TAIL = LC_X2 + LC_XS  , LC_END = LC_TAIL + 256;
static_assert(LC_END <= MISC_OFF, "long-conv LDS map");
__device__ __forceinline__ int lc_ugran(int b, int G) { return b * 10240 + (G & 3) * 2560 + (G >> 2) * 16; }
__device__ __forceinline__ int lc_tokrow(int b, int l) { return l < 16 ? 8192 + 16 * b + l : b * 4096 + l - 16; }
struct LcRaw { u32x4 mid; unsigned left, right; };
__device__ __forceinline__ void lc_load_raw(const bf16_t* urow, int b, int gl, LcRaw& r) {
    const int l0 = 8 * gl; r.mid = *(const u32x4*)(urow + lc_tokrow(b, l0));
    r.left = urow[lc_tokrow(b, l0 > 0 ? l0 - 1 : 0)]; r.right = urow[lc_tokrow(b, l0 + 8 < L ? l0 + 8 : L - 1)];
}
__device__ __forceinline__ void lc_load_raw_x(const bf16_t* urow, int b, int gl, int lane, LcRaw& r) {
    const int l0 = 8 * gl; r.mid = *(const u32x4*)(urow + lc_tokrow(b, l0));
    unsigned edge = 0u;
    if (lane == 0 || lane == 63) edge = urow[lc_tokrow(b, lane == 0 ? l0 - 1 : (l0 + 8 < L ? l0 + 8 : L - 1))];
    r.left = edge; r.right = edge;
}
__device__ __forceinline__ void lc_fix_edges(LcRaw& r, int lane) {
    const unsigned up = (unsigned)__shfl_up((int)(r.mid.w >> 16), 1), dn = (unsigned)__shfl_down((int)(r.mid.x & 0xffffu), 1);
    if (lane != 0) r.left = up; if (lane != 63) r.right = dn;
}
__device__ __forceinline__ u32x4 lc_conv3(const LcRaw& r, int gl, float w0, float w1, float w2) {
    float x[10]; x[0] = (gl > 0) ? bf1((bf16_t)r.left) : 0.f; x[9] = (8 * gl + 8 < L) ? bf1((bf16_t)r.right) : 0.f;
    x[1] = bflo(r.mid.x); x[2] = bfhi(r.mid.x); x[3] = bflo(r.mid.y); x[4] = bfhi(r.mid.y); x[5] = bflo(r.mid.z); x[6] = bfhi(r.mid.z); x[7] = bflo(r.mid.w); x[8] = bfhi(r.mid.w);
    float o[8];
#pragma unroll
    for (int k = 0; k < 8; ++k) o[k] = w0 * x[k] + w1 * x[k + 1] + w2 * x[k + 2];
    return (u32x4){pk2(o[0], o[1]), pk2(o[2], o[3]), pk2(o[4], o[5]), pk2(o[6], o[7])};
}
struct LcFilt { u32x4 a[3]; u32x2 n[3]; };
__device__ __forceinline__ void lc_load_filter(const bf16_t* krow, int tid, LcFilt& f) {
#pragma unroll
    for (int j = 0; j < 3; ++j) { const int m = tid + NTHR * j; const int mc = m < KLEN / 8 ? m : KLEN / 8 - 1, mn = mc + 1 < KLEN / 8 ? mc + 1 : KLEN / 8 - 1;
        f.a[j] = *(const u32x4*)(krow + 8 * mc); f.n[j] = *(const u32x2*)(krow + 8 * mn); }
}
__device__ __forceinline__ void lc_store_filter(const LcFilt& f, LAS unsigned char* lds, int tid) {
#pragma unroll
    for (int j = 0; j < 3; ++j) { const int m = tid + NTHR * j;
        if (m < KLEN / 8) { const bool lastc = (m + 1 >= KLEN / 8); const unsigned w[6] = {f.a[j].x, f.a[j].y, f.a[j].z, f.a[j].w, lastc ? 0u : f.n[j].x, lastc ? 0u : f.n[j].y};
            *(LAS u32x4*)(lds + LC_KC + 0 * LC_KCS + 16 * m) = (u32x4){__builtin_amdgcn_alignbit(w[1], w[0], 16), __builtin_amdgcn_alignbit(w[2], w[1], 16), __builtin_amdgcn_alignbit(w[3], w[2], 16), __builtin_amdgcn_alignbit(w[4], w[3], 16)};
            *(LAS u32x4*)(lds + LC_KC + 1 * LC_KCS + 16 * m) = (u32x4){w[1], w[2], w[3], w[4]};
            *(LAS u32x4*)(lds + LC_KC + 2 * LC_KCS + 16 * m) = (u32x4){__builtin_amdgcn_alignbit(w[2], w[1], 16), __builtin_amdgcn_alignbit(w[3], w[2], 16), __builtin_amdgcn_alignbit(w[4], w[3], 16), __builtin_amdgcn_alignbit(w[5], w[4], 16)};
            *(LAS u32x4*)(lds + LC_KC + 3 * LC_KCS + 16 * m) = (u32x4){w[2], w[3], w[4], w[5]}; } }
}
template <int VAR = 0> __device__ __forceinline__ void lc_conv(LAS unsigned char* lds, int uin_off, int wave, int lane, f32x16& accm) {
    const int g = wave; const int i32 = lane & 31, h = lane >> 5, n16 = lane & 15, b = (lane >> 4) & 1;
    const int e0 = 32 * g - 257;
    const int p0 = KOFF - 16 * e0 - i32 + 8 * h; const int sh = ((p0 - 1) & 3) + 1; const int q0 = p0 - sh;
    const LAS unsigned char* kpA = lds + LC_KC + (sh - 1) * LC_KCS + 2 * q0;
    const int I = 16 * g + n16;
    const int G0 = 4 * I - 2 * e0 + h + 60, G1 = G0 - 2;
    const LAS unsigned char* up0 = lds + uin_off + lc_ugran(b, G0); const LAS unsigned char* up1 = lds + uin_off + lc_ugran(b, G1);
    f32x16 acc0, acc1;
#pragma unroll
    for (int r = 0; r < 16; ++r) { acc0[r] = 0.f; acc1[r] = 0.f; }
    u32x2 fa[4], fb[4]; u32x4 fu[4];
    if (VAR != 0) { for (int j = 0; j < 4; ++j) { fa[j] = (u32x2){0u, 0u}; fb[j] = (u32x2){0u, 0u}; fu[j] = (u32x4){0u, 0u, 0u, 0u}; } }
    unsigned ka = (unsigned)(size_t)kpA - 96u, u0 = (unsigned)(size_t)up0 - 16u, u1 = (unsigned)(size_t)up1 - 16u;
#define LC_LD(j, jo, ko, uo) do { if (VAR == 0) asm volatile("ds_read_b64 %0, %3 offset:" #ko "\n\tds_read_b64 %1, %3 offset:" #ko "+8\n\tds_read_b128 %2, %4 offset:" #uo \
        : "=v"(fa[j]), "=v"(fb[j]), "=v"(fu[j]) : "v"(ka), "v"(((jo) & 1) ? u1 : u0) : "memory"); \
        else if (VAR == 1) asm volatile("ds_read_b64 %0, %2 offset:" #ko "\n\tds_read_b64 %1, %2 offset:" #ko "+8" : "=v"(fa[j]), "=v"(fb[j]) : "v"(ka) : "memory"); } while (0)
#define LC_WAIT(n, j) do { if (VAR == 0) asm volatile("s_waitcnt lgkmcnt(" #n ")" : "+v"(fa[j]), "+v"(fb[j]), "+v"(fu[j])); else if (VAR == 1) asm volatile("s_waitcnt lgkmcnt(" #n "*2/3)" : "+v"(fa[j]), "+v"(fb[j]), "+v"(fu[j])); else asm volatile("" : "+v"(fa[j]), "+v"(fb[j]), "+v"(fu[j])); } while (0)
#define LC_MM(j, acc) acc = __builtin_amdgcn_mfma_f32_32x32x16_bf16(__builtin_bit_cast(bf16x8, (u32x4){fa[j].x, fa[j].y, fb[j].x, fb[j].y}), __builtin_bit_cast(bf16x8, fu[j]), acc, 0, 0, 0)
    LC_LD(0, 0, 96, 16); LC_LD(1, 1, 64, 16); LC_LD(2, 2, 32, 0); LC_LD(3, 3, 0, 0);
    for (int k = 0; k < 71; ++k) {
        ka -= 128u; u0 -= 32u; u1 -= 32u;
        LC_WAIT(9, 0); LC_MM(0, acc0); LC_LD(0, 0, 96, 16);
        LC_WAIT(9, 1); LC_MM(1, acc1); LC_LD(1, 1, 64, 16);
        LC_WAIT(9, 2); LC_MM(2, acc0); LC_LD(2, 2, 32, 0);
        LC_WAIT(9, 3); LC_MM(3, acc1); LC_LD(3, 3, 0, 0);
    }
    LC_WAIT(9, 0); LC_MM(0, acc0); LC_WAIT(6, 1); LC_MM(1, acc1); LC_WAIT(3, 2); LC_MM(2, acc0); LC_WAIT(0, 3); LC_MM(3, acc1);
#undef LC_LD
#undef LC_WAIT
#undef LC_MM
    accm = acc0 + acc1;
    {
        const int h4 = lane >> 4; f32x4 t = (f32x4){0.f, 0.f, 0.f, 0.f};
        const int s_lo = 17 * wave, s_hi = (s_lo + 17 < 129) ? s_lo + 17 : 129;
        const int pt = 32 - n16 + 8 * h4; const int st_ = ((pt - 1) & 3) + 1; const LAS unsigned char* kt = lds + LC_KC + (st_ - 1) * LC_KCS + 2 * (pt - st_);
        const LAS unsigned char* ut = lds + uin_off + (n16 & 1) * 10240 + h4 * 2560 + 16 * 15;
        for (int s = s_lo; s < s_hi; ++s) {
            const u32x2 a0 = *(const LAS u32x2*)(kt + 64 * s), a1 = *(const LAS u32x2*)(kt + 64 * s + 8);
            u32x4 bw = *(const LAS u32x4*)(ut + 16 * s); if (n16 >= 2) bw = (u32x4){0u, 0u, 0u, 0u};
            t = __builtin_amdgcn_mfma_f32_16x16x32_bf16(__builtin_bit_cast(bf16x8, (u32x4){a0.x, a0.y, a1.x, a1.y}), __builtin_bit_cast(bf16x8, bw), t, 0, 0, 0);
        }
        if (n16 < 2) { LAS float* tl = (LAS float*)(lds + LC_TAIL) + n16 * 16 + 4 * h4;
#pragma unroll
            for (int r = 0; r < 4; ++r) (void)__hip_atomic_fetch_add(tl + r, t[r], __ATOMIC_RELAXED, __HIP_MEMORY_SCOPE_WORKGROUP); }
    }
}
__device__ __forceinline__ void lc_item(int tid, int j, int& b, int& gl) { if (j < 2) { b = j; gl = 2 + tid; } else { b = (tid >> 1) & 1; gl = tid & 1; } }
__device__ __forceinline__ void phase_longconv(const Params& p, LAS unsigned char* lds, int jl, int vcu, int G, int tid, int wave, int lane) {
    const bf16_t* UT = (const bf16_t*)(p.ws + WS_P); bf16_t* YT = (bf16_t*)(p.ws + WS_YT); const bf16_t* KT = (const bf16_t*)(p.ws + WS_KT);
    const float* wsh = p.in[I_HYSHORT] + (size_t)jl * 3 * 4096 * 3; const float* hb = p.in[I_HYBIAS] + (size_t)jl * 2 * 4096;
    for (int i = tid; i < 2 * LC_US / 16; i += NTHR) *(LAS u32x4*)(lds + LC_U1 + 16 * i) = (u32x4){0u, 0u, 0u, 0u};
    const int h = lane >> 5, n16 = lane & 15, bl = (lane >> 4) & 1;
    LcRaw rv[3], r1[3], r2[3]; LcFilt flt; float wv[9], nb0 = 0.f, nb1 = 0.f, nb0n = 0.f, nb1n = 0.f;
    auto load_channel = [&](int c) {
#pragma unroll
        for (int k = 0; k < 3; ++k) { wv[k] = wsh[c * 3 + k]; wv[3 + k] = wsh[(4096 + c) * 3 + k]; wv[6 + k] = wsh[(8192 + c) * 3 + k]; }
        nb0n = hb[c]; nb1n = hb[4096 + c];
#pragma unroll
        for (int j = 0; j < 2; ++j) { int b, gl; lc_item(tid, j, b, gl);
            lc_load_raw_x(UT + (size_t)c * MP, b, gl, lane, rv[j]); lc_load_raw_x(UT + (size_t)(4096 + c) * MP, b, gl, lane, r1[j]); lc_load_raw_x(UT + (size_t)(8192 + c) * MP, b, gl, lane, r2[j]); }
        if (tid < 4) { int b, gl; lc_item(tid, 2, b, gl);
            lc_load_raw(UT + (size_t)c * MP, b, gl, rv[2]); lc_load_raw(UT + (size_t)(4096 + c) * MP, b, gl, r1[2]); lc_load_raw(UT + (size_t)(8192 + c) * MP, b, gl, r2[2]); }
        lc_load_filter(KT + ((size_t)(jl * 2 + 0) * 4096 + c) * KLEN, tid, flt);
    };
    if (vcu < 4096) { load_channel(vcu); nb0 = nb0n; nb1 = nb1n; }
    lds_barrier();
    for (int c = vcu; c < 4096; c += G) {
        const bf16_t* grow = UT + (size_t)(12288 + c) * MP;
        const float bias0 = nb0, bias1 = nb1;
        SUBP_T0(10)
#pragma unroll
        for (int j = 0; j < 2; ++j) { lc_fix_edges(rv[j], lane); lc_fix_edges(r1[j], lane); lc_fix_edges(r2[j], lane); }
#pragma unroll
        for (int j = 0; j < 3; ++j) { if (j < 2 || tid < 4) { int b, gl; lc_item(tid, j, b, gl);
            *(LAS u32x4*)(lds + LC_U1 + lc_ugran(b, gl + 60)) = lc_conv3(rv[j], gl, wv[0], wv[1], wv[2]);
            *(LAS u32x4*)(lds + LC_X1 + b * 8224 + 16 * gl) = lc_conv3(r1[j], gl, wv[3], wv[4], wv[5]);
            *(LAS u32x4*)(lds + LC_X2 + b * 8224 + 16 * gl) = lc_conv3(r2[j], gl, wv[6], wv[7], wv[8]); } }
        lc_store_filter(flt, lds, tid);
        if (tid < 32) ((LAS float*)(lds + LC_TAIL))[tid] = 0.f;
        lc_load_filter(KT + ((size_t)(jl * 2 + 1) * 4096 + c) * KLEN, tid, flt);
        lds_barrier(); SUBP_T1(10)
        SUBP_T0(11)
        f32x16 acc;
#if MK_LCX
        { lc_conv<MK_LCX - 1>(lds, LC_U1, wave, lane, acc); asm volatile("" :: "v"(acc)); lds_barrier(); if (tid < 32) ((LAS float*)(lds + LC_TAIL))[tid] = 0.f; lds_barrier(); }
#endif
        lc_conv(lds, LC_U1, wave, lane, acc);
        lds_barrier(); SUBP_T1(11) SUBP_T0(12)
        {
            const int I = 16 * wave + n16;
#pragma unroll
            for (int rg = 0; rg < 4; ++rg) { const int t = 32 * I + 8 * rg + 4 * h; const int G8 = (t + 480) >> 3; const int uoff = lc_ugran(bl, G8) + 2 * (t & 7);
                const u32x2 uu = *(const LAS u32x2*)(lds + LC_U1 + uoff); const u32x2 xx = *(const LAS u32x2*)(lds + LC_X1 + bl * 8224 + 2 * t);
                const float z0 = bflo(xx.x) * (acc[4 * rg + 0] + bias0 * bflo(uu.x)), z1 = bfhi(xx.x) * (acc[4 * rg + 1] + bias0 * bfhi(uu.x));
                const float z2 = bflo(xx.y) * (acc[4 * rg + 2] + bias0 * bflo(uu.y)), z3 = bfhi(xx.y) * (acc[4 * rg + 3] + bias0 * bfhi(uu.y));
                *(LAS u32x2*)(lds + LC_U2 + uoff) = (u32x2){pk2(z0, z1), pk2(z2, z3)}; }
            if (tid < 32) { const int b = tid >> 4, i = tid & 15, t = 4096 + i; const int uoff = lc_ugran(b, (t + 480) >> 3) + 2 * (t & 7);
                const float u = bf1(*(const LAS bf16_t*)(lds + LC_U1 + uoff)), x = bf1(*(const LAS bf16_t*)(lds + LC_X1 + b * 8224 + 2 * t));
                const float y = ((LAS float*)(lds + LC_TAIL))[b * 16 + i];
                *(LAS bf16_t*)(lds + LC_U2 + uoff) = (bf16_t)f2bf(x * (y + bias0 * u)); }
        }
        lc_store_filter(flt, lds, tid);
        lds_barrier(); SUBP_T1(12) SUBP_T0(13)
        if (tid < 32) ((LAS float*)(lds + LC_TAIL))[tid] = 0.f;
        u32x2 gg[4]; bf16_t gtail = 0;
#pragma unroll
        for (int rg = 0; rg < 4; ++rg) gg[rg] = *(const u32x2*)(grow + lc_tokrow(bl, 32 * (16 * wave + n16) + 8 * rg + 4 * h));
        gtail = grow[lc_tokrow((tid >> 4) & 1, 4096 + (tid & 15))];
        if (c + G < 4096) load_channel(c + G);
        lds_barrier(); SUBP_T1(13) SUBP_T0(14)
        lc_conv(lds, LC_U2, wave, lane, acc);
        lds_barrier(); SUBP_T1(14) SUBP_T0(15)
        {
            const int I = 16 * wave + n16;
#pragma unroll
            for (int rg = 0; rg < 4; ++rg) { const int t = 32 * I + 8 * rg + 4 * h; const int G8 = (t + 480) >> 3; const int uoff = lc_ugran(bl, G8) + 2 * (t & 7);
                const u32x2 zz = *(const LAS u32x2*)(lds + LC_U2 + uoff); const u32x2 xx = *(const LAS u32x2*)(lds + LC_X2 + bl * 8224 + 2 * t);
                const int row = lc_tokrow(bl, t); const u32x2 g2 = gg[rg];
                const float o0 = bflo(xx.x) * (acc[4 * rg + 0] + bias1 * bflo(zz.x)) * bflo(g2.x), o1 = bfhi(xx.x) * (acc[4 * rg + 1] + bias1 * bfhi(zz.x)) * bfhi(g2.x);
                const float o2 = bflo(xx.y) * (acc[4 * rg + 2] + bias1 * bflo(zz.y)) * bflo(g2.y), o3 = bfhi(xx.y) * (acc[4 * rg + 3] + bias1 * bfhi(zz.y)) * bfhi(g2.y);
                *(u32x2*)(YT + (size_t)c * MP + row) = (u32x2){pk2(o0, o1), pk2(o2, o3)}; }
            if (tid < 32) { const int b = tid >> 4, i = tid & 15, t = 4096 + i; const int uoff = lc_ugran(b, (t + 480) >> 3) + 2 * (t & 7);
                const float z = bf1(*(const LAS bf16_t*)(lds + LC_U2 + uoff)), x = bf1(*(const LAS bf16_t*)(lds + LC_X2 + b * 8224 + 2 * t));
                const float y = ((LAS float*)(lds + LC_TAIL))[b * 16 + i]; const int row = lc_tokrow(b, t);
                YT[(size_t)c * MP + row] = (bf16_t)f2bf(x * (y + bias1 * z) * bf1(gtail)); }
        }
        asm volatile("" : "+v"(nb0n), "+v"(nb1n));
        nb0 = nb0n; nb1 = nb1n;
        lds_barrier(); SUBP_T1(15)
    }
}
__device__ __forceinline__ void phase_transpose(const Params& p, LAS unsigned char* lds, int gw, int NGW, int wave, int lane) {
    const bf16_t* YT = (const bf16_t*)(p.ws + WS_YT); bf16_t* Y = (bf16_t*)(p.ws + WS_Y);
    LAS bf16_t* tile = (LAS bf16_t*)(lds + wave * 8704);
    constexpr int NTT = MP / 64;
    for (int it = gw; it < (D / 64) * NTT; it += NGW) {
        const int ct = it / NTT, tt = it % NTT; const int c0 = 64 * ct, t0 = 64 * tt;
#pragma unroll
        for (int k = 0; k < 8; ++k) { const int cl = 8 * k + (lane >> 3), ch = lane & 7; const u32x4 v = *(const u32x4*)(YT + (size_t)(c0 + cl) * MP + t0 + 8 * ch);
            LAS unsigned* d = (LAS unsigned*)(tile + cl * 68 + 8 * ch); d[0] = v.x; d[1] = v.y; d[2] = v.z; d[3] = v.w; }
        LDS_WAIT(); asm volatile("" ::: "memory");
#pragma unroll
        for (int k = 0; k < 8; ++k) { const int tl = 8 * k + (lane >> 3), ch = lane & 7; const LAS bf16_t* s = tile + (8 * ch) * 68 + tl;
            u32x4 o; o.x = (unsigned)s[0] | ((unsigned)s[68] << 16); o.y = (unsigned)s[2 * 68] | ((unsigned)s[3 * 68] << 16); o.z = (unsigned)s[4 * 68] | ((unsigned)s[5 * 68] << 16); o.w = (unsigned)s[6 * 68] | ((unsigned)s[7 * 68] << 16);
            *(u32x4*)(Y + (size_t)(t0 + tl) * D + c0 + 8 * ch) = o; }
        LDS_WAIT(); asm volatile("" ::: "memory");
    }
}
constexpr int TG_ROWB = 528;
constexpr int TG_A = 0, TG_B = 32 * TG_ROWB, TG_BUF = 96 * TG_ROWB;
__device__ __forceinline__ void thin_gemm(const Params& p, LAS unsigned char* lds, int mode, int jp, const bf16_t* Ameta, const bf16_t* W, int N, int vcu, int G, int tid, int wave, int lane) {
    const int r32 = lane & 31, h = lane >> 5, nt = wave & 1, kq = wave >> 1; LAS float* RED = (LAS float*)lds;
    for (int nb = vcu; nb < N / 64; nb += G) {
        const int n0 = 64 * nb;
        u32x4 st[6];
#define TG_LOAD(kc) do { _Pragma("unroll") for (int j = 0; j < 6; ++j) { const int q_ = tid + NTHR * j; const int row_ = (q_ >> 5) & 63, col_ = q_ & 31; \
            const bf16_t* src_ = (j < 2) ? Ameta + (size_t)(q_ >> 5) * D : W + (size_t)(n0 + row_ - (j < 2 ? 0 : 0)) * D; \
            st[j] = *(const u32x4*)((j < 2 ? Ameta + (size_t)(q_ >> 5) * D : W + (size_t)(n0 + ((q_ - 1024) >> 5)) * D) + 256 * (kc) + 8 * col_); (void)src_; (void)row_; } } while (0)
#define TG_STORE(buf) do { _Pragma("unroll") for (int j = 0; j < 6; ++j) { const int q_ = tid + NTHR * j; const int col_ = q_ & 31; \
            const int off_ = (j < 2) ? TG_A + (q_ >> 5) * TG_ROWB : TG_B + ((q_ - 1024) >> 5) * TG_ROWB; *(LAS u32x4*)(lds + (buf) * TG_BUF + off_ + 16 * col_) = st[j]; } } while (0)
        f32x16 acc;
#pragma unroll
        for (int i = 0; i < 16; ++i) acc[i] = 0.f;
        TG_LOAD(0); TG_STORE(0); lds_barrier();
        for (int kc = 0; kc < 16; ++kc) {
            const int buf = kc & 1;
            if (kc + 1 < 16) TG_LOAD(kc + 1);
            const LAS unsigned char* ab = lds + buf * TG_BUF + TG_A + r32 * TG_ROWB + 128 * kq + 16 * h; const LAS unsigned char* bb = lds + buf * TG_BUF + TG_B + (32 * nt + r32) * TG_ROWB + 128 * kq + 16 * h;
#pragma unroll
            for (int s4 = 0; s4 < 4; ++s4) acc = __builtin_amdgcn_mfma_f32_32x32x16_bf16(*(const LAS bf16x8*)(ab + 32 * s4), *(const LAS bf16x8*)(bb + 32 * s4), acc, 0, 0, 0);
            if (kc + 1 < 16) TG_STORE(buf ^ 1);
            lds_barrier();
        }
#undef TG_LOAD
#undef TG_STORE
#pragma unroll
        for (int reg = 0; reg < 16; ++reg) RED[(wave * 32 + (reg & 3) + 8 * (reg >> 2) + 4 * h) * 33 + r32] = acc[reg];
        lds_barrier();
#pragma unroll
        for (int half = 0; half < 2; ++half) {
            const int nh0 = n0 + 32 * half;
            const int seg = (mode == 0) ? (nh0 >> 11) : 0; const bool transposed = (mode == 2) || (mode == 0 && seg == 2);
            float v[2]; int tok[2], nn[2];
#pragma unroll
            for (int k = 0; k < 2; ++k) { tok[k] = transposed ? 2 * (tid & 15) + k : (tid >> 4); nn[k] = transposed ? (tid >> 4) : 2 * (tid & 15) + k; float s = 0.f;
#pragma unroll
                for (int q4 = 0; q4 < 4; ++q4) s += RED[((2 * q4 + half) * 32 + tok[k]) * 33 + nn[k]];
                v[k] = s; }
            if (mode == 0) {
                const float* lb = (const float*)(p.ws + WS_LB) + (size_t)jp * 4096;
#pragma unroll
                for (int k = 0; k < 2; ++k) { const int n = nh0 + nn[k];
                    if (seg == 0) v[k] *= 0.08838834764831845f; else if (seg == 3) v[k] = pg8::silu_f(v[k]) * 0.08838834764831845f;
                    else if (seg == 5 || seg == 6) { const float x = fminf(fmaxf(v[k], -80.f), 80.f); const float sg = __builtin_amdgcn_rcpf(1.0f + __expf(-x)); const float l0 = lb[(seg - 5) * 2048 + (n & 2047)]; v[k] = __logf(l0 + (1.0f - l0) * sg); }
                    else if (seg >= 7) v[k] = pg8::silu_f(v[k]); }
                if (seg == 2) *(unsigned*)((bf16_t*)(p.ws + WS_VT) + (size_t)(nh0 - 4096 + nn[0]) * MP + 8192 + tok[0]) = pk2(v[0], v[1]);
                else *(unsigned*)((bf16_t*)(p.ws + WS_P) + (size_t)(8192 + tok[0]) * EIN + nh0 + nn[0]) = pk2(v[0], v[1]);
            } else if (mode == 1) {
                *(unsigned*)((bf16_t*)(p.ws + WS_OUT) + (size_t)(8192 + tok[0]) * D + nh0 + nn[0]) = pk2(v[0], v[1]);
            } else {
                if (nh0 >= 12288) { v[0] = pg8::silu_f(v[0]); v[1] = pg8::silu_f(v[1]); }
                *(unsigned*)((bf16_t*)(p.ws + WS_P) + (size_t)(nh0 + nn[0]) * MP + 8192 + tok[0]) = pk2(v[0], v[1]);
            }
        }
        lds_barrier();
    }
}
#define GEMM_ALIGN true
#define GEMM_SP2 true
__global__ void __launch_bounds__(NTHR, 2) mk_fwd(Params p) {
    extern __shared__ __attribute__((aligned(16))) unsigned char lds_raw[];
    LAS unsigned char* lds = (LAS unsigned char*)lds_raw;
    volatile LAS unsigned* MISC = (volatile LAS unsigned*)(lds + MISC_OFF);
    const int tid = threadIdx.x, lane = tid & 63, wave = __builtin_amdgcn_readfirstlane(tid >> 6);
    const int G = gridDim.x; const int bx = blockIdx.x; const int vcu = (G % 8 == 0) ? (bx % 8) * (G / 8) + bx / 8 : bx;
    const int gw = vcu * NWAVES + wave, NGW = G * NWAVES;
    unsigned char* ws = p.ws;
    for (int u = tid; u < (LDS_BYTES - MISC_OFF) / 4; u += NTHR) MISC[u] = 0u;
    __syncthreads();
    XcdBarrier bar; bar.bar = (unsigned*)(ws + WS_CTL) + CW_BAR; bar.x = 0; bar.st = nullptr;
#if !MK_PER_PHASE
    bar = xcd_barrier_post((unsigned*)(ws + WS_CTL) + CW_BAR, MISC);
#endif
    const int lo = p.ph_lo, hi = p.ph_hi;
#define FRESH() int tid_ = threadIdx.x; asm volatile("" : "+v"(tid_)); const int lane_ = tid_ & 63, wave_ = __builtin_amdgcn_readfirstlane(tid_ >> 6); \
    int vcu_ = vcu; asm volatile("" : "+s"(vcu_)); const int gw_ = vcu_ * NWAVES + wave_; Params q = p; { __attribute__((address_space(1))) unsigned char* w_ = (__attribute__((address_space(1))) unsigned char*)q.ws; asm volatile("" : "+s"(w_)); q.ws = (unsigned char*)w_; } unsigned char* ws_ = q.ws; (void)lane_; (void)gw_; (void)ws_;
#define IN(k) (lo <= (k) && (k) < hi)
#if MK_PER_PHASE
#define SEAM(k) do { } while (0)
#elif MK_TIME_MASK || MK_SUBPROBE
    unsigned long long t_prev = wall_clock64(), t_acc = 0;
#define SEAM(k) do { if (IN(k) && IN((k) + 1)) xcd_barrier(bar); { const unsigned long long now_ = wall_clock64(); if ((MK_TIME_MASK >> (k)) & 1u) t_acc += now_ - t_prev; t_prev = now_; } } while (0)
#else
#define SEAM(k) do { if (IN(k) && IN((k) + 1)) xcd_barrier(bar); } while (0)
#endif
    if (IN(0)) { FRESH() phase_prologue(q, lds, gw_, NGW, wave_, lane_); } SEAM(0);
    if (IN(1)) { FRESH() phase_filtergen(q, lds, gw_, NGW, wave_, lane_); } SEAM(1);
    for (int jp = 0; jp < 2; ++jp) {
        const int pb = 2 + 11 * jp;
        if (IN(pb + 0)) { FRESH() const bf16_t* HN = (const bf16_t*)(ws_ + WS_HN);
            const bf16_t* W = (const bf16_t*)(ws_ + WS_WEIN) + (size_t)jp * EIN * D;
            pg8::DualOrder S; S.init(HN, W, NB * T, EIN - 2048, W + (size_t)4096 * D, HN, 2048, NB * T, D, G, bx, 16, 8);
            pg8::EpiEvenIn E{(bf16_t*)(ws_ + WS_P), EIN, (bf16_t*)(ws_ + WS_VT), MP, (const float*)(ws_ + WS_LB) + (size_t)jp * 4096};
            pg8::gemm_phase<pg8::EpiEvenIn, pg8::DualOrder, GEMM_ALIGN, GEMM_SP2>(lds, D, S, E);
            SUBP_T0(3) thin_gemm(q, lds, 0, jp, HN + (size_t)NB * T * D, W, EIN, vcu_, G, tid_, wave_, lane_); SUBP_T1(3)
        } SEAM(pb + 0);
        if (IN(pb + 1)) { FRESH()
            SUBP_T0(1) hgrn_stage1(q, lds, vcu_, G, tid_, wave_, lane_); SUBP_T1(1)
        } SEAM(pb + 1);
        if (IN(pb + 2)) { FRESH()
            int bx_ = blockIdx.x, G_ = gridDim.x; asm volatile("" : "+s"(bx_), "+s"(G_));
            if (G_ >= 128) {
                if (bx_ < 64) { SUBP_T0(30) hgrn_stage2f(q, lds, bx_, tid_, wave_, lane_); SUBP_T1(30)
                    for (int it = 8192 + bx_ * NWAVES + wave_; it < 8192 + 32; it += 64 * NWAVES) natten_item(q, (LAS float*)(lds + wave_ * 2048), it, jp, lane_); }
                else { const int nw = G_ - 64, b2 = bx_ - 64; const bool xa = (nw & 7) == 0;
                    const int s0 = xa ? (b2 & 7) * 128 + (b2 >> 3) : b2, sst = xa ? (nw >> 3) : nw, sen = xa ? (b2 & 7) * 128 + 128 : 1024;
                    SUBP_T0(2) natten_wg(q, lds, s0, sst, sen, jp, tid_, wave_, lane_); SUBP_T1(2) }
            } else {
                for (int item = bx_; item < 64; item += G_) hgrn_stage2f(q, lds, item, tid_, wave_, lane_);
                for (int it = gw_; it < 8192 + 32; it += NGW) natten_item(q, (LAS float*)(lds + wave_ * 2048), it, jp, lane_);
            }
        } SEAM(pb + 2);
        if (IN(pb + 3)) { FRESH() phase_combine(q, jp, gw_, NGW, lane_); } SEAM(pb + 3);
        if (IN(pb + 4)) { FRESH()
            pg8::DualOrder S; S.init(ws_ + WS_Y, (const bf16_t*)(ws_ + WS_WEOUT) + (size_t)jp * D * D, NB * T, D, nullptr, nullptr, 0, 0, D, G, bx, 1 << 30, 0);
            pg8::EpiBf16Plain E{(bf16_t*)(ws_ + WS_OUT), D};
            pg8::gemm_phase<pg8::EpiBf16Plain, pg8::DualOrder, GEMM_ALIGN, GEMM_SP2>(lds, D, S, E);
            thin_gemm(q, lds, 1, jp, (const bf16_t*)(ws_ + WS_Y) + (size_t)NB * T * D, (const bf16_t*)(ws_ + WS_WEOUT) + (size_t)jp * D * D, D, vcu_, G, tid_, wave_, lane_);
        } SEAM(pb + 4);
        if (IN(pb + 5)) { FRESH() phase_postnorm(q, lds, 2 * jp, vcu_, G, tid_, wave_, lane_); } SEAM(pb + 5);
        if (IN(pb + 6)) { FRESH() const bf16_t* HN = (const bf16_t*)(ws_ + WS_HN);
            pg8::DualOrder S; S.init((const bf16_t*)(ws_ + WS_WOIN) + (size_t)jp * OIN * D, HN, OIN, NB * T, nullptr, nullptr, 0, 0, D, G, bx, 1 << 30, 0);
            pg8::EpiOddIn E{(bf16_t*)(ws_ + WS_P), MP, 48};
            pg8::gemm_phase<pg8::EpiOddIn, pg8::DualOrder, GEMM_ALIGN, GEMM_SP2>(lds, D, S, E);
            SUBP_T0(5) thin_gemm(q, lds, 2, jp, HN + (size_t)NB * T * D, (const bf16_t*)(ws_ + WS_WOIN) + (size_t)jp * OIN * D, OIN, vcu_, G, tid_, wave_, lane_); SUBP_T1(5)
        } SEAM(pb + 6);
        if (IN(pb + 7)) { FRESH() phase_longconv(q, lds, jp, vcu_, G, tid_, wave_, lane_); } SEAM(pb + 7);
        if (IN(pb + 8)) { FRESH() phase_transpose(q, lds, gw_, NGW, wave_, lane_); } SEAM(pb + 8);
        if (IN(pb + 9)) { FRESH()
            pg8::DualOrder S; S.init(ws_ + WS_Y, (const bf16_t*)(ws_ + WS_WOOUT) + (size_t)jp * D * D, NB * T, D, nullptr, nullptr, 0, 0, D, G, bx, 1 << 30, 0);
            pg8::EpiBf16Plain E{(bf16_t*)(ws_ + WS_OUT), D};
            pg8::gemm_phase<pg8::EpiBf16Plain, pg8::DualOrder, GEMM_ALIGN, GEMM_SP2>(lds, D, S, E);
            thin_gemm(q, lds, 1, jp, (const bf16_t*)(ws_ + WS_Y) + (size_t)NB * T * D, (const bf16_t*)(ws_ + WS_WOOUT) + (size_t)jp * D * D, D, vcu_, G, tid_, wave_, lane_);
        } SEAM(pb + 9);
        if (IN(pb + 10)) { FRESH() phase_postnorm(q, lds, 2 * jp + 1, vcu_, G, tid_, wave_, lane_); } SEAM(pb + 10);
    }
#if (MK_TIME_MASK || MK_SUBPROBE) && !MK_PER_PHASE
    if (blockIdx.x == 0) { __syncthreads(); const unsigned long long sub_ = ((unsigned long long)MISC[5] << 32) | MISC[4]; const unsigned long long t_end = wall_clock64(); while (wall_clock64() - t_end < (unsigned long long)MK_TIME_MULT * (t_acc + sub_)) __builtin_amdgcn_s_sleep(8); }
#endif
#undef IN
#undef SEAM
}

extern "C" void kernel_launch(void* const* d_in, const int* in_sizes, int n_in, void* d_out, int out_size, void* d_ws, size_t ws_size, hipStream_t stream) {
    static int grid = 0;
    if (grid == 0) {
        if (n_in != 21 || ws_size < WS_END) { fprintf(stderr, "kernel_launch: expected 21 inputs and >= %zu bytes of workspace; got %d, %zu\n", (size_t)WS_END, n_in, ws_size); grid = -1; return; }
        int dev = 0, cus = 0, per_cu = 0;
        if (hipGetDevice(&dev) != hipSuccess || hipDeviceGetAttribute(&cus, hipDeviceAttributeMultiprocessorCount, dev) != hipSuccess) { grid = -1; return; }
        if (hipFuncSetAttribute((const void*)mk_fwd, hipFuncAttributeMaxDynamicSharedMemorySize, LDS_BYTES) != hipSuccess) { fprintf(stderr, "kernel_launch: hipFuncSetAttribute failed\n"); grid = -1; return; }
        if (hipOccupancyMaxActiveBlocksPerMultiprocessor(&per_cu, (const void*)mk_fwd, NTHR, LDS_BYTES) != hipSuccess || per_cu < 1)
            fprintf(stderr, "kernel_launch: note: occupancy query reports %d workgroups per CU\n", per_cu);
        (void)hipGetLastError();
        grid = cus;
    }
    if (grid < 0) return;
    if (hipMemsetAsync((char*)d_ws + WS_CTL, 0, CTL_ZERO_BYTES, stream) != hipSuccess) return;
    Params a{};
    for (int i = 0; i < 21; ++i) a.in[i] = (const float*)d_in[i];
    a.out = (float*)d_out; a.ws = (unsigned char*)d_ws;
#if MK_PER_PHASE
    for (int ph = 0; ph < NPHASE; ++ph) { a.ph_lo = ph; a.ph_hi = ph + 1; hipLaunchKernelGGL(mk_fwd, dim3(grid), dim3(NTHR), LDS_BYTES, stream, a); }
#else
    a.ph_lo = 0; a.ph_hi = NPHASE; hipLaunchKernelGGL(mk_fwd, dim3(grid), dim3(NTHR), LDS_BYTES, stream, a);
#endif
    const hipError_t le = hipPeekAtLastError();
    if (le != hipSuccess) fprintf(stderr, "kernel_launch: launch failed: %s\n", hipGetErrorName(le));
}
```

```cpp
#include <hip/hip_runtime.h>
#include <cstdio>
#include <cstdint>
#ifndef MK_PER_PHASE
#define MK_PER_PHASE 0
#endif
#ifndef MK_TIME_MASK
#define MK_TIME_MASK 0u
#endif
#ifndef MK_TIME_MULT
#define MK_TIME_MULT 4
#endif
#ifndef MK_SUBPROBE
#define MK_SWAP 0
#define MK_SUBPROBE 0
#endif
#ifndef MK_LCX
#define MK_LCX 0
#endif
namespace pg8 {
#define PG8_LAS __attribute__((address_space(3)))
typedef unsigned short bf16_t;
typedef short bf16x8 __attribute__((ext_vector_type(8)));
typedef float f32x4 __attribute__((ext_vector_type(4)));
typedef unsigned u32x4 __attribute__((ext_vector_type(4)));
constexpr int BM = 256, BK = 64, HALF = 128, HTB = HALF * BK * 2  , STAGE_BYTES = 8 * HTB, NXCD = 8, WGM = 8;

__host__ __device__ __forceinline__ int lds_byte(int r, int c) { const int st = (r >> 4) * 2 + (c >> 5), rr = r & 15, cc = c & 31, ob = rr * 64 + cc * 2; return st * 1024 + (ob ^ (((ob >> 9) & 1) << 5)); }
__host__ __device__ __forceinline__ void stage_rc(int b, int& R, int& C) { const int st = b / 1024, sb = b % 1024, swz = sb ^ (((sb >> 9) & 1) << 5); R = (st >> 1) * 16 + swz / 64; C = (st & 1) * 32 + (swz % 64) / 2; }
__host__ __device__ __forceinline__ int perm32(int rho) { const int n = rho >> 4, i = rho & 15; return 8 * (i >> 2) + 4 * n + (i & 3); }

struct Unit { int pm, pn, kind; };

struct DualOrder {
    const char *A0, *B0, *A1, *B1; int nM0, nN0, n0, nM1, nN1, n1, G, c, skip_lo, skip_n; size_t tstep;
    __device__ void init(const void* a0, const void* b0, int M0, int N0, const void* a1, const void* b1, int M1, int N1, int K, int G_, int c_, int sl, int sn) {
        A0 = (const char*)a0; B0 = (const char*)b0; A1 = (const char*)a1; B1 = (const char*)b1; nM0 = M0 / BM; nN0 = N0 / BM; n0 = nM0 * nN0; nM1 = M1 / BM; nN1 = N1 / BM; n1 = nM1 * nN1;
        G = G_; c = c_; skip_lo = sl; skip_n = sn; tstep = (size_t)BM * K * 2; }
    __device__ bool next(int i, Unit& u) const {
        const long L = (long)i * G + c; const int nwg = n0 + n1; if (L >= nwg) return false;
        int wgid = (int)L; { const int q = nwg / NXCD, r = nwg % NXCD, xcd = wgid % NXCD, off = wgid / NXCD; wgid = (xcd < r ? xcd * (q + 1) : r * (q + 1) + (xcd - r) * q) + off; }
        int nM, nN, kind;
        if (wgid < n0) { nM = nM0; nN = nN0; kind = 0; } else { wgid -= n0; nM = nM1; nN = nN1; kind = 1; }
        const int nig = WGM * nN, gid = wgid / nig, fm = gid * WGM, gsz = (nM - fm) < WGM ? (nM - fm) : WGM;
        u.pm = fm + ((wgid % nig) % gsz); int pn = (wgid % nig) / gsz; if (kind == 0 && pn >= skip_lo) pn += skip_n; u.pn = pn; u.kind = kind; return true;
    }
    __device__ __forceinline__ const char* abase(const Unit& u) const { return (u.kind ? A1 : A0) + (size_t)u.pm * tstep; }
    __device__ __forceinline__ const char* bbase(const Unit& u) const { return (u.kind ? B1 : B0) + (size_t)u.pn * tstep; }
    __device__ __forceinline__ void a_ready(const Unit&) const {}
    __device__ __forceinline__ void done(const Unit&) const {}
};

typedef __bf16 bf16x2_t __attribute__((ext_vector_type(2)));
typedef float f32x2_t __attribute__((ext_vector_type(2)));
__device__ __forceinline__ unsigned cvt_pk_bf16(float lo, float hi) { const f32x2_t v = {lo, hi}; const bf16x2_t b = __builtin_convertvector(v, bf16x2_t); return __builtin_bit_cast(unsigned, b); }

struct EpiF32 {
    static constexpr bool PERM = false, AFTER_DRAIN = false;
    float* C; int ldc;
    __device__ __forceinline__ void operator()(const f32x4 (&acc)[2][2][4][2], const Unit& u, int wr, int wc, int fr, int fq) const {
        const int row0 = u.pm * BM + wr * 64 + fr, col0 = u.pn * BM + wc * 32 + 4 * fq;
#pragma unroll
        for (int ai = 0; ai < 2; ++ai)
#pragma unroll
            for (int m = 0; m < 4; ++m) { float* rowp = C + (size_t)(row0 + ai * HALF + m * 16) * ldc + col0;
#pragma unroll
                for (int bj = 0; bj < 2; ++bj)
#pragma unroll
                    for (int n = 0; n < 2; ++n) *(f32x4*)(rowp + bj * HALF + n * 16) = acc[ai][bj][m][n]; }
    }
};
struct EpiBf16Plain {
    static constexpr bool PERM = true, AFTER_DRAIN = false;
    bf16_t* O; int ldc;
    __device__ __forceinline__ void operator()(const f32x4 (&acc)[2][2][4][2], const Unit& u, int wr, int wc, int fr, int fq) const {
        const int row0 = u.pm * BM + wr * 64 + fr; const int col0 = u.pn * BM + wc * 32 + 8 * fq;
#pragma unroll
        for (int ai = 0; ai < 2; ++ai)
#pragma unroll
            for (int m = 0; m < 4; ++m) { bf16_t* rowp = O + (size_t)(row0 + ai * HALF + m * 16) * ldc + col0;
#pragma unroll
                for (int bj = 0; bj < 2; ++bj) { const f32x4 v0 = acc[ai][bj][m][0], v1 = acc[ai][bj][m][1];
                    u32x4 w; w.x = cvt_pk_bf16(v0[0], v0[1]); w.y = cvt_pk_bf16(v0[2], v0[3]); w.z = cvt_pk_bf16(v1[0], v1[1]); w.w = cvt_pk_bf16(v1[2], v1[3]);
                    *(u32x4*)(rowp + bj * HALF) = w; } }
    }
};
__device__ __forceinline__ float silu_f(float x) { return x * __builtin_amdgcn_rcpf(1.0f + __expf(-x)); }
struct EpiEvenIn {
    static constexpr bool PERM = true, AFTER_DRAIN = false;
    bf16_t* P; int ldp; bf16_t* VT; int ldv; const float* lb;
    __device__ __forceinline__ void operator()(const f32x4 (&acc)[2][2][4][2], const Unit& u, int wr, int wc, int fr, int fq) const {
        const int row0 = u.pm * BM + wr * 64 + fr; const int col0 = u.pn * BM + wc * 32 + 8 * fq;
        bf16_t* base = u.kind ? VT : P; const int ldc = u.kind ? ldv : ldp;
        const int seg = u.kind ? 1 : (u.pn >> 3);
        const int mode = (seg == 0) ? 1 : (seg == 3) ? 2 : (seg == 5 || seg == 6) ? 3 : (seg >= 7) ? 4 : 0;
        f32x4 lbv[2][2];
#pragma unroll
        for (int bj = 0; bj < 2; ++bj)
#pragma unroll
            for (int n = 0; n < 2; ++n) lbv[bj][n] = (mode == 3) ? *(const f32x4*)(lb + (seg - 5) * 2048 + ((col0 + bj * HALF + 4 * n) & 2047)) : (f32x4){0.f, 0.f, 0.f, 0.f};
#pragma unroll
        for (int ai = 0; ai < 2; ++ai)
#pragma unroll
            for (int m = 0; m < 4; ++m) { bf16_t* rowp = base + (size_t)(row0 + ai * HALF + m * 16) * ldc + col0;
#pragma unroll
                for (int bj = 0; bj < 2; ++bj) { f32x4 v[2] = {acc[ai][bj][m][0], acc[ai][bj][m][1]};
                    if (mode == 1) { v[0] = v[0] * 0.08838834764831845f; v[1] = v[1] * 0.08838834764831845f; }
                    else if (mode == 2) {
#pragma unroll
                        for (int n = 0; n < 2; ++n)
#pragma unroll
                            for (int k = 0; k < 4; ++k) v[n][k] = silu_f(v[n][k]) * 0.08838834764831845f; }
                    else if (mode == 3) {
#pragma unroll
                        for (int n = 0; n < 2; ++n)
#pragma unroll
                            for (int k = 0; k < 4; ++k) { const float x = fminf(fmaxf(v[n][k], -80.f), 80.f); const float sg = __builtin_amdgcn_rcpf(1.0f + __expf(-x)); const float l0 = lbv[bj][n][k];
                                v[n][k] = __logf(l0 + (1.0f - l0) * sg); } }
                    else if (mode == 4) {
#pragma unroll
                        for (int n = 0; n < 2; ++n)
#pragma unroll
                            for (int k = 0; k < 4; ++k) v[n][k] = silu_f(v[n][k]); }
                    u32x4 w; w.x = cvt_pk_bf16(v[0][0], v[0][1]); w.y = cvt_pk_bf16(v[0][2], v[0][3]); w.z = cvt_pk_bf16(v[1][0], v[1][1]); w.w = cvt_pk_bf16(v[1][2], v[1][3]);
                    *(u32x4*)(rowp + bj * HALF) = w; } }
    }
};
struct EpiOddIn {
    static constexpr bool PERM = true, AFTER_DRAIN = false;
    bf16_t* O; int ldc; int gate_pm0;
    __device__ __forceinline__ void operator()(const f32x4 (&acc)[2][2][4][2], const Unit& u, int wr, int wc, int fr, int fq) const {
        const int row0 = u.pm * BM + wr * 64 + fr; const int col0 = u.pn * BM + wc * 32 + 8 * fq; const bool gate = u.pm >= gate_pm0;
#pragma unroll
        for (int ai = 0; ai < 2; ++ai)
#pragma unroll
            for (int m = 0; m < 4; ++m) { bf16_t* rowp = O + (size_t)(row0 + ai * HALF + m * 16) * ldc + col0;
#pragma unroll
                for (int bj = 0; bj < 2; ++bj) { f32x4 v[2] = {acc[ai][bj][m][0], acc[ai][bj][m][1]};
                    if (gate) {
#pragma unroll
                        for (int n = 0; n < 2; ++n)
#pragma unroll
                            for (int k = 0; k < 4; ++k) v[n][k] = silu_f(v[n][k]); }
                    u32x4 w; w.x = cvt_pk_bf16(v[0][0], v[0][1]); w.y = cvt_pk_bf16(v[0][2], v[0][3]); w.z = cvt_pk_bf16(v[1][0], v[1][1]); w.w = cvt_pk_bf16(v[1][2], v[1][3]);
                    *(u32x4*)(rowp + bj * HALF) = w; } }
    }
};
template <class Epi, class Sched, bool ALIGN_EPI = false, bool SP2 = false>
__device__ __forceinline__ void gemm_phase(PG8_LAS unsigned char* lds, const int K, const Sched& S, const Epi& E) {
    int tid = threadIdx.x; asm volatile("" : "+v"(tid));
    const int wid = __builtin_amdgcn_readfirstlane(tid >> 6), lane = tid & 63, wr = wid >> 2, wc = wid & 3, fr = lane & 15, fq = lane >> 4;
    const int nt = K / BK;
    unsigned voffA[2], voffB[2];
#pragma unroll
    for (int i = 0; i < 2; ++i) { int R, C; stage_rc(tid * 16 + i * 8192, R, C); const int Rb = Epi::PERM ? ((R & ~31) + perm32(R & 31)) : R;
        voffA[i] = (unsigned)(R * K + C) * 2u; voffB[i] = (unsigned)(Rb * K + C) * 2u; }
    const size_t kstep = (size_t)(BK * 2);
    const size_t hstep = (size_t)HALF * K * 2;
    const size_t tstep = 2 * hstep;
    const unsigned ldsw = (unsigned)wid * 1024u;
    const int aoff = lds_byte(wr * 64 + fr, fq * 8), boff = lds_byte(wc * 32 + fr, fq * 8);
#define PG8_SA(b, h) (((b) * 2 + (h)) * HTB)
#define PG8_SB(b, h) ((4 + (b) * 2 + (h)) * HTB)
#define PG8_STAGE(bufoff, gbase, voff) do { _Pragma("unroll") for (int _i = 0; _i < 2; ++_i) \
        __builtin_amdgcn_global_load_lds((const unsigned*)((const char*)(gbase) + (voff)[_i]), (PG8_LAS unsigned*)(lds + (bufoff) + ldsw + _i * 8192), 16, 0, 0); } while (0)
#define PG8_LDA(dst, b, h) do { _Pragma("unroll") for (int m = 0; m < 4; ++m) _Pragma("unroll") for (int k = 0; k < 2; ++k) dst[m][k] = *(const PG8_LAS bf16x8*)(lds + PG8_SA(b, h) + aoff + m * 2048 + k * 1024); } while (0)
#define PG8_LDB(dst, b, h) do { _Pragma("unroll") for (int n = 0; n < 2; ++n) _Pragma("unroll") for (int k = 0; k < 2; ++k) dst[n][k] = *(const PG8_LAS bf16x8*)(lds + PG8_SB(b, h) + boff + n * 2048 + k * 1024); } while (0)
#define PG8_MMA(ai, bj, At, Bt) do { __builtin_amdgcn_s_setprio(1); _Pragma("unroll") for (int m = 0; m < 4; ++m) _Pragma("unroll") for (int n = 0; n < 2; ++n) _Pragma("unroll") for (int k = 0; k < 2; ++k) \
        acc[ai][bj][m][n] = __builtin_amdgcn_mfma_f32_16x16x32_bf16(Bt[n][k], At[m][k], acc[ai][bj][m][n], 0, 0, 0); __builtin_amdgcn_s_setprio(0); } while (0)
#define PG8_WAIT_V(n) asm volatile("s_waitcnt vmcnt(" #n ")" ::: "memory")
#define PG8_WAIT_L(n) asm volatile("s_waitcnt lgkmcnt(" #n ")" ::: "memory")
#define PG8_BAR __builtin_amdgcn_s_barrier()
#define PG8_SCHED __builtin_amdgcn_sched_barrier(0)
    Unit cur, nxt; int ui = 0;
    if (!S.next(0, cur)) return;
    f32x4 acc[2][2][4][2];
#pragma unroll
    for (int a = 0; a < 2; ++a)
#pragma unroll
        for (int b = 0; b < 2; ++b)
#pragma unroll
            for (int m = 0; m < 4; ++m)
#pragma unroll
                for (int n = 0; n < 2; ++n) acc[a][b][m][n] = (f32x4){0.f, 0.f, 0.f, 0.f};
    bf16x8 At[4][2], B0[2][2], B1[2][2];
    const char* cA = S.abase(cur); const char* cB = S.bbase(cur);
    S.a_ready(cur);
    if constexpr (SP2) {
        PG8_STAGE(PG8_SB(0, 0), cB, voffB); PG8_STAGE(PG8_SB(0, 1), cB + hstep, voffB); PG8_STAGE(PG8_SA(0, 0), cA, voffA); PG8_STAGE(PG8_SA(0, 1), cA + hstep, voffA);
        if (wr == 1) PG8_BAR;
        PG8_WAIT_V(2); PG8_BAR;
        PG8_STAGE(PG8_SB(1, 0), cB + kstep, voffB); PG8_STAGE(PG8_SA(1, 0), cA + kstep, voffA); PG8_STAGE(PG8_SB(1, 1), cB + hstep + kstep, voffB);
        PG8_WAIT_V(6); PG8_BAR;
    } else {
        PG8_STAGE(PG8_SB(0, 0), cB, voffB); PG8_STAGE(PG8_SA(0, 0), cA, voffA); PG8_STAGE(PG8_SB(0, 1), cB + hstep, voffB); PG8_STAGE(PG8_SA(0, 1), cA + hstep, voffA);
        if (wr == 1) PG8_BAR;
        PG8_WAIT_V(4); PG8_BAR;
        PG8_STAGE(PG8_SB(1, 0), cB + kstep, voffB); PG8_STAGE(PG8_SA(1, 0), cA + kstep, voffA); PG8_STAGE(PG8_SB(1, 1), cB + hstep + kstep, voffB);
        PG8_WAIT_V(6); PG8_BAR;
    }
    for (;;) {
        const bool has_next = S.next(ui + 1, nxt);
        const char* nA = has_next ? S.abase(nxt) : cA; const char* nB = has_next ? S.bbase(nxt) : cB;
        for (int t = 0; t < nt; t += 2) {
            const bool last = (t == nt - 2);
            const char* a1 = cA + (size_t)(t + 1) * kstep;
            const char* a2 = last ? nA : cA + (size_t)(t + 2) * kstep; const char* b2 = last ? nB : cB + (size_t)(t + 2) * kstep;
            const char* a3 = a2 + kstep; const char* b3 = b2 + kstep;
            if (last && has_next) S.a_ready(nxt);
            if constexpr (SP2) {
            PG8_LDB(B0, 0, 0); PG8_LDB(B1, 0, 1); PG8_SCHED; PG8_LDA(At, 0, 0); PG8_STAGE(PG8_SA(1, 1), a1 + hstep, voffA);
            PG8_WAIT_V(8); PG8_WAIT_L(0); PG8_BAR; PG8_MMA(0, 0, At, B0); PG8_MMA(0, 1, At, B1); PG8_BAR; PG8_SCHED;
            PG8_LDA(At, 0, 1); PG8_STAGE(PG8_SB(0, 0), b2, voffB); PG8_STAGE(PG8_SB(0, 1), b2 + hstep, voffB); PG8_STAGE(PG8_SA(0, 0), a2, voffA);
            PG8_WAIT_V(8); PG8_WAIT_L(0); PG8_BAR; PG8_MMA(1, 0, At, B0); PG8_MMA(1, 1, At, B1); PG8_BAR; PG8_SCHED;
            PG8_LDB(B0, 1, 0); PG8_LDB(B1, 1, 1); PG8_SCHED; PG8_LDA(At, 1, 0); PG8_STAGE(PG8_SA(0, 1), a2 + hstep, voffA);
            PG8_WAIT_V(8); PG8_WAIT_L(0); PG8_BAR; PG8_MMA(0, 0, At, B0); PG8_MMA(0, 1, At, B1); PG8_BAR; PG8_SCHED;
            PG8_LDA(At, 1, 1); PG8_STAGE(PG8_SB(1, 0), b3, voffB); PG8_STAGE(PG8_SB(1, 1), b3 + hstep, voffB); PG8_STAGE(PG8_SA(1, 0), a3, voffA);
            PG8_WAIT_V(8); PG8_WAIT_L(0); PG8_BAR; PG8_MMA(1, 0, At, B0); PG8_MMA(1, 1, At, B1); PG8_BAR; PG8_SCHED;
            } else {
            PG8_LDB(B0, 0, 0); PG8_SCHED; PG8_LDA(At, 0, 0); PG8_STAGE(PG8_SA(1, 1), a1 + hstep, voffA);
            PG8_WAIT_L(8); PG8_BAR; PG8_WAIT_L(0); PG8_MMA(0, 0, At, B0); PG8_BAR; PG8_SCHED;
            PG8_LDB(B1, 0, 1); PG8_STAGE(PG8_SB(0, 0), b2, voffB);
            PG8_BAR; PG8_WAIT_L(0); PG8_MMA(0, 1, At, B1); PG8_BAR;
            PG8_LDA(At, 0, 1); PG8_STAGE(PG8_SA(0, 0), a2, voffA);
            PG8_BAR; PG8_WAIT_L(0); PG8_MMA(1, 0, At, B0); PG8_BAR; PG8_SCHED;
            PG8_STAGE(PG8_SB(0, 1), b2 + hstep, voffB);
            PG8_WAIT_V(6); PG8_BAR; PG8_MMA(1, 1, At, B1); PG8_BAR;
            PG8_LDB(B0, 1, 0); PG8_SCHED; PG8_LDA(At, 1, 0); PG8_STAGE(PG8_SA(0, 1), a2 + hstep, voffA);
            PG8_WAIT_L(8); PG8_BAR; PG8_WAIT_L(0); PG8_MMA(0, 0, At, B0); PG8_BAR; PG8_SCHED;
            PG8_LDB(B1, 1, 1); PG8_STAGE(PG8_SB(1, 0), b3, voffB);
            PG8_BAR; PG8_WAIT_L(0); PG8_MMA(0, 1, At, B1); PG8_BAR;
            PG8_LDA(At, 1, 1); PG8_STAGE(PG8_SA(1, 0), a3, voffA);
            PG8_BAR; PG8_WAIT_L(0); PG8_MMA(1, 0, At, B0); PG8_BAR; PG8_SCHED;
            PG8_STAGE(PG8_SB(1, 1), b3 + hstep, voffB);
            PG8_WAIT_V(6); PG8_BAR; PG8_MMA(1, 1, At, B1); PG8_BAR;
            }
        }
        if constexpr (ALIGN_EPI) { if (wr == 0) PG8_BAR; }
        if constexpr (!Epi::AFTER_DRAIN) { E(acc, cur, wr, wc, fr, fq); S.done(cur); }
        if (!has_next) break;
#pragma unroll
        for (int a = 0; a < 2; ++a)
#pragma unroll
            for (int b = 0; b < 2; ++b)
#pragma unroll
                for (int m = 0; m < 4; ++m)
#pragma unroll
                    for (int n = 0; n < 2; ++n) acc[a][b][m][n] = (f32x4){0.f, 0.f, 0.f, 0.f};
        cur = nxt; cA = nA; cB = nB; ++ui;
        if constexpr (ALIGN_EPI) { if (wr == 1) PG8_BAR; }
    }
    PG8_WAIT_V(0);
    if constexpr (!ALIGN_EPI) { if (wr == 0) PG8_BAR; }
    PG8_BAR;

#undef PG8_SA
#undef PG8_SB
#undef PG8_STAGE
#undef PG8_LDA
#undef PG8_LDB
#undef PG8_MMA
#undef PG8_WAIT_V
#undef PG8_WAIT_L
#undef PG8_BAR
#undef PG8_SCHED
}
}
constexpr int NB = 2, T = 4096, NMETA = 16, L = T + NMETA, D = 4096;
constexpr int MV = NB * L;
constexpr int MP = 8448;
constexpr int EIN = 18432, OIN = 16384, HD = 128;
constexpr int QA_OFF = 0, KA_OFF = 2048, QB_OFF = 6144, IB_OFF = 8192, FF_OFF = 10240, FB_OFF = 12288, GATE_OFF = 14336;
constexpr int KOFF = 4128, KLEN = 8256;
constexpr int LPAD = 4128;
constexpr float EPS = 1e-6f;
constexpr int NWAVES = 8, NTHR = 512;
constexpr int NPHASE = 24;
constexpr int NA_SPLIT = 0, NA_TAIL = 7680;

constexpr size_t MiB = 1u << 20;
constexpr size_t WS_CTL = 0, CTL_ZERO_BYTES = 1 * MiB;
constexpr size_t WS_WEIN = 1 * MiB;
constexpr size_t WS_WEOUT = WS_WEIN + 2 * (size_t)EIN * D * 2;
constexpr size_t WS_WOIN = WS_WEOUT + 2 * (size_t)D * D * 2;
constexpr size_t WS_WOOUT = WS_WOIN + 2 * (size_t)OIN * D * 2;
constexpr size_t WS_H = WS_WOOUT + 2 * (size_t)D * D * 2;
constexpr size_t WS_HN = WS_H + (size_t)MP * D * 4;
constexpr size_t WS_P = WS_HN + (size_t)MP * D * 2;
constexpr size_t WS_VT = WS_P + (size_t)MP * EIN * 2;
constexpr size_t WS_Y = WS_VT + (size_t)2048 * MP * 2;
constexpr size_t WS_YT = WS_Y + (size_t)MP * D * 2;
constexpr size_t WS_OBP = WS_YT + (size_t)MP * D * 2;
constexpr size_t WS_OUT = WS_OBP + (size_t)2 * MP * 2048 * 4;
constexpr size_t WS_KT = WS_OUT + (size_t)MP * D * 4;
constexpr size_t WS_HID2 = WS_KT + (size_t)2 * 2 * 4096 * KLEN * 2;
constexpr size_t WS_LB = WS_HID2 + (size_t)2 * LPAD * 64 * 2;
constexpr size_t WS_QSG = WS_LB + (size_t)2 * 2 * 2048 * 4;
constexpr size_t WS_KSG = WS_QSG + (size_t)4160 * 8192 * 2;
constexpr size_t WS_VTG = WS_KSG + (size_t)4160 * 8192 * 2;
constexpr size_t WS_DECG = WS_VTG + (size_t)4160 * 8192 * 2;
constexpr size_t WS_END = WS_DECG + (size_t)4160 * 128 * 4;
static_assert(WS_WEIN % 256 == 0 && WS_H % 256 == 0 && WS_P % 256 == 0 && WS_KT % 256 == 0 && WS_HID2 % 256 == 0 && WS_LB % 256 == 0, "alignment");
constexpr int CW_BAR = 4096;

constexpr int LDS_BYTES = 163840;
constexpr int MISC_OFF = 162816;

#define LAS __attribute__((address_space(3)))
typedef unsigned short bf16_t;
typedef short bf16x8 __attribute__((ext_vector_type(8)));
typedef short bf16x4 __attribute__((ext_vector_type(4)));
typedef float f32x4 __attribute__((ext_vector_type(4)));
typedef float f32x16 __attribute__((ext_vector_type(16)));
typedef unsigned u32x4 __attribute__((ext_vector_type(4)));
typedef unsigned u32x2 __attribute__((ext_vector_type(2)));
#define LDS_WAIT() asm volatile("s_waitcnt lgkmcnt(0)" ::: "memory")
#define VM_WAIT() asm volatile("s_waitcnt vmcnt(0)" ::: "memory")
__device__ __forceinline__ unsigned f2bf(float f) { return pg8::cvt_pk_bf16(f, 0.f) & 0xffffu; }
__device__ __forceinline__ unsigned pk2(float lo, float hi) { return pg8::cvt_pk_bf16(lo, hi); }
__device__ __forceinline__ float bflo(unsigned w) { return __builtin_bit_cast(float, w << 16); }
__device__ __forceinline__ float bfhi(unsigned w) { return __builtin_bit_cast(float, w & 0xffff0000u); }
__device__ __forceinline__ float bf1(bf16_t w) { return __builtin_bit_cast(float, ((unsigned)w) << 16); }
__device__ __forceinline__ void lds_barrier() { asm volatile("s_waitcnt lgkmcnt(0)" ::: "memory"); __builtin_amdgcn_s_barrier(); asm volatile("" ::: "memory"); }
__device__ __forceinline__ float wave_sum(float v) {
#pragma unroll
    for (int o = 1; o < 64; o <<= 1) v += __shfl_xor(v, o);
    return v;
}

#define XB_TMO      128
#define XB_XCNT(j)  (256  + 64 * (j))
#define XB_XSUB(j)  (1280 + 64 * (j))
#define XB_XGEN(j)  (2304 + 64 * (j))
#define XB_TOP      3328
#define XB_TOPGEN   3392
#define XCD_BAR_WORDS 3456
#define XB_SPIN_CAP (1u << 20)
__device__ __forceinline__ unsigned xb_ld(unsigned* p)              { return __hip_atomic_load(p, __ATOMIC_RELAXED, __HIP_MEMORY_SCOPE_AGENT); }
__device__ __forceinline__ unsigned xb_add(unsigned* p, unsigned v) { return __hip_atomic_fetch_add(p, v, __ATOMIC_RELAXED, __HIP_MEMORY_SCOPE_AGENT); }
__device__ __forceinline__ unsigned xb_xcc_id() { return (unsigned)__builtin_amdgcn_s_getreg((3 << 11) | 20) & 0xFu; }
#define XB_SPIN(cond, bar) do { unsigned _sp = 0; while (cond) { __builtin_amdgcn_s_sleep(1); \
    if ((++_sp & 255u) == 0u) { if (xb_ld(&(bar)[XB_TMO])) break; if (_sp > XB_SPIN_CAP) { atomicAdd(&(bar)[XB_TMO], 1u); break; } } } } while (0)
struct XcdBarrier { unsigned* bar; unsigned x; volatile LAS unsigned* st; };
__device__ __forceinline__ XcdBarrier xcd_barrier_post(unsigned* bar, volatile LAS unsigned* st) {
    XcdBarrier b; b.bar = bar; b.x = xb_xcc_id(); b.st = st;
    if (threadIdx.x == 0) (void)xb_add(&bar[XB_XCNT(b.x)], 1u);
    return b;
}
__device__ __forceinline__ void xcd_barrier_complete(unsigned* bar, unsigned x, unsigned& nloc, unsigned& nx) {
    const unsigned G = gridDim.x * gridDim.y * gridDim.z;
    unsigned sum, cnt, mine, sp = 0u;
    for (;;) {
        sum = 0u; cnt = 0u; mine = 0u;
#pragma unroll
        for (unsigned j = 0; j < 16; ++j) { const unsigned c = xb_ld(&bar[XB_XCNT(j)]); sum += c; cnt += (c > 0u) ? 1u : 0u; mine = (j == x) ? c : mine; }
        if (sum == G) break;
        __builtin_amdgcn_s_sleep(1);
        if ((++sp & 255u) == 0u) { if (xb_ld(&bar[XB_TMO])) break; if (sp > XB_SPIN_CAP) { atomicAdd(&bar[XB_TMO], 1u); break; } }
    }
    nloc = mine > 0u ? mine : 1u; nx = cnt > 0u ? cnt : 1u;
}
__device__ __forceinline__ void xcd_barrier(const XcdBarrier& b) {
    asm volatile("s_waitcnt vmcnt(0)" ::: "memory");
    __syncthreads();
    if (threadIdx.x == 0) {
        unsigned* bar = b.bar;
        __builtin_amdgcn_s_waitcnt(0);
        unsigned nloc = b.st[0], nx = b.st[1];
        if (nloc == 0u) { xcd_barrier_complete(bar, b.x, nloc, nx); b.st[0] = nloc; b.st[1] = nx; }
        const unsigned old = xb_add(&bar[XB_XSUB(b.x)], 1u);
        const unsigned gen = old / nloc;
        if (old + 1u == (gen + 1u) * nloc) {
            __builtin_amdgcn_fence(__ATOMIC_RELEASE, "agent");
            asm volatile("s_waitcnt vmcnt(0)" ::: "memory");
            const unsigned og = xb_add(&bar[XB_TOP], 1u);
            const unsigned tg = og / nx;
            if (og + 1u == (tg + 1u) * nx) xb_add(&bar[XB_TOPGEN], 1u);
            else XB_SPIN(xb_ld(&bar[XB_TOPGEN]) == tg, bar);
            __builtin_amdgcn_fence(__ATOMIC_ACQUIRE, "agent");
            xb_add(&bar[XB_XGEN(b.x)], 1u);
            asm volatile("s_waitcnt vmcnt(0)" ::: "memory");
        } else {
            XB_SPIN(xb_ld(&bar[XB_XGEN(b.x)]) == gen, bar);
            __builtin_amdgcn_fence(__ATOMIC_ACQUIRE, "agent");
            asm volatile("s_waitcnt vmcnt(0)" ::: "memory");
        }
    }
    __syncthreads();
}

struct Params { const float* in[21]; float* out; unsigned char* ws; int ph_lo, ph_hi; };
enum { I_X = 0, I_META, I_NPRE, I_NPOST, I_EWIN, I_EWOUT, I_RPB, I_MBIAS, I_HGLOW, I_HGNORM, I_OWIN, I_OWOUT, I_HYSHORT, I_W1, I_B1, I_FR1, I_W2, I_B2, I_FR2, I_W3, I_HYBIAS };

#if MK_SUBPROBE
#define SUBP_T0(id) unsigned long long sp_t0_##id = 0; if (MK_SUBPROBE == (id)) sp_t0_##id = wall_clock64();
#define SUBP_T1(id) if (MK_SUBPROBE == (id) && threadIdx.x == 0) { volatile LAS unsigned* M_ = (volatile LAS unsigned*)(lds + MISC_OFF); const unsigned long long d_ = wall_clock64() - sp_t0_##id + (((unsigned long long)M_[5] << 32) | M_[4]); M_[4] = (unsigned)d_; M_[5] = (unsigned)(d_ >> 32); }
#else
#define SUBP_T0(id)
#define SUBP_T1(id)
#endif
struct P0Item { const float* W; bf16_t* WT; int N, k0, n0; };
__device__ __forceinline__ P0Item p0_item(const Params& p, int it) {
    constexpr int I_EIN = (D / 64) * (EIN / 256), I_SQ = (D / 64) * (D / 256), I_OIN = (D / 64) * (OIN / 256), I_LAYER = I_EIN + 2 * I_SQ + I_OIN;
    const int j = it / I_LAYER; int r = it % I_LAYER; P0Item x;
    if (r < I_EIN) { x.W = p.in[I_EWIN] + (size_t)j * D * EIN; x.WT = (bf16_t*)(p.ws + WS_WEIN) + (size_t)j * EIN * D; x.N = EIN; }
    else if ((r -= I_EIN) < I_SQ) { x.W = p.in[I_EWOUT] + (size_t)j * D * D; x.WT = (bf16_t*)(p.ws + WS_WEOUT) + (size_t)j * D * D; x.N = D; }
    else if ((r -= I_SQ) < I_OIN) { x.W = p.in[I_OWIN] + (size_t)j * D * OIN; x.WT = (bf16_t*)(p.ws + WS_WOIN) + (size_t)j * OIN * D; x.N = OIN; }
    else { r -= I_OIN; x.W = p.in[I_OWOUT] + (size_t)j * D * D; x.WT = (bf16_t*)(p.ws + WS_WOOUT) + (size_t)j * D * D; x.N = D; }
    const int nblk = x.N / 256; x.k0 = 64 * (r / nblk); x.n0 = 256 * (r % nblk); return x;
}
__device__ __forceinline__ void p0_load(const P0Item& x, int tid, f32x4 (&v)[8]) {
#pragma unroll
    for (int j = 0; j < 8; ++j) { const int q = tid + NTHR * j; v[j] = *(const f32x4*)(x.W + (size_t)(x.k0 + (q >> 6)) * x.N + x.n0 + 4 * (q & 63)); }
}
__device__ __forceinline__ void rms_row_to_bf16(const f32x4 (&v)[16], const float* g, bf16_t* orow, int lane) {
    float s = 0.f;
#pragma unroll
    for (int j = 0; j < 16; ++j) s += (v[j].x * v[j].x + v[j].y * v[j].y) + (v[j].z * v[j].z + v[j].w * v[j].w);
    const float rstd = 1.0f / sqrtf(wave_sum(s) * (1.0f / D) + EPS);
    const f32x4* g4 = (const f32x4*)g + lane; u32x2* o8 = (u32x2*)orow + lane;
#pragma unroll
    for (int j = 0; j < 16; ++j) { const f32x4 gg = g4[64 * j]; u32x2 w; w.x = pk2(v[j].x * rstd * gg.x, v[j].y * rstd * gg.y); w.y = pk2(v[j].z * rstd * gg.z, v[j].w * rstd * gg.w); o8[64 * j] = w; }
}
__device__ __forceinline__ void phase_prologue(const Params& p, LAS unsigned char* lds, int gw, int NGW, int wave, int lane) {
    unsigned char* ws = p.ws;
    {
        LAS float* tile = (LAS float*)lds;
        constexpr int NITEMS = 2 * ((D / 64) * (EIN / 256) + 2 * (D / 64) * (D / 256) + (D / 64) * (OIN / 256));
        const int vcu = gw / NWAVES, G = NGW / NWAVES, tid = wave * 64 + lane;
        f32x4 v[8]; P0Item cur;
        if (vcu < NITEMS) { cur = p0_item(p, vcu); p0_load(cur, tid, v); }
        for (int it = vcu; it < NITEMS; it += G) {
#pragma unroll
            for (int j = 0; j < 8; ++j) { const int q = tid + NTHR * j; *(LAS f32x4*)(tile + (q >> 6) * 260 + ((4 * (q & 63) + 16 * (q >> 10)) & 255)) = v[j]; }
            lds_barrier();
            const P0Item me = cur;
            if (it + G < NITEMS) { cur = p0_item(p, it + G); p0_load(cur, tid, v); }
#pragma unroll
            for (int half = 0; half < 2; ++half) { const int n = 128 * half + (tid >> 2), kq = tid & 3; const LAS float* s = tile + (16 * kq) * 260 + ((n + 16 * kq) & 255);
                u32x4 o0, o1;
                o0.x = pk2(s[0 * 260], s[1 * 260]); o0.y = pk2(s[2 * 260], s[3 * 260]); o0.z = pk2(s[4 * 260], s[5 * 260]); o0.w = pk2(s[6 * 260], s[7 * 260]);
                o1.x = pk2(s[8 * 260], s[9 * 260]); o1.y = pk2(s[10 * 260], s[11 * 260]); o1.z = pk2(s[12 * 260], s[13 * 260]); o1.w = pk2(s[14 * 260], s[15 * 260]);
                bf16_t* d = me.WT + (size_t)(me.n0 + n) * D + me.k0 + 16 * kq;
                *(u32x4*)d = o0; *(u32x4*)(d + 8) = o1; }
            lds_barrier();
        }
    }
    bf16_t* HN = (bf16_t*)(ws + WS_HN);
    for (int m = gw; m < MP; m += NGW) {
        f32x4 v[16];
        if (m < MV) {
            const float* src = (m < NB * T) ? p.in[I_X] + (size_t)m * D : p.in[I_META] + (size_t)((m - NB * T) & 15) * D;
#pragma unroll
            for (int j = 0; j < 16; ++j) v[j] = ((const f32x4*)src)[lane + 64 * j];
            rms_row_to_bf16(v, p.in[I_NPRE], HN + (size_t)m * D, lane);
        } else {
#pragma unroll
            for (int j = 0; j < 16; ++j) ((u32x2*)(HN + (size_t)m * D))[lane + 64 * j] = (u32x2){0u, 0u};
        }
    }
    { float* LB = (float*)(ws + WS_LB); const float* hl = p.in[I_HGLOW];
      for (int i = gw * 64 + lane; i < 2 * 2048; i += NGW * 64) { LB[i] = 0.f; LB[4096 + i] = 1.0f / (1.0f + __expf(hl[i] - hl[4096 + i])); } }
    { bf16_t* HID2 = (bf16_t*)(ws + WS_HID2);
      for (int it = gw; it < 2 * LPAD; it += NGW) {
        const int jl = it / LPAD, l = it % LPAD; float h2 = 0.f;
        if (l < L) {
            float z = 0.f;
            if (lane == 0) z = (float)l * (1.0f / (float)(L - 1));
            else if (lane < 33) { const int k = (lane - 1) & 15; const float band = 1e-4f + (float)k * ((15.0f - 1e-4f) / 15.0f); float rev = band * ((float)l / (float)L); rev -= floorf(rev);
                z = (lane < 17) ? __builtin_amdgcn_cosf(rev) : -__builtin_amdgcn_sinf(rev); }
            const float* w1 = p.in[I_W1] + (size_t)jl * 33 * 64; const float* w2 = p.in[I_W2] + (size_t)jl * 64 * 64;
            float a = p.in[I_B1][jl * 64 + lane];
#pragma unroll
            for (int i = 0; i < 33; ++i) a += __shfl(z, i) * w1[i * 64 + lane];
            const float h1 = __sinf(p.in[I_FR1][jl * 64 + lane] * a);
            float a2 = p.in[I_B2][jl * 64 + lane];
#pragma unroll 16
            for (int i = 0; i < 64; ++i) a2 += __shfl(h1, i) * w2[i * 64 + lane];
            h2 = __sinf(p.in[I_FR2][jl * 64 + lane] * a2);
        }
        HID2[(size_t)it * 64 + lane] = (bf16_t)f2bf(h2);
      } }
}

__device__ __forceinline__ void phase_filtergen(const Params& p, LAS unsigned char* lds, int gw, int NGW, int wave, int lane) {
    unsigned char* ws = p.ws; const bf16_t* HID2 = (const bf16_t*)(ws + WS_HID2); bf16_t* KT = (bf16_t*)(ws + WS_KT);
    const int r32 = lane & 31, h = lane >> 5;
    LAS bf16_t* tile = (LAS bf16_t*)(lds + wave * 5120);
    for (int wi = gw; wi < 2048; wi += NGW) {
        const int lpart = wi & 3, cb = (wi >> 2) & 127, n = (wi >> 9) & 1, jl = wi >> 10; const int c0 = cb * 32;
        const float* w3 = p.in[I_W3] + (size_t)jl * 64 * 16384;
        bf16x8 A[2][4];
#pragma unroll
        for (int dir = 0; dir < 2; ++dir)
#pragma unroll
            for (int st = 0; st < 4; ++st) { const float* src = w3 + (size_t)(16 * st + 8 * h) * 16384 + (dir * 2 + n) * 4096 + c0 + r32;
                u32x4 w; w.x = pk2(src[0], src[16384]); w.y = pk2(src[2 * 16384], src[3 * 16384]); w.z = pk2(src[4 * 16384], src[5 * 16384]); w.w = pk2(src[6 * 16384], src[7 * 16384]);
                A[dir][st] = __builtin_bit_cast(bf16x8, w); }
        const int lb0 = lpart * 33, lb1 = (lb0 + 33 < 129) ? lb0 + 33 : 129;
        const bf16_t* hrow = HID2 + (size_t)jl * LPAD * 64;
        LAS unsigned char* hidt = lds + 40960 + wave * 4864;
        u32x4 HR[5]; bf16x8 Bf[4], Bb[4];
#define FG_LOAD(lb) do { _Pragma("unroll") for (int q_ = 0; q_ < 5; ++q_) { const int pc_ = lane + 64 * q_; int row_ = (lb) * 32 + (pc_ >> 3); row_ = row_ < LPAD ? row_ : LPAD - 1; \
        HR[q_] = *(const u32x4*)(hrow + (size_t)row_ * 64 + 8 * (pc_ & 7)); } } while (0)
        FG_LOAD(lb0);
        for (int lb = lb0; lb < lb1; ++lb) {
#pragma unroll
            for (int q_ = 0; q_ < 5; ++q_) { const int pc_ = lane + 64 * q_; if (q_ < 4 || lane < 8) *(LAS u32x4*)(hidt + (pc_ >> 3) * 144 + 16 * (pc_ & 7)) = HR[q_]; }
            if (lb + 1 < lb1) FG_LOAD(lb + 1);
            LDS_WAIT(); asm volatile("" ::: "memory");
#pragma unroll
            for (int st = 0; st < 4; ++st) { Bf[st] = *(const LAS bf16x8*)(hidt + (r32 + 1) * 144 + 32 * st + 16 * h); Bb[st] = *(const LAS bf16x8*)(hidt + r32 * 144 + 32 * st + 16 * h); }
            f32x16 acc0, acc1, accc;
#pragma unroll
            for (int i = 0; i < 16; ++i) { acc0[i] = 0.f; acc1[i] = 0.f; accc[i] = 0.f; }
#pragma unroll
            for (int st = 0; st < 4; ++st) { acc0 = __builtin_amdgcn_mfma_f32_32x32x16_bf16(A[0][st], Bf[st], acc0, 0, 0, 0); acc1 = __builtin_amdgcn_mfma_f32_32x32x16_bf16(A[1][st], Bb[st], acc1, 0, 0, 0); }
            if (lb == 0) {
#pragma unroll
                for (int st = 0; st < 4; ++st) accc = __builtin_amdgcn_mfma_f32_32x32x16_bf16(A[0][st], Bb[st], accc, 0, 0, 0);
            }
            const int lbk = lb * 32 + r32, lfw = lbk + 1;
            const float tb = (float)lbk * (1.0f / (float)(L - 1)), tf = (float)lfw * (1.0f / (float)(L - 1));
            const bool odd = (r32 & 1) != 0;
#pragma unroll
            for (int rp = 0; rp < 8; ++rp) { const int reg = 2 * rp; const int cl = (reg & 3) + 8 * (reg >> 2) + 4 * h;
                const float da = 3.0701134f + (15.350567f - 3.0701134f) * ((float)(c0 + cl) * (1.0f / 4095.0f)), db = 3.0701134f + (15.350567f - 3.0701134f) * ((float)(c0 + cl + 1) * (1.0f / 4095.0f));
                float v1a = acc1[reg] * __expf(-tb * da), v1b = acc1[reg + 1] * __expf(-tb * db); if (lbk == 0) { v1a += accc[reg]; v1b += accc[reg + 1]; }
                const float v0a = acc0[reg] * __expf(-tf * da), v0b = acc0[reg + 1] * __expf(-tf * db);
                { const float keep = odd ? v1b : v1a, send = odd ? v1a : v1b;
                  const float recv = __builtin_bit_cast(float, __builtin_amdgcn_update_dpp(0, __builtin_bit_cast(int, send), 0xB1, 0xf, 0xf, true));
                  *(LAS unsigned*)(tile + (32 + cl + (odd ? 1 : 0)) * 40 + (r32 & ~1)) = pk2(odd ? recv : keep, odd ? keep : recv); }
                { const float keep = odd ? v0b : v0a, send = odd ? v0a : v0b;
                  const float recv = __builtin_bit_cast(float, __builtin_amdgcn_update_dpp(0, __builtin_bit_cast(int, send), 0xB1, 0xf, 0xf, true));
                  *(LAS unsigned*)(tile + (cl + (odd ? 1 : 0)) * 40 + ((31 - r32) & ~1)) = pk2(odd ? keep : recv, odd ? recv : keep); } }
            LDS_WAIT(); asm volatile("" ::: "memory");
#pragma unroll
            for (int k = 0; k < 2; ++k) { const int cl = (lane >> 2) + 16 * k, ch = lane & 3;
                bf16_t* R = KT + ((size_t)(jl * 2 + n) * 4096 + c0 + cl) * KLEN;
                *(u32x4*)(R + (KOFF - 32 - 32 * lb) + 8 * ch) = *(const LAS u32x4*)(tile + cl * 40 + 8 * ch);
                *(u32x4*)(R + (KOFF + 32 * lb) + 8 * ch) = *(const LAS u32x4*)(tile + (32 + cl) * 40 + 8 * ch); }
            LDS_WAIT(); asm volatile("" ::: "memory");
        }
#undef FG_LOAD
    }
}
constexpr int HG_QM = 0, HG_KM = 17408, HG_KST = 34816, HG_VT = 53248, HG_TOT = 71680, HG_OUT = 79872, HG_END1 = 97280;
__device__ __forceinline__ int hg_row(int dir, int b, int ci, int tau) {
    if (dir == 0) { if (ci == 0) return tau < 16 ? 8192 + 16 * b + tau : -1; return b * 4096 + 64 * (ci - 1) + tau; }
    if (ci == 64) return tau < 16 ? 8192 + 16 * b + 15 - tau : -1;
    return b * 4096 + 4095 - (64 * ci + tau);
}
struct HgRaw { u32x2 q[4], l[4]; u32x4 v[2]; };
__device__ __forceinline__ void hg1_load(const bf16_t* P, int item, int tid, HgRaw& r) {
    const int ci = item % 65, hd = (item / 65) & 15, b = (item / (65 * 16)) & 1, dir = item / (65 * 32);
    const int qcol = QB_OFF + hd * 128, vcol = IB_OFF + hd * 128, fcol = (dir ? FB_OFF : FF_OFF) + hd * 128;
    const int dg = tid & 31, tg = tid >> 5, tv = tid >> 3, dvq = tid & 7;
#pragma unroll
    for (int i = 0; i < 4; ++i) { const int row = hg_row(dir, b, ci, 4 * tg + i); const int rc = row < 0 ? 0 : row;
        r.q[i] = *(const u32x2*)(P + (size_t)rc * EIN + qcol + 4 * dg); r.l[i] = *(const u32x2*)(P + (size_t)rc * EIN + fcol + 4 * dg); }
    { const int row = hg_row(dir, b, ci, tv); const int rc = row < 0 ? 0 : row;
      r.v[0] = *(const u32x4*)(P + (size_t)rc * EIN + vcol + 8 * dvq); r.v[1] = *(const u32x4*)(P + (size_t)rc * EIN + vcol + 64 + 8 * dvq); }
}
constexpr int HG_C1 = 36;
__device__ __forceinline__ void hgrn_stage1(const Params& p, LAS unsigned char* lds, int c_lo, int c_hi, int vcu, int G, int tid, int wave, int lane) {
    const bf16_t* P = (const bf16_t*)(p.ws + WS_P);
    bf16_t* QSG = (bf16_t*)(p.ws + WS_QSG); bf16_t* KSG = (bf16_t*)(p.ws + WS_KSG); bf16_t* VTG = (bf16_t*)(p.ws + WS_VTG); float* DECG = (float*)(p.ws + WS_DECG);
    const int dg = tid & 31, tg = tid >> 5, tv = tid >> 3, dvq = tid & 7, r32 = lane & 31, h = lane >> 5;
    LAS bf16_t* QM = (LAS bf16_t*)(lds + HG_QM); LAS bf16_t* KM = (LAS bf16_t*)(lds + HG_KM); LAS bf16_t* KST = (LAS bf16_t*)(lds + HG_KST); LAS bf16_t* VTL = (LAS bf16_t*)(lds + HG_VT);
    LAS float* TOT = (LAS float*)(lds + HG_TOT);
    HgRaw raw;
    const int ncs = c_hi - c_lo, NV = 64 * ncs;
#define HG1_VITEM(v) (((v) / ncs) * 65 + c_lo + ((v) % ncs))
    if (vcu < NV) hg1_load(P, HG1_VITEM(vcu), tid, raw);
    for (int vi = vcu; vi < NV; vi += G) { const int item = HG1_VITEM(vi);
        const int ci = item % 65, hd = (item / 65) & 15, b = (item / (65 * 16)) & 1, dir = item / (65 * 32);
        SUBP_T0(20)
        float qs[4][4], lg[4][4], kk[4][4], cs[4][4];
#pragma unroll
        for (int i = 0; i < 4; ++i) if (hg_row(dir, b, ci, 4 * tg + i) < 0) { raw.q[i] = (u32x2){0u, 0u}; raw.l[i] = (u32x2){0u, 0u}; }
        if (hg_row(dir, b, ci, tv) < 0) { raw.v[0] = (u32x4){0u, 0u, 0u, 0u}; raw.v[1] = (u32x4){0u, 0u, 0u, 0u}; }
#pragma unroll
        for (int i = 0; i < 4; ++i) { qs[i][0] = bflo(raw.q[i].x); qs[i][1] = bfhi(raw.q[i].x); qs[i][2] = bflo(raw.q[i].y); qs[i][3] = bfhi(raw.q[i].y);
            lg[i][0] = bflo(raw.l[i].x); lg[i][1] = bfhi(raw.l[i].x); lg[i][2] = bflo(raw.l[i].y); lg[i][3] = bfhi(raw.l[i].y); }
#pragma unroll
        for (int i = 0; i < 4; ++i)
#pragma unroll
            for (int k = 0; k < 4; ++k) kk[i][k] = 1.0f - __expf(lg[i][k]);
#pragma unroll
        for (int k = 0; k < 4; ++k) { cs[0][k] = lg[0][k]; cs[1][k] = cs[0][k] + lg[1][k]; cs[2][k] = cs[1][k] + lg[2][k]; cs[3][k] = cs[2][k] + lg[3][k]; }
        *(LAS f32x4*)(TOT + tg * 128 + 4 * dg) = (f32x4){cs[3][0], cs[3][1], cs[3][2], cs[3][3]};
        { const unsigned vw[8] = {raw.v[0].x, raw.v[0].y, raw.v[0].z, raw.v[0].w, raw.v[1].x, raw.v[1].y, raw.v[1].z, raw.v[1].w};
          const int tvs0 = tv ^ (8 * (dvq >> 1)), tvs1 = tv ^ (8 * (4 + (dvq >> 1)));
#pragma unroll
          for (int k = 0; k < 4; ++k) { VTL[(8 * dvq + 2 * k) * 72 + tvs0] = (bf16_t)(vw[k] & 0xffffu); VTL[(8 * dvq + 2 * k + 1) * 72 + tvs0] = (bf16_t)(vw[k] >> 16);
              VTL[(64 + 8 * dvq + 2 * k) * 72 + tvs1] = (bf16_t)(vw[4 + k] & 0xffffu); VTL[(64 + 8 * dvq + 2 * k + 1) * 72 + tvs1] = (bf16_t)(vw[4 + k] >> 16); } }
        lds_barrier(); SUBP_T1(20) SUBP_T0(21)
        f32x4 pre = (f32x4){0.f, 0.f, 0.f, 0.f}, mid = pre, end = pre;
#pragma unroll
        for (int g = 0; g < 16; ++g) { const f32x4 t4 = *(const LAS f32x4*)(TOT + g * 128 + 4 * dg); if (g < tg) pre += t4; if (g < 8) mid += t4; end += t4; }
        if (vi + G < NV) hg1_load(P, HG1_VITEM(vi + G), tid, raw);
        bf16_t* qsg = QSG + (size_t)item * 8192; bf16_t* ksg = KSG + (size_t)item * 8192; bf16_t* vtg = VTG + (size_t)item * 8192;
        float qsv[4][4], qmv[4][4], kmv[4][4];
#pragma unroll
        for (int k = 0; k < 4; ++k) {
            const float emid = __expf(mid[k]), eem = __expf(end[k] - mid[k]);
            float ksv[4];
#pragma unroll
            for (int i = 0; i < 4; ++i) { const float Gc = pre[k] + cs[i][k]; const float e1 = __expf(Gc - mid[k]), e2 = __expf(mid[k] - Gc);
                const float qm = qs[i][k] * e1, km = kk[i][k] * e2; qmv[i][k] = qm; kmv[i][k] = km; qsv[i][k] = qm * emid; ksv[i] = km * eem; }
            *(LAS u32x2*)(KST + (4 * dg + k) * 72 + 4 * tg) = (u32x2){pk2(ksv[0], ksv[1]), pk2(ksv[2], ksv[3])};
            if (tg == 0) DECG[(size_t)item * 128 + 4 * dg + k] = emid * eem;
        }
#pragma unroll
        for (int i = 0; i < 4; ++i) { const int tau = 4 * tg + i;
            *(LAS u32x2*)(QM + tau * 136 + 4 * dg) = (u32x2){pk2(qmv[i][0], qmv[i][1]), pk2(qmv[i][2], qmv[i][3])};
            *(LAS u32x2*)(KM + tau * 136 + 4 * dg) = (u32x2){pk2(kmv[i][0], kmv[i][1]), pk2(kmv[i][2], kmv[i][3])};
            *(u32x2*)(qsg + tau * 128 + 4 * dg) = (u32x2){pk2(qsv[i][0], qsv[i][1]), pk2(qsv[i][2], qsv[i][3])}; }
        lds_barrier(); SUBP_T1(21) SUBP_T0(22)
        {
            const int dvt = wave & 3, tb = wave >> 2;
            f32x16 accO;
#pragma unroll
            for (int i = 0; i < 16; ++i) accO[i] = 0.f;
            for (int sb = 0; sb <= tb; ++sb) {
                f32x16 sT;
#pragma unroll
                for (int i = 0; i < 16; ++i) sT[i] = 0.f;
#pragma unroll
                for (int stp = 0; stp < 8; ++stp) { const bf16x8 a = *(const LAS bf16x8*)(KM + (32 * sb + r32) * 136 + 16 * stp + 8 * h); const bf16x8 bq = *(const LAS bf16x8*)(QM + (32 * tb + r32) * 136 + 16 * stp + 8 * h);
                    sT = __builtin_amdgcn_mfma_f32_32x32x16_bf16(a, bq, sT, 0, 0, 0); }
                if (sb == tb) {
#pragma unroll
                    for (int reg = 0; reg < 16; ++reg) { const int sl = (reg & 3) + 8 * (reg >> 2) + 4 * h; if (sl > r32) sT[reg] = 0.f; }
                }
#pragma unroll
                for (int st2 = 0; st2 < 2; ++st2) {
                    u32x4 pw; pw.x = pk2(sT[8 * st2 + 0], sT[8 * st2 + 1]); pw.y = pk2(sT[8 * st2 + 2], sT[8 * st2 + 3]); pw.z = pk2(sT[8 * st2 + 4], sT[8 * st2 + 5]); pw.w = pk2(sT[8 * st2 + 6], sT[8 * st2 + 7]);
                    const int vg8 = 8 * (((32 * dvt + r32) >> 4) & 7);
                    const LAS bf16_t* vp = VTL + (32 * dvt + r32) * 72 + 4 * h;
                    const u32x2 a0 = *(const LAS u32x2*)(vp + ((32 * sb + 16 * st2) ^ vg8)), a1 = *(const LAS u32x2*)(vp + ((32 * sb + 16 * st2 + 8) ^ vg8));
                    const u32x4 aw = (u32x4){a0.x, a0.y, a1.x, a1.y};
                    accO = __builtin_amdgcn_mfma_f32_32x32x16_bf16(__builtin_bit_cast(bf16x8, aw), __builtin_bit_cast(bf16x8, pw), accO, 0, 0, 0);
                }
            }
            { LAS bf16_t* ot = (LAS bf16_t*)(lds + HG_OUT) + (32 * tb + r32) * 136 + 32 * dvt + 4 * h;
#pragma unroll
              for (int g4 = 0; g4 < 4; ++g4) *(LAS u32x2*)(ot + 8 * g4) = (u32x2){pk2(accO[4 * g4], accO[4 * g4 + 1]), pk2(accO[4 * g4 + 2], accO[4 * g4 + 3])}; }
#pragma unroll
            for (int j = 0; j < 2; ++j) { const int pc = tid + NTHR * j, rr = pc >> 3, ch = pc & 7;
                *(u32x4*)(ksg + rr * 64 + 8 * ch) = *(const LAS u32x4*)(KST + rr * 72 + 8 * ch); *(u32x4*)(vtg + rr * 64 + 8 * ch) = *(const LAS u32x4*)(VTL + rr * 72 + 8 * (ch ^ ((rr >> 4) & 7))); }
        }
        lds_barrier(); SUBP_T1(22)
        { bf16_t* OB = (bf16_t*)(p.ws + WS_OBP) + (size_t)dir * MP * 2048;
#pragma unroll
          for (int j = 0; j < 2; ++j) { const int q = tid + NTHR * j, tau = q >> 4, c16 = q & 15; const int row = hg_row(dir, b, ci, tau);
              if (row >= 0) *(u32x4*)(OB + (size_t)row * 2048 + hd * 128 + 8 * c16) = *(const LAS u32x4*)(lds + HG_OUT + tau * 272 + 16 * c16); } }
    }
#undef HG1_VITEM
}
constexpr int HF_STB = 0, HF_SLOT0 = 34816, HF_QS = 0, HF_KST = 17408, HF_VT = 35840, HF_DEC = 54272, HF_SLOT = 54784, HF_OUT = HF_SLOT0 + 2 * HF_SLOT;
static_assert(HF_OUT + 64 * 272 <= MISC_OFF, "stage-2 LDS map");
__device__ __forceinline__ void hgrn_stage2f(const Params& p, LAS unsigned char* lds, int item, unsigned* flag, unsigned target, int tid, int wave, int lane) {
    const int hd = item & 15, b = (item >> 4) & 1, dir = item >> 5;
    const int r32 = lane & 31, h = lane >> 5, dvt = wave & 3, tb = wave >> 2; const size_t item0 = (size_t)(((dir * 2 + b) * 16 + hd) * 65);
    LAS bf16_t* STB = (LAS bf16_t*)(lds + HF_STB);
    for (int i = tid; i < 128 * 136 / 2; i += NTHR) ((LAS unsigned*)STB)[i] = 0u;
    f32x16 st0, st1;
#pragma unroll
    for (int i = 0; i < 16; ++i) { st0[i] = 0.f; st1[i] = 0.f; }
    u32x4 R[7], R2[7];
    const unsigned lqs = HF_QS + (tid >> 4) * 272 + 16 * (tid & 15), lk = (tid >> 3) * 144 + 16 * (tid & 7);
#define HF_LD(R, ci) do { if ((ci) < 65) { const size_t it_ = item0 + (ci); const bf16_t* q_ = (const bf16_t*)(p.ws + WS_QSG) + it_ * 8192 + 8 * tid; const bf16_t* k_ = (const bf16_t*)(p.ws + WS_KSG) + it_ * 8192 + 8 * tid; \
        const bf16_t* v_ = (const bf16_t*)(p.ws + WS_VTG) + it_ * 8192 + 8 * tid; \
        R[0] = *(const u32x4*)q_; R[1] = *(const u32x4*)(q_ + 4096); R[2] = *(const u32x4*)k_; R[3] = *(const u32x4*)(k_ + 4096); R[4] = *(const u32x4*)v_; R[5] = *(const u32x4*)(v_ + 4096); \
        if (tid < 32) R[6] = *(const u32x4*)((const float*)(p.ws + WS_DECG) + it_ * 128 + 4 * tid); } } while (0)
#define HF_ST(R, ci) do { if ((ci) < 65) { LAS unsigned char* sl_ = lds + HF_SLOT0 + ((ci) & 1) * HF_SLOT; \
        *(LAS u32x4*)(sl_ + lqs) = R[0]; *(LAS u32x4*)(sl_ + lqs + 32 * 272) = R[1]; *(LAS u32x4*)(sl_ + HF_KST + lk) = R[2]; *(LAS u32x4*)(sl_ + HF_KST + lk + 64 * 144) = R[3]; \
        *(LAS u32x4*)(sl_ + HF_VT + lk) = R[4]; *(LAS u32x4*)(sl_ + HF_VT + lk + 64 * 144) = R[5]; if (tid < 32) *(LAS u32x4*)(sl_ + HF_DEC + 16 * tid) = R[6]; } } while (0)
    HF_LD(R, 0); HF_ST(R, 0); HF_LD(R, 1); HF_LD(R2, 2);
    bf16_t* OB2 = (bf16_t*)(p.ws + WS_OBP) + (size_t)2 * MP * 2048 + (size_t)dir * MP * 2048;
    lds_barrier();
    f32x16 dl0, dl1;
    auto step = [&](int ci, u32x4 (&RX)[7]) {
        const LAS unsigned char* slot = lds + HF_SLOT0 + (ci & 1) * HF_SLOT;
        if (flag != nullptr && ci == HG_C1 - 3) { unsigned* fl = flag;
            if (tid == 0) { unsigned sp = 0u; while (xb_ld(fl) < target) { __builtin_amdgcn_s_sleep(1); if (++sp > XB_SPIN_CAP) break; } __builtin_amdgcn_fence(__ATOMIC_ACQUIRE, "agent"); }
            lds_barrier(); }
        HF_ST(RX, ci + 1);
        HF_LD(RX, ci + 3);
        {
            f32x16 accO, accP;
#pragma unroll
            for (int i = 0; i < 16; ++i) { accO[i] = 0.f; accP[i] = 0.f; dl0[i] = 0.f; dl1[i] = 0.f; }
            const LAS bf16_t* sbp = STB + (32 * dvt + r32) * 136 + 8 * h; const LAS bf16_t* qsl = (const LAS bf16_t*)(slot + HF_QS) + (32 * tb + r32) * 136 + 8 * h;
            const LAS bf16_t* vtl = (const LAS bf16_t*)(slot + HF_VT) + (32 * dvt + r32) * 72 + 8 * h;
            const LAS bf16_t* ks0 = (const LAS bf16_t*)(slot + HF_KST) + (32 * (2 * tb) + r32) * 72 + 8 * h; const LAS bf16_t* ks1 = ks0 + 32 * 72;
#pragma unroll
            for (int stp = 0; stp < 4; ++stp) {
                accO = __builtin_amdgcn_mfma_f32_32x32x16_bf16(*(const LAS bf16x8*)(sbp + 32 * stp), *(const LAS bf16x8*)(qsl + 32 * stp), accO, 0, 0, 0);
                accP = __builtin_amdgcn_mfma_f32_32x32x16_bf16(*(const LAS bf16x8*)(sbp + 32 * stp + 16), *(const LAS bf16x8*)(qsl + 32 * stp + 16), accP, 0, 0, 0);
                const bf16x8 bv = *(const LAS bf16x8*)(vtl + 16 * stp);
                dl0 = __builtin_amdgcn_mfma_f32_32x32x16_bf16(*(const LAS bf16x8*)(ks0 + 16 * stp), bv, dl0, 0, 0, 0); dl1 = __builtin_amdgcn_mfma_f32_32x32x16_bf16(*(const LAS bf16x8*)(ks1 + 16 * stp), bv, dl1, 0, 0, 0); }
            accO += accP;
            LAS bf16_t* ot = (LAS bf16_t*)(lds + HF_OUT) + (32 * tb + r32) * 136 + 32 * dvt + 4 * h;
#pragma unroll
            for (int g4 = 0; g4 < 4; ++g4) *(LAS u32x2*)(ot + 8 * g4) = (u32x2){pk2(accO[4 * g4], accO[4 * g4 + 1]), pk2(accO[4 * g4 + 2], accO[4 * g4 + 3])};
        }
        lds_barrier();
#pragma unroll
        for (int j = 0; j < 2; ++j) { const int q = tid + 512 * j, tau = q >> 4, c16 = q & 15; const int row = hg_row(dir, b, ci, tau);
            if (row >= 0) *(u32x4*)(OB2 + (size_t)row * 2048 + hd * 128 + 8 * c16) = *(const LAS u32x4*)(lds + HF_OUT + tau * 272 + 16 * c16); }
        {
            const int db0 = 2 * tb; const LAS float* decp = (const LAS float*)(slot + HF_DEC) + 32 * db0 + 4 * h;
#pragma unroll
            for (int g4 = 0; g4 < 4; ++g4) { const f32x4 d0 = *(const LAS f32x4*)(decp + 8 * g4), d1 = *(const LAS f32x4*)(decp + 32 + 8 * g4);
#pragma unroll
                for (int k = 0; k < 4; ++k) { st0[4 * g4 + k] = __builtin_fmaf(st0[4 * g4 + k], d0[k], dl0[4 * g4 + k]); st1[4 * g4 + k] = __builtin_fmaf(st1[4 * g4 + k], d1[k], dl1[4 * g4 + k]); } }
            LAS bf16_t* srow = STB + (32 * dvt + r32) * 136 + 32 * db0 + 4 * h;
#pragma unroll
            for (int g4 = 0; g4 < 4; ++g4) { *(LAS u32x2*)(srow + 8 * g4) = (u32x2){pk2(st0[4 * g4], st0[4 * g4 + 1]), pk2(st0[4 * g4 + 2], st0[4 * g4 + 3])};
                *(LAS u32x2*)(srow + 32 + 8 * g4) = (u32x2){pk2(st1[4 * g4], st1[4 * g4 + 1]), pk2(st1[4 * g4 + 2], st1[4 * g4 + 3])}; }
        }
        lds_barrier();
    };
#pragma unroll 1
    for (int c2 = 0; c2 < 64; c2 += 2) { step(c2, R); step(c2 + 1, R2); }
    step(64, R);
#undef HF_LD
#undef HF_ST
}

typedef float f32x4v __attribute__((ext_vector_type(4)));
__device__ __forceinline__ void natten_item(const Params& p, LAS float* tbl, int item, int jl, int lane) {
    const bf16_t* P = (const bf16_t*)(p.ws + WS_P); const bf16_t* VT = (const bf16_t*)(p.ws + WS_VT); bf16_t* Y = (bf16_t*)(p.ws + WS_Y);
    const bool ismeta = item >= 8192;
    int b, hd, r, j;
    if (ismeta) { const int t = item - 8192; b = t >> 4; hd = t & 15; r = 0; j = 0; } else { j = item & 3; r = (item >> 2) & 63; hd = (item >> 8) & 15; b = item >> 12; }
    const int q16 = lane & 15, h4 = lane >> 4;
    const int qrow = ismeta ? 8192 + 16 * b + q16 : b * 4096 + 64 * r + 16 * j + q16;
    const int kw0 = (j == 0) ? 0 : (j == 1) ? 8 : (j == 2) ? 24 : 32;
    const int r0 = (r - 4 < 0) ? 0 : ((r - 4 > 56) ? 56 : r - 4);
    const float* rpb = p.in[I_RPB] + ((size_t)jl * 16 + hd) * 15 * 31; const float* mb = p.in[I_MBIAS] + ((size_t)jl * 16 + hd) * 16;
    { float tv[8];
#pragma unroll
      for (int k = 0; k < 8; ++k) { const int idx = lane + 64 * k; tv[k] = rpb[idx < 465 ? idx : 464]; }
#pragma unroll
      for (int k = 0; k < 8; ++k) tbl[lane + 64 * k] = tv[k]; }
    bf16x8 QF[4];
#pragma unroll
    for (int stp = 0; stp < 4; ++stp) QF[stp] = *(const bf16x8*)(P + (size_t)qrow * EIN + QA_OFF + hd * 128 + 32 * stp + 8 * h4);
    f32x4 S[17];
    auto rowbase = [&](int i) -> int { return b * 4096 + 64 * (r0 + i) + kw0; };
    auto keyrow = [&](int kt) -> int { if (kt == 0) return 8192 + 16 * b + q16; const int i = (kt - 1) >> 1, half = (kt - 1) & 1; return rowbase(i) + 8 * (q16 >> 2) + 4 * half + (q16 & 3); };
    {
        const bf16_t* kb = P + KA_OFF + hd * 128 + 8 * h4;
        bf16x8 KF[2][3][4];
#define NA_LDK(buf, bt) do { _Pragma("unroll") for (int t_ = 0; t_ < 3; ++t_) { const int kt_ = 3 * (bt) + t_; if (kt_ < 17) { const bf16_t* kp_ = kb + (size_t)keyrow(kt_) * EIN; \
            _Pragma("unroll") for (int stp = 0; stp < 4; ++stp) KF[buf][t_][stp] = *(const bf16x8*)(kp_ + 32 * stp); } } } while (0)
#define NA_MMK(buf, bt) do { _Pragma("unroll") for (int t_ = 0; t_ < 3; ++t_) { const int kt_ = 3 * (bt) + t_; if (kt_ < 17) { f32x4 s_ = (f32x4){0.f, 0.f, 0.f, 0.f}; \
            _Pragma("unroll") for (int stp = 0; stp < 4; ++stp) s_ = __builtin_amdgcn_mfma_f32_16x16x32_bf16(KF[buf][t_][stp], QF[stp], s_, 0, 0, 0); S[kt_] = s_; } } } while (0)
        NA_LDK(0, 0); __builtin_amdgcn_sched_barrier(0);
        if (ismeta) {
            NA_MMK(0, 0);
#pragma unroll
            for (int kt = 3; kt < 17; ++kt) S[kt] = (f32x4){0.f, 0.f, 0.f, 0.f};
        } else {
        NA_LDK(1, 1); __builtin_amdgcn_sched_barrier(0); NA_MMK(0, 0); __builtin_amdgcn_sched_barrier(0);
        NA_LDK(0, 2); __builtin_amdgcn_sched_barrier(0); NA_MMK(1, 1); __builtin_amdgcn_sched_barrier(0);
        NA_LDK(1, 3); __builtin_amdgcn_sched_barrier(0); NA_MMK(0, 2); __builtin_amdgcn_sched_barrier(0);
        NA_LDK(0, 4); __builtin_amdgcn_sched_barrier(0); NA_MMK(1, 3); __builtin_amdgcn_sched_barrier(0);
        NA_LDK(1, 5); __builtin_amdgcn_sched_barrier(0); NA_MMK(0, 4); __builtin_amdgcn_sched_barrier(0);
        NA_MMK(1, 5);
        }
#undef NA_LDK
#undef NA_MMK
    }
    const int qc = 16 * j + q16; const int c0 = (qc - 8 < 0) ? 0 : ((qc - 8 > 48) ? 48 : qc - 8);
    float mx = -3.0e38f;
#pragma unroll
    for (int reg = 0; reg < 4; ++reg) { S[0][reg] += mb[4 * h4 + reg]; mx = fmaxf(mx, S[0][reg]); }
    float rb[16][4];
#pragma unroll
    for (int kt = 1; kt < 17; ++kt) { const int i = (kt - 1) >> 1, half = (kt - 1) & 1;
#pragma unroll
        for (int reg = 0; reg < 4; ++reg) { int ci = kw0 + 8 * h4 + 4 * half + reg - qc + 15; ci = ci < 0 ? 0 : (ci > 30 ? 30 : ci); rb[kt - 1][reg] = tbl[((r0 + i) - r + 7) * 31 + ci]; } }
    __builtin_amdgcn_sched_barrier(0);
#pragma unroll
    for (int kt = 1; kt < 17; ++kt) { const int half = (kt - 1) & 1;
#pragma unroll
        for (int reg = 0; reg < 4; ++reg) { const int kc = kw0 + 8 * h4 + 4 * half + reg; const bool ok = !ismeta && kc >= c0 && kc < c0 + 16;
            const float v = ok ? S[kt][reg] + rb[kt - 1][reg] : -3.0e38f; S[kt][reg] = v; mx = fmaxf(mx, v); } }
    mx = fmaxf(mx, __shfl_xor(mx, 16)); mx = fmaxf(mx, __shfl_xor(mx, 32));
    float sum = 0.f;
#pragma unroll
    for (int kt = 0; kt < 17; ++kt)
#pragma unroll
        for (int reg = 0; reg < 4; ++reg) { const float e = (S[kt][reg] > -1.0e38f) ? __expf(S[kt][reg] - mx) : 0.f; S[kt][reg] = e; sum += e; }
    sum += __shfl_xor(sum, 16); sum += __shfl_xor(sum, 32);
    const float inv = 1.0f / sum;
    f32x4 O[8];
#pragma unroll
    for (int dt = 0; dt < 8; ++dt) O[dt] = (f32x4){0.f, 0.f, 0.f, 0.f};
    u32x4 PW[9];
    PW[0].x = pk2(S[0][0], S[0][1]); PW[0].y = pk2(S[0][2], S[0][3]); PW[0].z = 0u; PW[0].w = 0u;
#pragma unroll
    for (int u = 1; u < 9; ++u) { const int k0t = 2 * u - 1, k1t = 2 * u;
        PW[u].x = pk2(S[k0t][0], S[k0t][1]); PW[u].y = pk2(S[k0t][2], S[k0t][3]); PW[u].z = pk2(S[k1t][0], S[k1t][1]); PW[u].w = pk2(S[k1t][2], S[k1t][3]); }
    {
        const bf16_t* vb = VT + (size_t)(hd * 128 + q16) * MP;
        u32x4 VF[4][8];
#define NA_LDV(buf, u) do { if ((u) == 0) { _Pragma("unroll") for (int dt = 0; dt < 8; ++dt) { const u32x2 m_ = *(const u32x2*)(vb + (size_t)(16 * dt) * MP + 8192 + 16 * b + 4 * h4); VF[buf][dt] = (u32x4){m_.x, m_.y, 0u, 0u}; } } \
        else { const int t0_ = rowbase((u) - 1) + 8 * h4; _Pragma("unroll") for (int dt = 0; dt < 8; ++dt) VF[buf][dt] = *(const u32x4*)(vb + (size_t)(16 * dt) * MP + t0_); } } while (0)
#define NA_MMV(buf, u) do { _Pragma("unroll") for (int dt = 0; dt < 8; ++dt) \
        O[dt] = __builtin_amdgcn_mfma_f32_16x16x32_bf16(__builtin_bit_cast(bf16x8, VF[buf][dt]), __builtin_bit_cast(bf16x8, PW[u]), O[dt], 0, 0, 0); } while (0)
        if (ismeta) { NA_LDV(0, 0); NA_MMV(0, 0); } else {
        NA_LDV(0, 0); NA_LDV(1, 1); NA_LDV(2, 2); __builtin_amdgcn_sched_barrier(0);
        NA_LDV(3, 3); __builtin_amdgcn_sched_barrier(0); NA_MMV(0, 0); __builtin_amdgcn_sched_barrier(0);
        NA_LDV(0, 4); __builtin_amdgcn_sched_barrier(0); NA_MMV(1, 1); __builtin_amdgcn_sched_barrier(0);
        NA_LDV(1, 5); __builtin_amdgcn_sched_barrier(0); NA_MMV(2, 2); __builtin_amdgcn_sched_barrier(0);
        NA_LDV(2, 6); __builtin_amdgcn_sched_barrier(0); NA_MMV(3, 3); __builtin_amdgcn_sched_barrier(0);
        NA_LDV(3, 7); __builtin_amdgcn_sched_barrier(0); NA_MMV(0, 4); __builtin_amdgcn_sched_barrier(0);
        NA_LDV(0, 8); __builtin_amdgcn_sched_barrier(0); NA_MMV(1, 5); __builtin_amdgcn_sched_barrier(0);
        NA_MMV(2, 6); NA_MMV(3, 7); NA_MMV(0, 8);
        }
#undef NA_LDV
#undef NA_MMV
    }
#pragma unroll
    for (int dt = 0; dt < 8; ++dt) { const int col = hd * 128 + 16 * dt + 4 * h4;
        const u32x2 g = *(const u32x2*)(P + (size_t)qrow * EIN + GATE_OFF + col);
        u32x2 w; w.x = pk2(O[dt][0] * inv * bflo(g.x), O[dt][1] * inv * bfhi(g.x)); w.y = pk2(O[dt][2] * inv * bflo(g.y), O[dt][3] * inv * bfhi(g.y));
        *(u32x2*)(Y + (size_t)qrow * D + col) = w; }
}
__device__ __forceinline__ void phase_combine(const Params& p, int jl, int gw, int NGW, int lane) {
    const bf16_t* OB0 = (const bf16_t*)(p.ws + WS_OBP); const bf16_t* OB1 = OB0 + (size_t)MP * 2048; const bf16_t* OB2 = OB0 + (size_t)2 * MP * 2048; const bf16_t* OB3 = OB0 + (size_t)3 * MP * 2048;
    const bf16_t* P = (const bf16_t*)(p.ws + WS_P); bf16_t* Y = (bf16_t*)(p.ws + WS_Y);
    const float* gain = p.in[I_HGNORM] + (size_t)jl * 2048;
    f32x4 gv[8];
#pragma unroll
    for (int k = 0; k < 8; ++k) gv[k] = *(const f32x4*)(gain + 512 * (k >> 1) + 8 * lane + 4 * (k & 1));
    u32x4 a8[4], b8[4], c8[4], d8[4], g8[4], an[4], bn[4], cn[4], dn[4], gn[4];
#define CB_LOAD(A, B, C, Dd, Gt, m) do { _Pragma("unroll") for (int k = 0; k < 4; ++k) { A[k] = *(const u32x4*)(OB0 + (size_t)(m) * 2048 + 512 * k + 8 * lane); B[k] = *(const u32x4*)(OB1 + (size_t)(m) * 2048 + 512 * k + 8 * lane); \
        C[k] = *(const u32x4*)(OB2 + (size_t)(m) * 2048 + 512 * k + 8 * lane); Dd[k] = *(const u32x4*)(OB3 + (size_t)(m) * 2048 + 512 * k + 8 * lane); \
        Gt[k] = *(const u32x4*)(P + (size_t)(m) * EIN + GATE_OFF + 2048 + 512 * k + 8 * lane); } } while (0)
    int m = gw;
    if (m < MV) CB_LOAD(a8, b8, c8, d8, g8, m);
    for (; m < MV; m += NGW) {
        if (m + NGW < MV) CB_LOAD(an, bn, cn, dn, gn, m + NGW);
        f32x4 o[8]; float ss = 0.f;
#pragma unroll
        for (int k = 0; k < 4; ++k) {
            o[2 * k] = (f32x4){(bflo(a8[k].x) + bflo(c8[k].x)) + (bflo(b8[k].x) + bflo(d8[k].x)), (bfhi(a8[k].x) + bfhi(c8[k].x)) + (bfhi(b8[k].x) + bfhi(d8[k].x)),
                               (bflo(a8[k].y) + bflo(c8[k].y)) + (bflo(b8[k].y) + bflo(d8[k].y)), (bfhi(a8[k].y) + bfhi(c8[k].y)) + (bfhi(b8[k].y) + bfhi(d8[k].y))};
            o[2 * k + 1] = (f32x4){(bflo(a8[k].z) + bflo(c8[k].z)) + (bflo(b8[k].z) + bflo(d8[k].z)), (bfhi(a8[k].z) + bfhi(c8[k].z)) + (bfhi(b8[k].z) + bfhi(d8[k].z)),
                                   (bflo(a8[k].w) + bflo(c8[k].w)) + (bflo(b8[k].w) + bflo(d8[k].w)), (bfhi(a8[k].w) + bfhi(c8[k].w)) + (bfhi(b8[k].w) + bfhi(d8[k].w))}; }
        float rs[4];
#pragma unroll
        for (int k = 0; k < 4; ++k) { float s2 = (o[2 * k].x * o[2 * k].x + o[2 * k].y * o[2 * k].y) + (o[2 * k].z * o[2 * k].z + o[2 * k].w * o[2 * k].w)
                                                + (o[2 * k + 1].x * o[2 * k + 1].x + o[2 * k + 1].y * o[2 * k + 1].y) + (o[2 * k + 1].z * o[2 * k + 1].z + o[2 * k + 1].w * o[2 * k + 1].w);
            s2 += __shfl_xor(s2, 1); s2 += __shfl_xor(s2, 2); s2 += __shfl_xor(s2, 4); s2 += __shfl_xor(s2, 8);
            rs[k] = 1.0f / sqrtf(s2 * (1.0f / 128.0f) + EPS); }
        (void)ss;
#pragma unroll
        for (int k2 = 0; k2 < 4; ++k2) { const u32x4 g = g8[k2]; const f32x4 ga = gv[2 * k2], gb = gv[2 * k2 + 1]; const f32x4 a = o[2 * k2], bq = o[2 * k2 + 1]; const float rstd = rs[k2];
            u32x4 w; w.x = pk2(a.x * rstd * ga.x * bflo(g.x), a.y * rstd * ga.y * bfhi(g.x)); w.y = pk2(a.z * rstd * ga.z * bflo(g.y), a.w * rstd * ga.w * bfhi(g.y));
            w.z = pk2(bq.x * rstd * gb.x * bflo(g.z), bq.y * rstd * gb.y * bfhi(g.z)); w.w = pk2(bq.z * rstd * gb.z * bflo(g.w), bq.w * rstd * gb.w * bfhi(g.w));
            *(u32x4*)(Y + (size_t)m * D + 2048 + 512 * k2 + 8 * lane) = w; }
#pragma unroll
        for (int k = 0; k < 4; ++k) { a8[k] = an[k]; b8[k] = bn[k]; c8[k] = cn[k]; d8[k] = dn[k]; g8[k] = gn[k]; }
    }
#undef CB_LOAD
}
__device__ __forceinline__ void phase_postnorm(const Params& p, LAS unsigned char* lds, int layer, int vcu, int G, int tid, int wave, int lane) {
    const bf16_t* OUT = (const bf16_t*)(p.ws + WS_OUT); float* H = (float*)(p.ws + WS_H); bf16_t* HN = (bf16_t*)(p.ws + WS_HN);
    const bool last = (layer == 3), first = (layer == 0); const int MR = last ? NB * T : MV;
    const f32x4* gp4 = (const f32x4*)(p.in[I_NPOST] + (size_t)layer * D) + tid; const f32x4* gq4 = (const f32x4*)(p.in[I_NPRE] + (size_t)(last ? 0 : layer + 1) * D) + tid;
    const f32x4 gpa = gp4[0], gpb = gp4[512], gqa = gq4[0], gqb = gq4[512];
    LAS float* RED = (LAS float*)lds;
    f32x4 oa[3], ob[3], ha[3], hb[3];
#define PN_LOAD(s, m) do { const u32x2 oA_ = *(const u32x2*)(OUT + (size_t)(m) * D + 4 * tid), oB_ = *(const u32x2*)(OUT + (size_t)(m) * D + 2048 + 4 * tid); const f32x4* h4_ = (const f32x4*)(first ? (((m) < NB * T) ? p.in[I_X] + (size_t)(m) * D : p.in[I_META] + (size_t)(((m) - NB * T) & 15) * D) : H + (size_t)(m) * D) + tid; \
        oa[s] = (f32x4){bflo(oA_.x), bfhi(oA_.x), bflo(oA_.y), bfhi(oA_.y)}; ob[s] = (f32x4){bflo(oB_.x), bfhi(oB_.x), bflo(oB_.y), bfhi(oB_.y)}; ha[s] = h4_[0]; hb[s] = h4_[512]; } while (0)
#define PN_ROW(s, m, par) do { \
        float ss = (oa[s].x * oa[s].x + oa[s].y * oa[s].y) + (oa[s].z * oa[s].z + oa[s].w * oa[s].w) + (ob[s].x * ob[s].x + ob[s].y * ob[s].y) + (ob[s].z * ob[s].z + ob[s].w * ob[s].w); \
        ss = wave_sum(ss); if (lane == 0) RED[(par) * 8 + wave] = ss; lds_barrier(); \
        float tot = 0.f; _Pragma("unroll") for (int w = 0; w < 8; ++w) tot += RED[(par) * 8 + w]; \
        const float rstd = 1.0f / sqrtf(tot * (1.0f / D) + EPS); \
        const f32x4 na = ha[s] + oa[s] * rstd * gpa, nb = hb[s] + ob[s] * rstd * gpb; \
        if (last) { f32x4* d4_ = (f32x4*)(p.out + (size_t)(m) * D) + tid; d4_[0] = na; d4_[512] = nb; } \
        else { f32x4* d4_ = (f32x4*)(H + (size_t)(m) * D) + tid; d4_[0] = na; d4_[512] = nb; \
            float s2 = (na.x * na.x + na.y * na.y) + (na.z * na.z + na.w * na.w) + (nb.x * nb.x + nb.y * nb.y) + (nb.z * nb.z + nb.w * nb.w); \
            s2 = wave_sum(s2); if (lane == 0) RED[16 + (par) * 8 + wave] = s2; lds_barrier(); \
            float t2 = 0.f; _Pragma("unroll") for (int w = 0; w < 8; ++w) t2 += RED[16 + (par) * 8 + w]; \
            const float r2 = 1.0f / sqrtf(t2 * (1.0f / D) + EPS); \
            *(u32x2*)(HN + (size_t)(m) * D + 4 * tid) = (u32x2){pk2(na.x * r2 * gqa.x, na.y * r2 * gqa.y), pk2(na.z * r2 * gqa.z, na.w * r2 * gqa.w)}; \
            *(u32x2*)(HN + (size_t)(m) * D + 2048 + 4 * tid) = (u32x2){pk2(nb.x * r2 * gqb.x, nb.y * r2 * gqb.y), pk2(nb.z * r2 * gqb.z, nb.w * r2 * gqb.w)}; } \
    } while (0)
    int m0 = vcu;
    if (m0 < MR) PN_LOAD(0, m0); if (m0 + G < MR) PN_LOAD(1, m0 + G);
    int par = 0;
    for (; m0 < MR; m0 += 3 * G) {
        if (m0 + 2 * G < MR) PN_LOAD(2, m0 + 2 * G);
        PN_ROW(0, m0, par); par ^= 1;
        if (m0 + G < MR) { if (m0 + 3 * G < MR) PN_LOAD(0, m0 + 3 * G); PN_ROW(1, m0 + G, par); par ^= 1; }
        if (m0 + 2 * G < MR) { if (m0 + 4 * G < MR) PN_LOAD(1, m0 + 4 * G); PN_ROW(2, m0 + 2 * G, par); par ^= 1; }
    }
#undef PN_LOAD
#undef PN_ROW
    lds_barrier();
}
constexpr int NW_META = 147456, NW_TBL = 151552;
static_assert(NW_TBL + 4096 <= MISC_OFF, "attention LDS map");
__device__ __forceinline__ int nw_fc(int c) { return (c & 3) | (((c >> 3) & 3) << 2); }

#define NW_FRESH(z) int z = 0; asm volatile("" : "+v"(z));
#define NW_ISSUE_K(sx) do { const int b_ = (sx) >> 9, hd_ = ((sx) >> 5) & 15, rp_ = (sx) & 31; const int R0_ = (2 * rp_ - 4 < 0) ? 0 : ((2 * rp_ - 4 > 56) ? 56 : 2 * rp_ - 4); \
    const bf16_t* kb_ = P + KA_OFF + hd_ * 128 + 8 * (tid & 15); \
    _Pragma("unroll") for (int k = 0; k < 18; ++k) { int row_ = R0_ + (k >> 1); row_ = row_ > 63 ? 63 : row_; \
        R[k] = *(const u32x4*)(kb_ + (size_t)(b_ * 4096 + 64 * row_ + 32 * (k & 1) + (tid >> 4)) * EIN); } \
    RM = *(const u32x4*)(kb_ + (size_t)(8192 + 16 * b_ + ((tid >> 4) & 15)) * EIN); \
    tv = p.in[I_RPB][((size_t)jl * 16 + hd_) * 465 + (tid < 465 ? tid : 464)]; } while (0)

#define NW_ISSUE_Q(sx) do { const int b_ = (sx) >> 9, hd_ = ((sx) >> 5) & 15, rp_ = (sx) & 31; const bf16_t* qp_ = P + (size_t)(b_ * 4096 + 64 * (2 * rp_ + rr) + 16 * j + q16) * EIN + QA_OFF + hd_ * 128 + 8 * h4; \
    _Pragma("unroll") for (int stp = 0; stp < 4; ++stp) QF[stp] = *(const bf16x8*)(qp_ + 32 * stp); \
    MBV = *(const f32x4*)(p.in[I_MBIAS] + ((size_t)jl * 16 + hd_) * 16 + 4 * h4); } while (0)

__device__ __forceinline__ void natten_wg(const Params& p, LAS unsigned char* lds, int s0, int sstride, int send, int jl, int tid, int wave, int lane) {
    const bf16_t* P = (const bf16_t*)(p.ws + WS_P); const bf16_t* VT = (const bf16_t*)(p.ws + WS_VT); bf16_t* Y = (bf16_t*)(p.ws + WS_Y);
    if (s0 >= send) return;
    const int q16 = lane & 15, h4 = lane >> 4; const int rr = wave >> 2, j = wave & 3;
    const int kw0 = (j == 0) ? 0 : (j == 1) ? 8 : (j == 2) ? 24 : 32;
    u32x4 R[18]; u32x4 RM; float tv; bf16x8 QF[4]; f32x4 MBV;
    if (tid < 8) *(LAS float*)(lds + NW_TBL + 4 * (512 + 31 * tid)) = -1.0e30f;
    NW_ISSUE_K(s0);
    for (int s = s0; s < send; s += sstride) {
        const int b = s >> 9, hd = (s >> 5) & 15, rp = s & 31;
        const int R0 = (2 * rp - 4 < 0) ? 0 : ((2 * rp - 4 > 56) ? 56 : 2 * rp - 4);
        const int r = 2 * rp + rr; const int r0 = (r - 4 < 0) ? 0 : ((r - 4 > 56) ? 56 : r - 4); const int so = r0 - R0;
        const int qrow = b * 4096 + 64 * r + 16 * j + q16;
        NW_ISSUE_Q(s);
        SUBP_T0(41)
        { const int g = tid & 15, c0_ = tid >> 4;
          NW_FRESH(z_) LAS unsigned char* w0 = lds + z_ + c0_ * 256 + 16 * (g ^ nw_fc(c0_)); LAS unsigned char* w1 = w0 + 65536; LAS unsigned char* w2 = w0 + 131072;
#pragma unroll
          for (int k = 0; k < 18; ++k) *(LAS u32x4*)((k < 8 ? w0 : k < 16 ? w1 : w2) + 8192 * (k & 7)) = R[k];
          if (tid < 256) *(LAS u32x4*)(w2 + (NW_META - 131072) + 16 * ((g ^ c0_) - (g ^ nw_fc(c0_)))) = RM;
          if (tid < 465) *(LAS float*)(lds + z_ + NW_TBL + 4 * tid) = tv; }
        lds_barrier(); SUBP_T1(41)
#define NW_ISSUE_V(k0, k1) do { const bf16_t* vb_ = VT + (size_t)(hd * 128 + (tid >> 3)) * MP + b * 4096 + 8 * (tid & 7); \
        _Pragma("unroll") for (int k = (k0); k < (k1); ++k) { int row_ = R0 + (k >> 1); row_ = row_ > 63 ? 63 : row_; R[k] = *(const u32x4*)(vb_ + (size_t)(64 * (k & 1)) * MP + 64 * row_); } } while (0)
        NW_ISSUE_V(0, 9); __builtin_amdgcn_sched_barrier(0);
        f32x4 S[17]; SUBP_T0(42)
        { NW_FRESH(zs_)
            { f32x4 s_ = (f32x4){0.f, 0.f, 0.f, 0.f};
#pragma unroll
              for (int stp = 0; stp < 4; ++stp) { const u32x4 kf = *(const LAS u32x4*)(lds + zs_ + NW_META + q16 * 256 + 16 * ((4 * stp + h4) ^ q16));
                  s_ = __builtin_amdgcn_mfma_f32_16x16x32_bf16(__builtin_bit_cast(bf16x8, kf), QF[stp], s_, 0, 0, 0); }
              S[0] = s_; }
            const int cb = kw0 + 8 * (q16 >> 2) + (q16 & 3); const int fcv = nw_fc(cb);
            const LAS unsigned char* kbase = lds + zs_ + (so * 64 + cb) * 256;
            const LAS unsigned char* kx[4];
#pragma unroll
            for (int stp = 0; stp < 4; ++stp) kx[stp] = kbase + 16 * ((4 * stp + h4) ^ fcv);
#pragma unroll
            for (int kt = 1; kt < 17; ++kt) { const int i = (kt - 1) >> 1, half = (kt - 1) & 1; f32x4 s_ = (f32x4){0.f, 0.f, 0.f, 0.f};
                if (kt == 9) {
#pragma unroll
                    for (int stp = 0; stp < 4; ++stp) { kx[stp] += 65536; asm volatile("" : "+v"(kx[stp])); } }
#pragma unroll
                for (int stp = 0; stp < 4; ++stp) { const u32x4 kf = *(const LAS u32x4*)(kx[stp] + (i * 64 + 4 * half) * 256 - (kt >= 9 ? 65536 : 0));
                    s_ = __builtin_amdgcn_mfma_f32_16x16x32_bf16(__builtin_bit_cast(bf16x8, kf), QF[stp], s_, 0, 0, 0); }
                S[kt] = s_; if ((kt & 1) == 0) __builtin_amdgcn_sched_barrier(0); }
        }
        SUBP_T1(42) SUBP_T0(43)
        const int qc = 16 * j + q16; const int c0 = (qc - 8 < 0) ? 0 : ((qc - 8 > 48) ? 48 : qc - 8);
        NW_FRESH(zt_)
        const LAS float* tba[8];
#pragma unroll
        for (int e = 0; e < 8; ++e) { const int kc = kw0 + 8 * h4 + e; const int ci = kc - qc + 15;
            tba[e] = (const LAS float*)(lds + zt_ + NW_TBL) + ((kc >= c0 && kc < c0 + 16) ? (r0 - r + 7) * 31 + ci : 512); }
        float mx = -3.0e38f;
#pragma unroll
        for (int reg = 0; reg < 4; ++reg) { S[0][reg] += MBV[reg]; mx = fmaxf(mx, S[0][reg]); }
#pragma unroll
        for (int kt = 1; kt < 17; ++kt) { const int i = (kt - 1) >> 1, half = (kt - 1) & 1;
#pragma unroll
            for (int reg = 0; reg < 4; ++reg) { const float v = S[kt][reg] + tba[4 * half + reg][31 * i]; S[kt][reg] = v; mx = fmaxf(mx, v); }
            if ((kt & 3) == 0) __builtin_amdgcn_sched_barrier(0); }
        NW_ISSUE_V(9, 18); RM = *(const u32x4*)(VT + (size_t)(hd * 128 + ((tid >> 1) & 127)) * MP + 8192 + 16 * b + 8 * (tid & 1));
        __builtin_amdgcn_sched_barrier(0);
        mx = fmaxf(mx, __shfl_xor(mx, 16)); mx = fmaxf(mx, __shfl_xor(mx, 32));
        const float mxl = mx * 1.44269504f;
        float sum = 0.f;
#pragma unroll
        for (int kt = 0; kt < 17; ++kt) {
#pragma unroll
            for (int reg = 0; reg < 4; ++reg) { const float e = __builtin_amdgcn_exp2f(__builtin_fmaf(S[kt][reg], 1.44269504f, -mxl)); S[kt][reg] = e; sum += e; }
            if ((kt & 3) == 3) __builtin_amdgcn_sched_barrier(0); }
        sum += __shfl_xor(sum, 16); sum += __shfl_xor(sum, 32);
        const float inv = 1.0f / sum;
        u32x4 PW[9];
        PW[0].x = pk2(S[0][0], S[0][1]); PW[0].y = pk2(S[0][2], S[0][3]); PW[0].z = 0u; PW[0].w = 0u;
#pragma unroll
        for (int u = 1; u < 9; ++u) { const int k0t = 2 * u - 1, k1t = 2 * u;
            PW[u].x = pk2(S[k0t][0], S[k0t][1]); PW[u].y = pk2(S[k0t][2], S[k0t][3]); PW[u].z = pk2(S[k1t][0], S[k1t][1]); PW[u].w = pk2(S[k1t][2], S[k1t][3]); }
        SUBP_T1(43) SUBP_T0(44)
        lds_barrier();
        { const int gk = tid & 7, dv0 = tid >> 3;
          NW_FRESH(z_) LAS unsigned char* w0 = lds + z_ + dv0 * 128 + 16 * (gk ^ ((dv0 >> 1) & 7)); LAS unsigned char* w1 = w0 + 65536; LAS unsigned char* w2 = w0 + 131072;
#pragma unroll
          for (int k = 0; k < 18; ++k) *(LAS u32x4*)((k < 8 ? w0 : k < 16 ? w1 : w2) + 8192 * (k & 7)) = R[k];
          if (tid < 256) *(LAS u32x4*)(lds + z_ + NW_META + 16 * tid) = RM; }
        lds_barrier();
        SUBP_T1(44) SUBP_T0(45)
        u32x2 GT[8];
#pragma unroll
        for (int dt = 0; dt < 8; ++dt) GT[dt] = *(const u32x2*)(P + (size_t)qrow * EIN + GATE_OFF + hd * 128 + 16 * dt + 4 * h4);
        if (s + sstride < send) NW_ISSUE_K(s + sstride);
#pragma unroll
        for (int hf = 0; hf < 2; ++hf) {
            f32x4 O[4];
#pragma unroll
            for (int d4 = 0; d4 < 4; ++d4) O[d4] = (f32x4){0.f, 0.f, 0.f, 0.f};
            NW_FRESH(zv_)
#pragma unroll
            for (int d4 = 0; d4 < 4; ++d4) { const u32x2 m_ = *(const LAS u32x2*)(lds + zv_ + NW_META + (16 * (4 * hf + d4) + q16) * 32 + 8 * h4);
                O[d4] = __builtin_amdgcn_mfma_f32_16x16x32_bf16(__builtin_bit_cast(bf16x8, (u32x4){m_.x, m_.y, 0u, 0u}), __builtin_bit_cast(bf16x8, PW[0]), O[d4], 0, 0, 0); }
            const LAS unsigned char* vbase = lds + zv_ + so * 16384 + q16 * 128 + 16 * (((kw0 >> 3) + h4) ^ ((q16 >> 1) & 7)) + hf * 8192;
#pragma unroll
            for (int u = 1; u < 9; ++u) {
                if (u == 5) { vbase += 65536; asm volatile("" : "+v"(vbase)); }
#pragma unroll
                for (int d4 = 0; d4 < 4; ++d4) { const u32x4 vf = *(const LAS u32x4*)(vbase + (u - 1) * 16384 + d4 * 2048 - (u >= 5 ? 65536 : 0));
                    O[d4] = __builtin_amdgcn_mfma_f32_16x16x32_bf16(__builtin_bit_cast(bf16x8, vf), __builtin_bit_cast(bf16x8, PW[u]), O[d4], 0, 0, 0); }
                if ((u & 1) == 0) __builtin_amdgcn_sched_barrier(0); }
#pragma unroll
            for (int d4 = 0; d4 < 4; ++d4) { const int col = hd * 128 + 16 * (4 * hf + d4) + 4 * h4;
                const u32x2 g = GT[4 * hf + d4];
                u32x2 w; w.x = pk2(O[d4][0] * inv * bflo(g.x), O[d4][1] * inv * bfhi(g.x)); w.y = pk2(O[d4][2] * inv * bflo(g.y), O[d4][3] * inv * bfhi(g.y));
                *(u32x2*)(Y + (size_t)qrow * D + col) = w; }
            __builtin_amdgcn_sched_barrier(0);
        }
        SUBP_T1(45) SUBP_T0(46)
        lds_barrier(); SUBP_T1(46)
    }
}
#undef NW_ISSUE_K
#undef NW_ISSUE_V
#undef NW_ISSUE_Q
#undef NW_FRESH
constexpr int LC_KCS = 16704;
constexpr int LC_KC = 0, LC_U1 = 4 * LC_KCS  , LC_US = 20480, LC_U2 = LC_U1 + LC_US, LC_X1 = LC_U2 + LC_US  , LC_XS = 16512, LC_X2 = LC_X1 + LC_XS, LC_TAIL = LC_X2 + LC_XS  , LC_END = LC_TAIL + 256;
static_assert(LC_END <= MISC_OFF, "long-conv LDS map");
__device__ __forceinline__ int lc_ugran(int b, int G) { return b * 10240 + (G & 3) * 2560 + (G >> 2) * 16; }
__device__ __forceinline__ int lc_tokrow(int b, int l) { return l < 16 ? 8192 + 16 * b + l : b * 4096 + l - 16; }
struct LcRaw { u32x4 mid; unsigned left, right; };
__device__ __forceinline__ void lc_load_raw(const bf16_t* urow, int b, int gl, LcRaw& r) {
    const int l0 = 8 * gl; r.mid = *(const u32x4*)(urow + lc_tokrow(b, l0));
    r.left = urow[lc_tokrow(b, l0 > 0 ? l0 - 1 : 0)]; r.right = urow[lc_tokrow(b, l0 + 8 < L ? l0 + 8 : L - 1)];
}
__device__ __forceinline__ void lc_load_raw_x(const bf16_t* urow, int b, int gl, int lane, LcRaw& r) {
    const int l0 = 8 * gl; r.mid = *(const u32x4*)(urow + lc_tokrow(b, l0));
    unsigned edge = 0u;
    if (lane == 0 || lane == 63) edge = urow[lc_tokrow(b, lane == 0 ? l0 - 1 : (l0 + 8 < L ? l0 + 8 : L - 1))];
    r.left = edge; r.right = edge;
}
__device__ __forceinline__ void lc_fix_edges(LcRaw& r, int lane) {
    const unsigned up = (unsigned)__shfl_up((int)(r.mid.w >> 16), 1), dn = (unsigned)__shfl_down((int)(r.mid.x & 0xffffu), 1);
    if (lane != 0) r.left = up; if (lane != 63) r.right = dn;
}
__device__ __forceinline__ u32x4 lc_conv3(const LcRaw& r, int gl, float w0, float w1, float w2) {
    float x[10]; x[0] = (gl > 0) ? bf1((bf16_t)r.left) : 0.f; x[9] = (8 * gl + 8 < L) ? bf1((bf16_t)r.right) : 0.f;
    x[1] = bflo(r.mid.x); x[2] = bfhi(r.mid.x); x[3] = bflo(r.mid.y); x[4] = bfhi(r.mid.y); x[5] = bflo(r.mid.z); x[6] = bfhi(r.mid.z); x[7] = bflo(r.mid.w); x[8] = bfhi(r.mid.w);
    float o[8];
#pragma unroll
    for (int k = 0; k < 8; ++k) o[k] = w0 * x[k] + w1 * x[k + 1] + w2 * x[k + 2];
    return (u32x4){pk2(o[0], o[1]), pk2(o[2], o[3]), pk2(o[4], o[5]), pk2(o[6], o[7])};
}
struct LcFilt { u32x4 a[3]; u32x2 n[3]; };
__device__ __forceinline__ void lc_load_filter(const bf16_t* krow, int tid, LcFilt& f) {
#pragma unroll
    for (int j = 0; j < 3; ++j) { const int m = tid + NTHR * j; const int mc = m < KLEN / 8 ? m : KLEN / 8 - 1, mn = mc + 1 < KLEN / 8 ? mc + 1 : KLEN / 8 - 1;
        f.a[j] = *(const u32x4*)(krow + 8 * mc); f.n[j] = *(const u32x2*)(krow + 8 * mn); }
}
__device__ __forceinline__ void lc_store_filter(const LcFilt& f, LAS unsigned char* lds, int tid) {
#pragma unroll
    for (int j = 0; j < 3; ++j) { const int m = tid + NTHR * j;
        if (m < KLEN / 8) { const bool lastc = (m + 1 >= KLEN / 8); const unsigned w[6] = {f.a[j].x, f.a[j].y, f.a[j].z, f.a[j].w, lastc ? 0u : f.n[j].x, lastc ? 0u : f.n[j].y};
            *(LAS u32x4*)(lds + LC_KC + 0 * LC_KCS + 16 * m) = (u32x4){__builtin_amdgcn_alignbit(w[1], w[0], 16), __builtin_amdgcn_alignbit(w[2], w[1], 16), __builtin_amdgcn_alignbit(w[3], w[2], 16), __builtin_amdgcn_alignbit(w[4], w[3], 16)};
            *(LAS u32x4*)(lds + LC_KC + 1 * LC_KCS + 16 * m) = (u32x4){w[1], w[2], w[3], w[4]};
            *(LAS u32x4*)(lds + LC_KC + 2 * LC_KCS + 16 * m) = (u32x4){__builtin_amdgcn_alignbit(w[2], w[1], 16), __builtin_amdgcn_alignbit(w[3], w[2], 16), __builtin_amdgcn_alignbit(w[4], w[3], 16), __builtin_amdgcn_alignbit(w[5], w[4], 16)};
            *(LAS u32x4*)(lds + LC_KC + 3 * LC_KCS + 16 * m) = (u32x4){w[2], w[3], w[4], w[5]}; } }
}
template <int VAR = 0> __device__ __forceinline__ void lc_conv(LAS unsigned char* lds, int uin_off, int wave, int lane, f32x16& accm) {
    const int g = wave; const int i32 = lane & 31, h = lane >> 5, n16 = lane & 15, b = (lane >> 4) & 1;
    const int e0 = 32 * g - 257;
    const int p0 = KOFF - 16 * e0 - i32 + 8 * h; const int sh = ((p0 - 1) & 3) + 1; const int q0 = p0 - sh;
    const LAS unsigned char* kpA = lds + LC_KC + (sh - 1) * LC_KCS + 2 * q0;
    const int I = 16 * g + n16;
    const int G0 = 4 * I - 2 * e0 + h + 60, G1 = G0 - 2;
    const LAS unsigned char* up0 = lds + uin_off + lc_ugran(b, G0); const LAS unsigned char* up1 = lds + uin_off + lc_ugran(b, G1);
    f32x16 acc0, acc1;
#pragma unroll
    for (int r = 0; r < 16; ++r) { acc0[r] = 0.f; acc1[r] = 0.f; }
    u32x2 fa[4], fb[4]; u32x4 fu[4];
    if (VAR != 0) { for (int j = 0; j < 4; ++j) { fa[j] = (u32x2){0u, 0u}; fb[j] = (u32x2){0u, 0u}; fu[j] = (u32x4){0u, 0u, 0u, 0u}; } }
    unsigned ka = (unsigned)(size_t)kpA - 96u, u0 = (unsigned)(size_t)up0 - 16u, u1 = (unsigned)(size_t)up1 - 16u;
#define LC_LD(j, jo, ko, uo) do { if (VAR == 0) asm volatile("ds_read_b64 %0, %3 offset:" #ko "\n\tds_read_b64 %1, %3 offset:" #ko "+8\n\tds_read_b128 %2, %4 offset:" #uo \
        : "=v"(fa[j]), "=v"(fb[j]), "=v"(fu[j]) : "v"(ka), "v"(((jo) & 1) ? u1 : u0) : "memory"); \
        else if (VAR == 1) asm volatile("ds_read_b64 %0, %2 offset:" #ko "\n\tds_read_b64 %1, %2 offset:" #ko "+8" : "=v"(fa[j]), "=v"(fb[j]) : "v"(ka) : "memory"); } while (0)
#define LC_WAIT(n, j) do { if (VAR == 0) asm volatile("s_waitcnt lgkmcnt(" #n ")" : "+v"(fa[j]), "+v"(fb[j]), "+v"(fu[j])); else if (VAR == 1) asm volatile("s_waitcnt lgkmcnt(" #n "*2/3)" : "+v"(fa[j]), "+v"(fb[j]), "+v"(fu[j])); else asm volatile("" : "+v"(fa[j]), "+v"(fb[j]), "+v"(fu[j])); } while (0)
#define LC_MM(j, acc) acc = __builtin_amdgcn_mfma_f32_32x32x16_bf16(__builtin_bit_cast(bf16x8, (u32x4){fa[j].x, fa[j].y, fb[j].x, fb[j].y}), __builtin_bit_cast(bf16x8, fu[j]), acc, 0, 0, 0)
    LC_LD(0, 0, 96, 16); LC_LD(1, 1, 64, 16); LC_LD(2, 2, 32, 0); LC_LD(3, 3, 0, 0);
    for (int k = 0; k < 71; ++k) {
        ka -= 128u; u0 -= 32u; u1 -= 32u;
        LC_WAIT(9, 0); LC_MM(0, acc0); LC_LD(0, 0, 96, 16);
        LC_WAIT(9, 1); LC_MM(1, acc1); LC_LD(1, 1, 64, 16);
        LC_WAIT(9, 2); LC_MM(2, acc0); LC_LD(2, 2, 32, 0);
        LC_WAIT(9, 3); LC_MM(3, acc1); LC_LD(3, 3, 0, 0);
    }
    LC_WAIT(9, 0); LC_MM(0, acc0); LC_WAIT(6, 1); LC_MM(1, acc1); LC_WAIT(3, 2); LC_MM(2, acc0); LC_WAIT(0, 3); LC_MM(3, acc1);
#undef LC_LD
#undef LC_WAIT
#undef LC_MM
    accm = acc0 + acc1;
    {
        const int h4 = lane >> 4; f32x4 t = (f32x4){0.f, 0.f, 0.f, 0.f};
        const int s_lo = 17 * wave, s_hi = (s_lo + 17 < 129) ? s_lo + 17 : 129;
        const int pt = 32 - n16 + 8 * h4; const int st_ = ((pt - 1) & 3) + 1; const LAS unsigned char* kt = lds + LC_KC + (st_ - 1) * LC_KCS + 2 * (pt - st_);
        const LAS unsigned char* ut = lds + uin_off + (n16 & 1) * 10240 + h4 * 2560 + 16 * 15;
        for (int s = s_lo; s < s_hi; ++s) {
            const u32x2 a0 = *(const LAS u32x2*)(kt + 64 * s), a1 = *(const LAS u32x2*)(kt + 64 * s + 8);
            u32x4 bw = *(const LAS u32x4*)(ut + 16 * s); if (n16 >= 2) bw = (u32x4){0u, 0u, 0u, 0u};
            t = __builtin_amdgcn_mfma_f32_16x16x32_bf16(__builtin_bit_cast(bf16x8, (u32x4){a0.x, a0.y, a1.x, a1.y}), __builtin_bit_cast(bf16x8, bw), t, 0, 0, 0);
        }
        if (n16 < 2) { LAS float* tl = (LAS float*)(lds + LC_TAIL) + n16 * 16 + 4 * h4;
#pragma unroll
            for (int r = 0; r < 4; ++r) (void)__hip_atomic_fetch_add(tl + r, t[r], __ATOMIC_RELAXED, __HIP_MEMORY_SCOPE_WORKGROUP); }
    }
}
__device__ __forceinline__ void lc_item(int tid, int j, int& b, int& gl) { if (j < 2) { b = j; gl = 2 + tid; } else { b = (tid >> 1) & 1; gl = tid & 1; } }
__device__ __forceinline__ void phase_longconv(const Params& p, LAS unsigned char* lds, int jl, int vcu, int G, int tid, int wave, int lane) {
    const bf16_t* UT = (const bf16_t*)(p.ws + WS_P); bf16_t* YT = (bf16_t*)(p.ws + WS_YT); const bf16_t* KT = (const bf16_t*)(p.ws + WS_KT);
    const float* wsh = p.in[I_HYSHORT] + (size_t)jl * 3 * 4096 * 3; const float* hb = p.in[I_HYBIAS] + (size_t)jl * 2 * 4096;
    for (int i = tid; i < 2 * LC_US / 16; i += NTHR) *(LAS u32x4*)(lds + LC_U1 + 16 * i) = (u32x4){0u, 0u, 0u, 0u};
    const int h = lane >> 5, n16 = lane & 15, bl = (lane >> 4) & 1;
    LcRaw rv[3], r1[3], r2[3]; LcFilt flt; float wv[9], nb0 = 0.f, nb1 = 0.f, nb0n = 0.f, nb1n = 0.f;
    auto load_channel = [&](int c) {
#pragma unroll
        for (int k = 0; k < 3; ++k) { wv[k] = wsh[c * 3 + k]; wv[3 + k] = wsh[(4096 + c) * 3 + k]; wv[6 + k] = wsh[(8192 + c) * 3 + k]; }
        nb0n = hb[c]; nb1n = hb[4096 + c];
#pragma unroll
        for (int j = 0; j < 2; ++j) { int b, gl; lc_item(tid, j, b, gl);
            lc_load_raw_x(UT + (size_t)c * MP, b, gl, lane, rv[j]); lc_load_raw_x(UT + (size_t)(4096 + c) * MP, b, gl, lane, r1[j]); lc_load_raw_x(UT + (size_t)(8192 + c) * MP, b, gl, lane, r2[j]); }
        if (tid < 4) { int b, gl; lc_item(tid, 2, b, gl);
            lc_load_raw(UT + (size_t)c * MP, b, gl, rv[2]); lc_load_raw(UT + (size_t)(4096 + c) * MP, b, gl, r1[2]); lc_load_raw(UT + (size_t)(8192 + c) * MP, b, gl, r2[2]); }
        lc_load_filter(KT + ((size_t)(jl * 2 + 0) * 4096 + c) * KLEN, tid, flt);
    };
    if (vcu < 4096) { load_channel(vcu); nb0 = nb0n; nb1 = nb1n; }
    lds_barrier();
    for (int c = vcu; c < 4096; c += G) {
        const bf16_t* grow = UT + (size_t)(12288 + c) * MP;
        const float bias0 = nb0, bias1 = nb1;
        SUBP_T0(10)
#pragma unroll
        for (int j = 0; j < 2; ++j) { lc_fix_edges(rv[j], lane); lc_fix_edges(r1[j], lane); lc_fix_edges(r2[j], lane); }
#pragma unroll
        for (int j = 0; j < 3; ++j) { if (j < 2 || tid < 4) { int b, gl; lc_item(tid, j, b, gl);
            *(LAS u32x4*)(lds + LC_U1 + lc_ugran(b, gl + 60)) = lc_conv3(rv[j], gl, wv[0], wv[1], wv[2]);
            *(LAS u32x4*)(lds + LC_X1 + b * 8224 + 16 * gl) = lc_conv3(r1[j], gl, wv[3], wv[4], wv[5]);
            *(LAS u32x4*)(lds + LC_X2 + b * 8224 + 16 * gl) = lc_conv3(r2[j], gl, wv[6], wv[7], wv[8]); } }
        lc_store_filter(flt, lds, tid);
        if (tid < 32) ((LAS float*)(lds + LC_TAIL))[tid] = 0.f;
        lc_load_filter(KT + ((size_t)(jl * 2 + 1) * 4096 + c) * KLEN, tid, flt);
        lds_barrier(); SUBP_T1(10)
        SUBP_T0(11)
        f32x16 acc;
#if MK_LCX
        { lc_conv<MK_LCX - 1>(lds, LC_U1, wave, lane, acc); asm volatile("" :: "v"(acc)); lds_barrier(); if (tid < 32) ((LAS float*)(lds + LC_TAIL))[tid] = 0.f; lds_barrier(); }
#endif
        lc_conv(lds, LC_U1, wave, lane, acc);
        lds_barrier(); SUBP_T1(11) SUBP_T0(12)
        {
            const int I = 16 * wave + n16;
#pragma unroll
            for (int rg = 0; rg < 4; ++rg) { const int t = 32 * I + 8 * rg + 4 * h; const int G8 = (t + 480) >> 3; const int uoff = lc_ugran(bl, G8) + 2 * (t & 7);
                const u32x2 uu = *(const LAS u32x2*)(lds + LC_U1 + uoff); const u32x2 xx = *(const LAS u32x2*)(lds + LC_X1 + bl * 8224 + 2 * t);
                const float z0 = bflo(xx.x) * (acc[4 * rg + 0] + bias0 * bflo(uu.x)), z1 = bfhi(xx.x) * (acc[4 * rg + 1] + bias0 * bfhi(uu.x));
                const float z2 = bflo(xx.y) * (acc[4 * rg + 2] + bias0 * bflo(uu.y)), z3 = bfhi(xx.y) * (acc[4 * rg + 3] + bias0 * bfhi(uu.y));
                *(LAS u32x2*)(lds + LC_U2 + uoff) = (u32x2){pk2(z0, z1), pk2(z2, z3)}; }
            if (tid < 32) { const int b = tid >> 4, i = tid & 15, t = 4096 + i; const int uoff = lc_ugran(b, (t + 480) >> 3) + 2 * (t & 7);
                const float u = bf1(*(const LAS bf16_t*)(lds + LC_U1 + uoff)), x = bf1(*(const LAS bf16_t*)(lds + LC_X1 + b * 8224 + 2 * t));
                const float y = ((LAS float*)(lds + LC_TAIL))[b * 16 + i];
                *(LAS bf16_t*)(lds + LC_U2 + uoff) = (bf16_t)f2bf(x * (y + bias0 * u)); }
        }
        lc_store_filter(flt, lds, tid);
        lds_barrier(); SUBP_T1(12) SUBP_T0(13)
        if (tid < 32) ((LAS float*)(lds + LC_TAIL))[tid] = 0.f;
        u32x2 gg[4]; bf16_t gtail = 0;
#pragma unroll
        for (int rg = 0; rg < 4; ++rg) gg[rg] = *(const u32x2*)(grow + lc_tokrow(bl, 32 * (16 * wave + n16) + 8 * rg + 4 * h));
        gtail = grow[lc_tokrow((tid >> 4) & 1, 4096 + (tid & 15))];
        if (c + G < 4096) load_channel(c + G);
        lds_barrier(); SUBP_T1(13) SUBP_T0(14)
        lc_conv(lds, LC_U2, wave, lane, acc);
        lds_barrier(); SUBP_T1(14) SUBP_T0(15)
        {
            const int I = 16 * wave + n16;
#pragma unroll
            for (int rg = 0; rg < 4; ++rg) { const int t = 32 * I + 8 * rg + 4 * h; const int G8 = (t + 480) >> 3; const int uoff = lc_ugran(bl, G8) + 2 * (t & 7);
                const u32x2 zz = *(const LAS u32x2*)(lds + LC_U2 + uoff); const u32x2 xx = *(const LAS u32x2*)(lds + LC_X2 + bl * 8224 + 2 * t);
                const int row = lc_tokrow(bl, t); const u32x2 g2 = gg[rg];
                const float o0 = bflo(xx.x) * (acc[4 * rg + 0] + bias1 * bflo(zz.x)) * bflo(g2.x), o1 = bfhi(xx.x) * (acc[4 * rg + 1] + bias1 * bfhi(zz.x)) * bfhi(g2.x);
                const float o2 = bflo(xx.y) * (acc[4 * rg + 2] + bias1 * bflo(zz.y)) * bflo(g2.y), o3 = bfhi(xx.y) * (acc[4 * rg + 3] + bias1 * bfhi(zz.y)) * bfhi(g2.y);
                *(u32x2*)(YT + (size_t)c * MP + row) = (u32x2){pk2(o0, o1), pk2(o2, o3)}; }
            if (tid < 32) { const int b = tid >> 4, i = tid & 15, t = 4096 + i; const int uoff = lc_ugran(b, (t + 480) >> 3) + 2 * (t & 7);
                const float z = bf1(*(const LAS bf16_t*)(lds + LC_U2 + uoff)), x = bf1(*(const LAS bf16_t*)(lds + LC_X2 + b * 8224 + 2 * t));
                const float y = ((LAS float*)(lds + LC_TAIL))[b * 16 + i]; const int row = lc_tokrow(b, t);
                YT[(size_t)c * MP + row] = (bf16_t)f2bf(x * (y + bias1 * z) * bf1(gtail)); }
        }
        asm volatile("" : "+v"(nb0n), "+v"(nb1n));
        nb0 = nb0n; nb1 = nb1n;
        lds_barrier(); SUBP_T1(15)
    }
}
__device__ __forceinline__ void phase_transpose(const Params& p, LAS unsigned char* lds, int gw, int NGW, int wave, int lane) {
    const bf16_t* YT = (const bf16_t*)(p.ws + WS_YT); bf16_t* Y = (bf16_t*)(p.ws + WS_Y);
    LAS bf16_t* tile = (LAS bf16_t*)(lds + wave * 8704);
    constexpr int NTT = MP / 64;
    for (int it = gw; it < (D / 64) * NTT; it += NGW) {
        const int ct = it / NTT, tt = it % NTT; const int c0 = 64 * ct, t0 = 64 * tt;
#pragma unroll
        for (int k = 0; k < 8; ++k) { const int cl = 8 * k + (lane >> 3), ch = lane & 7; const u32x4 v = *(const u32x4*)(YT + (size_t)(c0 + cl) * MP + t0 + 8 * ch);
            LAS unsigned* d = (LAS unsigned*)(tile + cl * 68 + 8 * ch); d[0] = v.x; d[1] = v.y; d[2] = v.z; d[3] = v.w; }
        LDS_WAIT(); asm volatile("" ::: "memory");
#pragma unroll
        for (int k = 0; k < 8; ++k) { const int tl = 8 * k + (lane >> 3), ch = lane & 7; const LAS bf16_t* s = tile + (8 * ch) * 68 + tl;
            u32x4 o; o.x = (unsigned)s[0] | ((unsigned)s[68] << 16); o.y = (unsigned)s[2 * 68] | ((unsigned)s[3 * 68] << 16); o.z = (unsigned)s[4 * 68] | ((unsigned)s[5 * 68] << 16); o.w = (unsigned)s[6 * 68] | ((unsigned)s[7 * 68] << 16);
            *(u32x4*)(Y + (size_t)(t0 + tl) * D + c0 + 8 * ch) = o; }
        LDS_WAIT(); asm volatile("" ::: "memory");
    }
}
constexpr int TG_ROWB = 528;
constexpr int TG_A = 0, TG_B = 32 * TG_ROWB, TG_BUF = 96 * TG_ROWB;
__device__ __forceinline__ void thin_gemm(const Params& p, LAS unsigned char* lds, int mode, int jp, const bf16_t* Ameta, const bf16_t* W, int N, int vcu, int G, int tid, int wave, int lane) {
    const int r32 = lane & 31, h = lane >> 5, nt = wave & 1, kq = wave >> 1; LAS float* RED = (LAS float*)lds;
    for (int nb = vcu; nb < N / 64; nb += G) {
        const int n0 = 64 * nb;
        u32x4 st[6];
#define TG_LOAD(kc) do { _Pragma("unroll") for (int j = 0; j < 6; ++j) { const int q_ = tid + NTHR * j; const int row_ = (q_ >> 5) & 63, col_ = q_ & 31; \
            const bf16_t* src_ = (j < 2) ? Ameta + (size_t)(q_ >> 5) * D : W + (size_t)(n0 + row_ - (j < 2 ? 0 : 0)) * D; \
            st[j] = *(const u32x4*)((j < 2 ? Ameta + (size_t)(q_ >> 5) * D : W + (size_t)(n0 + ((q_ - 1024) >> 5)) * D) + 256 * (kc) + 8 * col_); (void)src_; (void)row_; } } while (0)
#define TG_STORE(buf) do { _Pragma("unroll") for (int j = 0; j < 6; ++j) { const int q_ = tid + NTHR * j; const int col_ = q_ & 31; \
            const int off_ = (j < 2) ? TG_A + (q_ >> 5) * TG_ROWB : TG_B + ((q_ - 1024) >> 5) * TG_ROWB; *(LAS u32x4*)(lds + (buf) * TG_BUF + off_ + 16 * col_) = st[j]; } } while (0)
        f32x16 acc;
#pragma unroll
        for (int i = 0; i < 16; ++i) acc[i] = 0.f;
        TG_LOAD(0); TG_STORE(0); lds_barrier();
        for (int kc = 0; kc < 16; ++kc) {
            const int buf = kc & 1;
            if (kc + 1 < 16) TG_LOAD(kc + 1);
            const LAS unsigned char* ab = lds + buf * TG_BUF + TG_A + r32 * TG_ROWB + 128 * kq + 16 * h; const LAS unsigned char* bb = lds + buf * TG_BUF + TG_B + (32 * nt + r32) * TG_ROWB + 128 * kq + 16 * h;
#pragma unroll
            for (int s4 = 0; s4 < 4; ++s4) acc = __builtin_amdgcn_mfma_f32_32x32x16_bf16(*(const LAS bf16x8*)(ab + 32 * s4), *(const LAS bf16x8*)(bb + 32 * s4), acc, 0, 0, 0);
            if (kc + 1 < 16) TG_STORE(buf ^ 1);
            lds_barrier();
        }
#undef TG_LOAD
#undef TG_STORE
#pragma unroll
        for (int reg = 0; reg < 16; ++reg) RED[(wave * 32 + (reg & 3) + 8 * (reg >> 2) + 4 * h) * 33 + r32] = acc[reg];
        lds_barrier();
#pragma unroll
        for (int half = 0; half < 2; ++half) {
            const int nh0 = n0 + 32 * half;
            const int seg = (mode == 0) ? (nh0 >> 11) : 0; const bool transposed = (mode == 2) || (mode == 0 && seg == 2);
            float v[2]; int tok[2], nn[2];
#pragma unroll
            for (int k = 0; k < 2; ++k) { tok[k] = transposed ? 2 * (tid & 15) + k : (tid >> 4); nn[k] = transposed ? (tid >> 4) : 2 * (tid & 15) + k; float s = 0.f;
#pragma unroll
                for (int q4 = 0; q4 < 4; ++q4) s += RED[((2 * q4 + half) * 32 + tok[k]) * 33 + nn[k]];
                v[k] = s; }
            if (mode == 0) {
                const float* lb = (const float*)(p.ws + WS_LB) + (size_t)jp * 4096;
#pragma unroll
                for (int k = 0; k < 2; ++k) { const int n = nh0 + nn[k];
                    if (seg == 0) v[k] *= 0.08838834764831845f; else if (seg == 3) v[k] = pg8::silu_f(v[k]) * 0.08838834764831845f;
                    else if (seg == 5 || seg == 6) { const float x = fminf(fmaxf(v[k], -80.f), 80.f); const float sg = __builtin_amdgcn_rcpf(1.0f + __expf(-x)); const float l0 = lb[(seg - 5) * 2048 + (n & 2047)]; v[k] = __logf(l0 + (1.0f - l0) * sg); }
                    else if (seg >= 7) v[k] = pg8::silu_f(v[k]); }
                if (seg == 2) *(unsigned*)((bf16_t*)(p.ws + WS_VT) + (size_t)(nh0 - 4096 + nn[0]) * MP + 8192 + tok[0]) = pk2(v[0], v[1]);
                else *(unsigned*)((bf16_t*)(p.ws + WS_P) + (size_t)(8192 + tok[0]) * EIN + nh0 + nn[0]) = pk2(v[0], v[1]);
            } else if (mode == 1) {
                *(unsigned*)((bf16_t*)(p.ws + WS_OUT) + (size_t)(8192 + tok[0]) * D + nh0 + nn[0]) = pk2(v[0], v[1]);
            } else {
                if (nh0 >= 12288) { v[0] = pg8::silu_f(v[0]); v[1] = pg8::silu_f(v[1]); }
                *(unsigned*)((bf16_t*)(p.ws + WS_P) + (size_t)(nh0 + nn[0]) * MP + 8192 + tok[0]) = pk2(v[0], v[1]);
            }
        }
        lds_barrier();
    }
}
#define GEMM_ALIGN true
#define GEMM_SP2 true
__global__ void __launch_bounds__(NTHR, 2) mk_fwd(Params p) {
    extern __shared__ __attribute__((aligned(16))) unsigned char lds_raw[];
    LAS unsigned char* lds = (LAS unsigned char*)lds_raw;
    volatile LAS unsigned* MISC = (volatile LAS unsigned*)(lds + MISC_OFF);
    const int tid = threadIdx.x, lane = tid & 63, wave = __builtin_amdgcn_readfirstlane(tid >> 6);
    const int G = gridDim.x; const int bx = blockIdx.x; const int vcu = (G % 8 == 0) ? (bx % 8) * (G / 8) + bx / 8 : bx;
    const int gw = vcu * NWAVES + wave, NGW = G * NWAVES;
    unsigned char* ws = p.ws;
    for (int u = tid; u < (LDS_BYTES - MISC_OFF) / 4; u += NTHR) MISC[u] = 0u;
    __syncthreads();
    XcdBarrier bar; bar.bar = (unsigned*)(ws + WS_CTL) + CW_BAR; bar.x = 0; bar.st = nullptr;
#if !MK_PER_PHASE
    bar = xcd_barrier_post((unsigned*)(ws + WS_CTL) + CW_BAR, MISC);
#endif
    const int lo = p.ph_lo, hi = p.ph_hi;
#define FRESH() int tid_ = threadIdx.x; asm volatile("" : "+v"(tid_)); const int lane_ = tid_ & 63, wave_ = __builtin_amdgcn_readfirstlane(tid_ >> 6); \
    int vcu_ = vcu; asm volatile("" : "+s"(vcu_)); const int gw_ = vcu_ * NWAVES + wave_; Params q = p; { __attribute__((address_space(1))) unsigned char* w_ = (__attribute__((address_space(1))) unsigned char*)q.ws; asm volatile("" : "+s"(w_)); q.ws = (unsigned char*)w_; } unsigned char* ws_ = q.ws; (void)lane_; (void)gw_; (void)ws_; \
    int G_f = gridDim.x, bx_f = blockIdx.x; asm volatile("" : "+s"(G_f), "+s"(bx_f)); (void)G_f; (void)bx_f;
#define IN(k) (lo <= (k) && (k) < hi)
#if MK_PER_PHASE
#define SEAM(k) do { } while (0)
#elif MK_TIME_MASK || MK_SUBPROBE
    unsigned long long t_prev = wall_clock64(), t_acc = 0;
#define SEAM(k) do { if (IN(k) && IN((k) + 1)) xcd_barrier(bar); { const unsigned long long now_ = wall_clock64(); if ((MK_TIME_MASK >> (k)) & 1u) t_acc += now_ - t_prev; t_prev = now_; } } while (0)
#else
#define SEAM(k) do { if (IN(k) && IN((k) + 1)) xcd_barrier(bar); } while (0)
#endif
    if (IN(0)) { FRESH() phase_prologue(q, lds, gw_, NGW, wave_, lane_); } SEAM(0);
    if (IN(1)) { FRESH() phase_filtergen(q, lds, gw_, NGW, wave_, lane_); } SEAM(1);
    for (int jp = 0; jp < 2; ++jp) {
        const int pb = 2 + 11 * jp;
        if (IN(pb + 0)) { FRESH() const bf16_t* HN = (const bf16_t*)(ws_ + WS_HN);
            const bf16_t* W = (const bf16_t*)(ws_ + WS_WEIN) + (size_t)jp * EIN * D;
            pg8::DualOrder S; S.init(HN, W, NB * T, EIN - 2048, W + (size_t)4096 * D, HN, 2048, NB * T, D, G_f, bx_f, 16, 8);
            pg8::EpiEvenIn E{(bf16_t*)(ws_ + WS_P), EIN, (bf16_t*)(ws_ + WS_VT), MP, (const float*)(ws_ + WS_LB) + (size_t)jp * 4096};
            pg8::gemm_phase<pg8::EpiEvenIn, pg8::DualOrder, GEMM_ALIGN, GEMM_SP2>(lds, D, S, E);
            SUBP_T0(3) thin_gemm(q, lds, 0, jp, HN + (size_t)NB * T * D, W, EIN, vcu_, G_f, tid_, wave_, lane_); SUBP_T1(3)
        } SEAM(pb + 0);
        if (IN(pb + 1)) { FRESH()
            SUBP_T0(1) if (G_f >= 128) hgrn_stage1(q, lds, 0, HG_C1, vcu_, G_f, tid_, wave_, lane_); else hgrn_stage1(q, lds, 0, 65, vcu_, G_f, tid_, wave_, lane_); SUBP_T1(1)
        } SEAM(pb + 1);
        if (IN(pb + 2)) { FRESH()
            int bx_ = MK_SWAP ? (int)(gridDim.x - 1 - blockIdx.x) : (int)blockIdx.x, G_ = gridDim.x; asm volatile("" : "+s"(bx_), "+s"(G_));
            if (G_ >= 128) {
                const int nw = G_ - 64; const bool xa = (nw & 7) == 0; const bool nd = xa && (nw >> 3) == 24;
                unsigned* flag = (unsigned*)(ws_ + WS_CTL) + 16384 + 64 * jp;
                if (bx_ < 64) { SUBP_T0(30) hgrn_stage2f(q, lds, bx_, flag, (unsigned)nw, tid_, wave_, lane_); SUBP_T1(30)
                    if (nd) { const int s1 = (bx_ & 7) * 128 + 120 + (bx_ >> 3); natten_wg(q, lds, s1, 128, s1 + 1, jp, tid_, wave_, lane_); } }
                else { const int b2 = bx_ - 64; const int u = xa ? (b2 & 7) * (nw >> 3) + (b2 >> 3) : b2;
                    hgrn_stage1(q, lds, HG_C1, 65, u, nw, tid_, wave_, lane_);
                    asm volatile("s_waitcnt vmcnt(0)" ::: "memory"); __syncthreads();
                    if (tid_ == 0) { __builtin_amdgcn_fence(__ATOMIC_RELEASE, "agent"); asm volatile("s_waitcnt vmcnt(0)" ::: "memory"); (void)xb_add(flag, 1u); }
                    const int s0 = xa ? (b2 & 7) * 128 + (b2 >> 3) : b2, sst = xa ? (nw >> 3) : nw, sen = xa ? (b2 & 7) * 128 + (nd ? 120 : 128) : 1024;
                    SUBP_T0(2) natten_wg(q, lds, s0, sst, sen, jp, tid_, wave_, lane_); SUBP_T1(2)
                    const int mi = xa ? (((b2 >> 3) == (nw >> 3) - 1 && wave_ < 4) ? (b2 & 7) * 4 + wave_ : 32) : (b2 < 4 ? b2 * NWAVES + wave_ : 32);
                    if (mi < 32) natten_item(q, (LAS float*)(lds + wave_ * 2048), 8192 + mi, jp, lane_); }
            } else {
                for (int item = bx_; item < 64; item += G_) hgrn_stage2f(q, lds, item, nullptr, 0u, tid_, wave_, lane_);
                for (int it = gw_; it < 8192 + 32; it += NGW) natten_item(q, (LAS float*)(lds + wave_ * 2048), it, jp, lane_);
            }
        } SEAM(pb + 2);
        if (IN(pb + 3)) { FRESH() phase_combine(q, jp, gw_, NGW, lane_); } SEAM(pb + 3);
        if (IN(pb + 4)) { FRESH()
            pg8::DualOrder S; S.init(ws_ + WS_Y, (const bf16_t*)(ws_ + WS_WEOUT) + (size_t)jp * D * D, NB * T, D, nullptr, nullptr, 0, 0, D, G_f, bx_f, 1 << 30, 0);
            pg8::EpiBf16Plain E{(bf16_t*)(ws_ + WS_OUT), D};
            pg8::gemm_phase<pg8::EpiBf16Plain, pg8::DualOrder, GEMM_ALIGN, GEMM_SP2>(lds, D, S, E);
            thin_gemm(q, lds, 1, jp, (const bf16_t*)(ws_ + WS_Y) + (size_t)NB * T * D, (const bf16_t*)(ws_ + WS_WEOUT) + (size_t)jp * D * D, D, vcu_, G_f, tid_, wave_, lane_);
        } SEAM(pb + 4);
        if (IN(pb + 5)) { FRESH() phase_postnorm(q, lds, 2 * jp, vcu_, G_f, tid_, wave_, lane_); } SEAM(pb + 5);
        if (IN(pb + 6)) { FRESH() const bf16_t* HN = (const bf16_t*)(ws_ + WS_HN);
            pg8::DualOrder S; S.init((const bf16_t*)(ws_ + WS_WOIN) + (size_t)jp * OIN * D, HN, OIN, NB * T, nullptr, nullptr, 0, 0, D, G_f, bx_f, 1 << 30, 0);
            pg8::EpiOddIn E{(bf16_t*)(ws_ + WS_P), MP, 48};
            pg8::gemm_phase<pg8::EpiOddIn, pg8::DualOrder, GEMM_ALIGN, GEMM_SP2>(lds, D, S, E);
            SUBP_T0(5) thin_gemm(q, lds, 2, jp, HN + (size_t)NB * T * D, (const bf16_t*)(ws_ + WS_WOIN) + (size_t)jp * OIN * D, OIN, vcu_, G_f, tid_, wave_, lane_); SUBP_T1(5)
        } SEAM(pb + 6);
        if (IN(pb + 7)) { FRESH() phase_longconv(q, lds, jp, vcu_, G_f, tid_, wave_, lane_); } SEAM(pb + 7);
        if (IN(pb + 8)) { FRESH() phase_transpose(q, lds, gw_, NGW, wave_, lane_); } SEAM(pb + 8);
        if (IN(pb + 9)) { FRESH()
            pg8::DualOrder S; S.init(ws_ + WS_Y, (const bf16_t*)(ws_ + WS_WOOUT) + (size_t)jp * D * D, NB * T, D, nullptr, nullptr, 0, 0, D, G_f, bx_f, 1 << 30, 0);
            pg8::EpiBf16Plain E{(bf16_t*)(ws_ + WS_OUT), D};
            pg8::gemm_phase<pg8::EpiBf16Plain, pg8::DualOrder, GEMM_ALIGN, GEMM_SP2>(lds, D, S, E);
            thin_gemm(q, lds, 1, jp, (const bf16_t*)(ws_ + WS_Y) + (size_t)NB * T * D, (const bf16_t*)(ws_ + WS_WOOUT) + (size_t)jp * D * D, D, vcu_, G_f, tid_, wave_, lane_);
        } SEAM(pb + 9);
        if (IN(pb + 10)) { FRESH() phase_postnorm(q, lds, 2 * jp + 1, vcu_, G_f, tid_, wave_, lane_); } SEAM(pb + 10);
    }
#if (MK_TIME_MASK || MK_SUBPROBE) && !MK_PER_PHASE
    if (blockIdx.x == 0) { __syncthreads(); const unsigned long long sub_ = ((unsigned long long)MISC[5] << 32) | MISC[4]; const unsigned long long t_end = wall_clock64(); while (wall_clock64() - t_end < (unsigned long long)MK_TIME_MULT * (t_acc + sub_)) __builtin_amdgcn_s_sleep(8); }
#endif
#undef IN
#undef SEAM
}

extern "C" void kernel_launch(void* const* d_in, const int* in_sizes, int n_in, void* d_out, int out_size, void* d_ws, size_t ws_size, hipStream_t stream) {
    static int grid = 0;
    if (grid == 0) {
        if (n_in != 21 || ws_size < WS_END) { fprintf(stderr, "kernel_launch: expected 21 inputs and >= %zu bytes of workspace; got %d, %zu\n", (size_t)WS_END, n_in, ws_size); grid = -1; return; }
        int dev = 0, cus = 0, per_cu = 0;
        if (hipGetDevice(&dev) != hipSuccess || hipDeviceGetAttribute(&cus, hipDeviceAttributeMultiprocessorCount, dev) != hipSuccess) { grid = -1; return; }
        if (hipFuncSetAttribute((const void*)mk_fwd, hipFuncAttributeMaxDynamicSharedMemorySize, LDS_BYTES) != hipSuccess) { fprintf(stderr, "kernel_launch: hipFuncSetAttribute failed\n"); grid = -1; return; }
        if (hipOccupancyMaxActiveBlocksPerMultiprocessor(&per_cu, (const void*)mk_fwd, NTHR, LDS_BYTES) != hipSuccess || per_cu < 1)
            fprintf(stderr, "kernel_launch: note: occupancy query reports %d workgroups per CU\n", per_cu);
        (void)hipGetLastError();
        grid = cus;
    }
    if (grid < 0) return;
    if (hipMemsetAsync((char*)d_ws + WS_CTL, 0, CTL_ZERO_BYTES, stream) != hipSuccess) return;
    Params a{};
    for (int i = 0; i < 21; ++i) a.in[i] = (const float*)d_in[i];
    a.out = (float*)d_out; a.ws = (unsigned char*)d_ws;
#if MK_PER_PHASE
    for (int ph = 0; ph < NPHASE; ++ph) { a.ph_lo = ph; a.ph_hi = ph + 1; hipLaunchKernelGGL(mk_fwd, dim3(grid), dim3(NTHR), LDS_BYTES, stream, a); }
#else
    a.ph_lo = 0; a.ph_hi = NPHASE; hipLaunchKernelGGL(mk_fwd, dim3(grid), dim3(NTHR), LDS_BYTES, stream, a);
#endif
    const hipError_t le = hipPeekAtLastError();
    if (le != hipSuccess) fprintf(stderr, "kernel_launch: launch failed: %s\n", hipGetErrorName(le));
}
```
